# Optimizing an MI355X kernel written in HIP

```python
import math
import jax, jax.numpy as jnp
from jax import lax
import numpy as np

D_MODEL = 2048
BATCH = 4
SEQ = 4096
DEPTH = 2

N_META = 16
MLA_HEADS = 8
Q_LORA = 512
KV_LORA = 512
QK_NOPE = 128
QK_ROPE = 64
V_HEAD = 128
ROPE_THETA = 10000.0
Q_BLOCK = 128
ML_HEADS = 8
ML_QK = 128
ML_V = 256
CONV_K = 4
CHUNK = 64
N_EXPERTS = 64
TOP_K = 8
N_GROUPS = 8
TOPK_GROUPS = 4
D_EXPERT = 512
ROUTED_SCALE = 2.5
EXPERT_BLOCK = 128
ALPHA = (2 * DEPTH) ** 0.25
BETA = (8 * DEPTH) ** -0.25
LN_EPS = 1e-5
RMS_EPS = 1e-6
NEG = -1e30

IN_SIZES = (Q_LORA, KV_LORA, QK_ROPE,
            ML_HEADS * ML_QK, ML_HEADS * ML_QK, ML_HEADS * ML_V, ML_HEADS * ML_V,
            ML_HEADS, ML_HEADS, D_MODEL, D_MODEL)
IN_WIDTH = sum(IN_SIZES)
FG_OFFSET = sum(IN_SIZES[:8])

kernel_name = "hybrid_mla_mlstm_moe_deepnorm"


def _split(z, sizes):
    offs = tuple(int(o) for o in np.cumsum(sizes)[:-1])
    return jnp.split(z, offs, axis=-1)


def layer_norm(x, g, b):
    xf = x.astype(jnp.float32)
    mu = xf.mean(-1, keepdims=True)
    var = jnp.square(xf - mu).mean(-1, keepdims=True)
    return ((xf - mu) * lax.rsqrt(var + LN_EPS) * g + b).astype(x.dtype)


def rms_norm(x, g):
    xf = x.astype(jnp.float32)
    return (xf * lax.rsqrt(jnp.square(xf).mean(-1, keepdims=True) + RMS_EPS) * g).astype(x.dtype)


def rope(x, cos, sin):
    x1, x2 = jnp.split(x, 2, axis=-1)
    return jnp.concatenate([x1 * cos - x2 * sin, x1 * sin + x2 * cos], axis=-1).astype(x.dtype)


def mla_attention(cq, ckv, kr, q_norm_g, kv_norm_g, w_uq, w_ukv):
    B, T, _ = cq.shape
    H = MLA_HEADS
    q = (rms_norm(cq, q_norm_g) @ w_uq).reshape(B, T, H, QK_NOPE + QK_ROPE)
    qn, qr = q[..., :QK_NOPE], q[..., QK_NOPE:]
    kv = (rms_norm(ckv, kv_norm_g) @ w_ukv).reshape(B, T, H, QK_NOPE + V_HEAD)
    kn, v = kv[..., :QK_NOPE], kv[..., QK_NOPE:]
    pos = jnp.arange(T, dtype=jnp.float32)
    inv_freq = 1.0 / (ROPE_THETA ** (jnp.arange(0, QK_ROPE, 2, dtype=jnp.float32) / QK_ROPE))
    ang = pos[:, None] * inv_freq[None, :]
    cos, sin = jnp.cos(ang), jnp.sin(ang)
    qr = rope(qr, cos[None, :, None, :], sin[None, :, None, :])
    kr = rope(kr, cos[None], sin[None])
    nb = -(-T // Q_BLOCK)
    Tp = nb * Q_BLOCK
    padT = Tp - T
    pad4 = ((0, 0), (0, padT), (0, 0), (0, 0))
    qn, qr, kn, v = (jnp.pad(a, pad4) for a in (qn, qr, kn, v))
    kr = jnp.pad(kr, ((0, 0), (0, padT), (0, 0)))
    qn_b = qn.reshape(B, nb, Q_BLOCK, H, QK_NOPE).swapaxes(0, 1)
    qr_b = qr.reshape(B, nb, Q_BLOCK, H, QK_ROPE).swapaxes(0, 1)
    kpos = jnp.arange(Tp)
    scale = (QK_NOPE + QK_ROPE) ** -0.5

    def block(args):
        qn_i, qr_i, i = args
        s = (jnp.einsum('bqhd,bkhd->bhqk', qn_i, kn)
             + jnp.einsum('bqhr,bkr->bhqk', qr_i, kr)).astype(jnp.float32) * scale
        qpos = i * Q_BLOCK + jnp.arange(Q_BLOCK)
        s = jnp.where(kpos[None, :] <= qpos[:, None], s, -jnp.inf)
        p = jax.nn.softmax(s, axis=-1).astype(v.dtype)
        return jnp.einsum('bhqk,bkhd->bqhd', p, v)

    o = lax.map(block, (qn_b, qr_b, jnp.arange(nb)))
    return o.swapaxes(0, 1).reshape(B, Tp, H * V_HEAD)[:, :T]


def causal_conv(x, w, b):
    T = x.shape[1]
    xp = jnp.pad(x, ((0, 0), (CONV_K - 1, 0), (0, 0)))
    y = b
    for j in range(CONV_K):
        y = y + w[j] * xp[:, j:j + T]
    return y


def mlstm(q, k, v, ig, fg):
    B, T, _ = q.shape
    H, L = ML_HEADS, CHUNK
    padl = CHUNK - N_META
    f32 = jnp.float32
    q = q.astype(f32).reshape(B, T, H, ML_QK)
    k = k.astype(f32).reshape(B, T, H, ML_QK) * (ML_QK ** -0.5)
    v = v.astype(f32).reshape(B, T, H, ML_V)
    lf = jax.nn.log_sigmoid(fg.astype(f32))
    ig = ig.astype(f32)
    p4 = ((0, 0), (padl, 0), (0, 0), (0, 0))
    q, k, v = jnp.pad(q, p4), jnp.pad(k, p4), jnp.pad(v, p4)
    lf = jnp.pad(lf, ((0, 0), (padl, 0), (0, 0)))
    ig = jnp.pad(ig, ((0, 0), (padl, 0), (0, 0)), constant_values=NEG)
    Lm = T + padl
    nc = Lm // L

    def chunks4(a):
        return a.reshape(B, nc, L, H, a.shape[-1]).transpose(1, 0, 3, 2, 4)

    def chunks3(a):
        return a.reshape(B, nc, L, H).transpose(1, 0, 3, 2)

    causal = jnp.tril(jnp.ones((L, L), dtype=bool))

    def step(carry, inp):
        C, n, m = carry
        qc, kc, vc, lfc, igc = inp
        b = jnp.cumsum(lfc, axis=-1)
        dmat = jnp.where(causal, b[..., :, None] - b[..., None, :] + igc[..., None, :], NEG)
        inter = b + m[..., None]
        mrow = jnp.maximum(dmat.max(-1), inter)
        s = jnp.einsum('bhtd,bhsd->bhts', qc, kc) * jnp.exp(dmat - mrow[..., None])
        e_in = jnp.exp(inter - mrow)
        num = jnp.einsum('bhts,bhsv->bhtv', s, vc) + e_in[..., None] * jnp.einsum('bhtd,bhdv->bhtv', qc, C)
        den = s.sum(-1) + e_in * jnp.einsum('bhtd,bhd->bht', qc, n)
        hc = num / jnp.maximum(jnp.abs(den), jnp.exp(-mrow))[..., None]
        g = b[..., -1]
        a = g[..., None] - b + igc
        m_new = jnp.maximum(g + m, a.max(-1))
        ea = jnp.exp(a - m_new[..., None])
        decay = jnp.exp(g + m - m_new)
        C = decay[..., None, None] * C + jnp.einsum('bhs,bhsd,bhsv->bhdv', ea, kc, vc)
        n = decay[..., None] * n + jnp.einsum('bhs,bhsd->bhd', ea, kc)
        return (C, n, m_new), hc

    init = (jnp.zeros((B, H, ML_QK, ML_V), f32), jnp.zeros((B, H, ML_QK), f32), jnp.zeros((B, H), f32))
    _, hs = lax.scan(step, init, (chunks4(q), chunks4(k), chunks4(v), chunks3(lf), chunks3(ig)))
    hs = hs.transpose(1, 0, 3, 2, 4).reshape(B, Lm, H, ML_V)
    return hs[:, padl:]


def mixer(h, w_in, b_in, q_norm_g, kv_norm_g, w_uq, w_ukv, conv_w, conv_b, ml_norm_g,
          w_br_mla, w_br_mlstm, w_out):
    B, T, _ = h.shape
    z = h @ w_in + b_in
    cq, ckv, kr, mq, mk, mv, mo, mi, mf, ga, gb = _split(z, IN_SIZES)
    y_a = mla_attention(cq, ckv, kr, q_norm_g, kv_norm_g, w_uq, w_ukv) @ w_br_mla
    qk = jax.nn.silu(causal_conv(jnp.concatenate([mq, mk], -1), conv_w, conv_b))
    mq_c, mk_c = jnp.split(qk, 2, axis=-1)
    hm = mlstm(mq_c, mk_c, mv, mi, mf)
    hm = rms_norm(hm, ml_norm_g.reshape(ML_HEADS, ML_V).astype(jnp.float32))
    hm = hm.reshape(B, T, ML_HEADS * ML_V).astype(h.dtype) * jax.nn.sigmoid(mo)
    y_b = hm @ w_br_mlstm
    y = jax.nn.sigmoid(ga) * y_a + jax.nn.sigmoid(gb) * y_b
    return y @ w_out


def moe(h, w_router, e_bias, w1, w3, w2, ws1, ws3, ws2):
    B, T, D = h.shape
    xf = h.reshape(B * T, D)
    Tt = B * T
    scores = jax.nn.sigmoid(xf.astype(jnp.float32) @ w_router.astype(jnp.float32))
    biased = scores + e_bias.astype(jnp.float32)
    gs = lax.top_k(biased.reshape(Tt, N_GROUPS, N_EXPERTS // N_GROUPS), 2)[0].sum(-1)
    _, gidx = lax.top_k(gs, TOPK_GROUPS)
    gmask = jax.nn.one_hot(gidx, N_GROUPS).sum(1) > 0
    emask = jnp.repeat(gmask, N_EXPERTS // N_GROUPS, axis=1)
    _, idx = lax.top_k(jnp.where(emask, biased, -jnp.inf), TOP_K)
    wts = jnp.take_along_axis(scores, idx, axis=1)
    wts = wts / wts.sum(-1, keepdims=True) * ROUTED_SCALE
    N = Tt * TOP_K
    e_flat = idx.reshape(-1)
    tok_flat = jnp.arange(N, dtype=jnp.int32) // TOP_K
    w_flat = wts.reshape(-1)
    order = jnp.argsort(e_flat)
    e_s = e_flat[order]
    counts = jnp.bincount(e_flat, length=N_EXPERTS)
    starts = jnp.cumsum(counts) - counts
    pcounts = (counts + EXPERT_BLOCK - 1) // EXPERT_BLOCK * EXPERT_BLOCK
    pends = jnp.cumsum(pcounts)
    pstarts = pends - pcounts
    dest = pstarts[e_s] + (jnp.arange(N) - starts[e_s])
    NB = -(-N // EXPERT_BLOCK) + N_EXPERTS
    P = NB * EXPERT_BLOCK
    buf_tok = jnp.full((P,), Tt, dtype=jnp.int32).at[dest].set(tok_flat[order])
    buf_w = jnp.zeros((P,), jnp.float32).at[dest].set(w_flat[order])
    blk_e = jnp.clip(jnp.searchsorted(pends, jnp.arange(NB) * EXPERT_BLOCK, side='right'), 0, N_EXPERTS - 1)
    xpad = jnp.concatenate([xf, jnp.zeros((1, D), xf.dtype)], axis=0)

    def step(acc, blk):
        toks, ww, e = blk
        xb = xpad[toks]
        hb = jax.nn.silu(xb @ w1[e]) * (xb @ w3[e])
        y = (hb @ w2[e]).astype(jnp.float32) * ww[:, None]
        return acc.at[toks].add(y), None

    acc, _ = lax.scan(step, jnp.zeros((Tt + 1, D), jnp.float32),
                      (buf_tok.reshape(NB, EXPERT_BLOCK), buf_w.reshape(NB, EXPERT_BLOCK), blk_e))
    shared = (jax.nn.silu(xf @ ws1) * (xf @ ws3)) @ ws2
    out = acc[:Tt] + shared.astype(jnp.float32)
    return out.astype(h.dtype).reshape(B, T, D)


def setup_inputs(seed: int = 0) -> dict:
    key = jax.random.key(seed)
    ks = jax.random.split(key, 32)
    f32 = jnp.float32

    def nrm(k, shape, scale):
        return jax.random.normal(k, shape, f32) * scale

    Dd, L = D_MODEL, DEPTH
    b_in = nrm(ks[5], (L, IN_WIDTH), 0.02)
    b_in = b_in.at[:, FG_OFFSET:FG_OFFSET + ML_HEADS].add(jnp.linspace(3.0, 6.0, ML_HEADS, dtype=f32))
    return {
        "x": nrm(ks[0], (BATCH, SEQ, Dd), 1.0),
        "meta": nrm(ks[1], (N_META, Dd), 1.0),
        "ln_in_g": 1.0 + nrm(ks[2], (Dd,), 0.02),
        "ln_in_b": nrm(ks[3], (Dd,), 0.02),
        "w_in": nrm(ks[4], (L, Dd, IN_WIDTH), Dd ** -0.5),
        "b_in": b_in,
        "q_norm_g": 1.0 + nrm(ks[6], (L, Q_LORA), 0.02),
        "kv_norm_g": 1.0 + nrm(ks[7], (L, KV_LORA), 0.02),
        "w_uq": nrm(ks[8], (L, Q_LORA, MLA_HEADS * (QK_NOPE + QK_ROPE)), Q_LORA ** -0.5),
        "w_ukv": nrm(ks[9], (L, KV_LORA, MLA_HEADS * (QK_NOPE + V_HEAD)), KV_LORA ** -0.5),
        "conv_w": nrm(ks[10], (L, CONV_K, 2 * ML_HEADS * ML_QK), CONV_K ** -0.5),
        "conv_b": nrm(ks[11], (L, 2 * ML_HEADS * ML_QK), 0.02),
        "ml_norm_g": 1.0 + nrm(ks[12], (L, ML_HEADS * ML_V), 0.02),
        "w_br_mla": nrm(ks[13], (L, MLA_HEADS * V_HEAD, Dd), (MLA_HEADS * V_HEAD) ** -0.5),
        "w_br_mlstm": nrm(ks[14], (L, ML_HEADS * ML_V, Dd), (ML_HEADS * ML_V) ** -0.5),
        "w_out": nrm(ks[15], (L, Dd, Dd), BETA * Dd ** -0.5),
        "ln1_g": 1.0 + nrm(ks[16], (L, Dd), 0.02),
        "ln1_b": nrm(ks[17], (L, Dd), 0.02),
        "w_router": nrm(ks[18], (L, Dd, N_EXPERTS), Dd ** -0.5),
        "e_bias": nrm(ks[19], (L, N_EXPERTS), 0.01),
        "w1": nrm(ks[20], (L, N_EXPERTS, Dd, D_EXPERT), Dd ** -0.5),
        "w3": nrm(ks[21], (L, N_EXPERTS, Dd, D_EXPERT), Dd ** -0.5),
        "w2": nrm(ks[22], (L, N_EXPERTS, D_EXPERT, Dd), BETA * D_EXPERT ** -0.5),
        "ws1": nrm(ks[23], (L, Dd, D_EXPERT), Dd ** -0.5),
        "ws3": nrm(ks[24], (L, Dd, D_EXPERT), Dd ** -0.5),
        "ws2": nrm(ks[25], (L, D_EXPERT, Dd), BETA * D_EXPERT ** -0.5),
        "ln2_g": 1.0 + nrm(ks[26], (L, Dd), 0.02),
        "ln2_b": nrm(ks[27], (L, Dd), 0.02),
    }


def reference(x, meta, ln_in_g, ln_in_b, w_in, b_in, q_norm_g, kv_norm_g, w_uq, w_ukv,
              conv_w, conv_b, ml_norm_g, w_br_mla, w_br_mlstm, w_out, ln1_g, ln1_b,
              w_router, e_bias, w1, w3, w2, ws1, ws3, ws2, ln2_g, ln2_b):
    B = x.shape[0]
    h = jnp.concatenate([jnp.broadcast_to(meta[None].astype(x.dtype), (B, N_META, D_MODEL)), x], axis=1)
    h = layer_norm(h, ln_in_g, ln_in_b)
    for l in range(DEPTH):
        y = mixer(h, w_in[l], b_in[l], q_norm_g[l], kv_norm_g[l], w_uq[l], w_ukv[l],
                  conv_w[l], conv_b[l], ml_norm_g[l], w_br_mla[l], w_br_mlstm[l], w_out[l])
        h = layer_norm(ALPHA * h + y, ln1_g[l], ln1_b[l])
        y = moe(h, w_router[l], e_bias[l], w1[l], w3[l], w2[l], ws1[l], ws3[l], ws2[l])
        h = layer_norm(ALPHA * h + y, ln2_g[l], ln2_b[l])
    return h[:, N_META:]
```

```cpp
#include <hip/hip_runtime.h>
#include <stdint.h>
#include <stdio.h>

#define LAS __attribute__((address_space(3)))
typedef unsigned short bf16;
typedef short bf16x8 __attribute__((ext_vector_type(8)));
typedef float f32x2 __attribute__((ext_vector_type(2)));
typedef float f32x4 __attribute__((ext_vector_type(4)));
typedef float f32x16 __attribute__((ext_vector_type(16)));
typedef unsigned u32x2 __attribute__((ext_vector_type(2)));
typedef unsigned u32x4 __attribute__((ext_vector_type(4)));
typedef __bf16 bf16x2v __attribute__((ext_vector_type(2)));
#define DI __device__ __forceinline__

constexpr int DM = 2048, NBATCH = 4, SEQ = 4096, NMETA = 16, PADL = 48, TP = 4160, RROWS = NBATCH * TP, NREAL = NBATCH * SEQ;
__host__ __device__ __forceinline__ int chunk_row0(int b, int c) { return c == 0 ? NREAL + 64 * b : b * SEQ + 64 * (c - 1); }
constexpr int INW = 11344, ZW = 11520;
constexpr int ZC_CQ = 0, ZC_CKV = 512, ZC_MQ = 1024, ZC_MK = 2048, ZC_MV = 3072, ZC_MO = 5120, ZC_GA = 7168, ZC_GB = 9216, ZC_S = 11264;
constexpr int NEXP = 64, DEXP = 512, TOPK = 8;
#ifndef ZC_F8_START
#define ZC_F8_START ZC_MQ
#endif
constexpr int ZC_F8 = ZC_F8_START, NT_BF = ZC_F8 / 256, NT_F8 = (ZC_S - ZC_F8) / 256;
constexpr int MAXRT = 584, NSHT = RROWS / 256, MAXTILES = MAXRT + NSHT, PROWS = MAXTILES * 256;
constexpr float ALPHA = 1.41421356237f, LN_EPS = 1e-5f, RMS_EPS = 1e-6f;
constexpr float QSCALE = 0.07216878364870322f * 1.4426950408889634f;
constexpr int NW = 8, NT = 512;

constexpr size_t al4k(size_t x) { return (x + 4095) & ~(size_t)4095; }
constexpr size_t WS_CTL = 0, CTL_BYTES = 1u << 20;
constexpr size_t WS_WIN = CTL_BYTES;
constexpr size_t WS_WIN8 = WS_WIN + al4k((size_t)ZW * DM * 2);
constexpr size_t WS_WUQ = WS_WIN8 + al4k((size_t)(ZC_S - ZC_F8) * DM);
constexpr size_t WS_WKV = WS_WUQ + al4k((size_t)1536 * 512 * 2);
constexpr size_t WS_WBRA = WS_WKV + al4k((size_t)2048 * 512 * 2);
constexpr size_t WS_WBRB = WS_WBRA + al4k((size_t)2048 * 1024 * 2);
constexpr size_t WS_WOUT = WS_WBRB + al4k((size_t)2048 * 2048 * 2);
constexpr size_t WS_WR = WS_WOUT + al4k((size_t)2048 * 2048 * 2);
constexpr size_t WS_W13 = WS_WR + al4k((size_t)256 * 2048 * 2);
constexpr size_t WS_W2 = WS_W13 + al4k((size_t)65 * 1024 * 2048 * 2);
constexpr size_t WS_BIAS = WS_W2 + al4k((size_t)65 * 2048 * 512 * 2);
constexpr size_t WS_ROPE = WS_BIAS + al4k((size_t)ZW * 4);
constexpr size_t WS_H = WS_ROPE + al4k((size_t)TP * 64 * 4);
constexpr size_t WS_HB = WS_H + al4k((size_t)RROWS * DM * 4);
constexpr size_t WS_HB8 = WS_HB + al4k((size_t)RROWS * DM * 2);
constexpr size_t WS_SCR = WS_HB8 + al4k((size_t)RROWS * DM);
constexpr size_t WS_Z = WS_SCR;
constexpr size_t WS_ZS = WS_Z + al4k((size_t)RROWS * ZW * 2);
constexpr size_t WS_Q = WS_ZS + al4k((size_t)RROWS * 128 * 4);
constexpr size_t WS_KN = WS_Q + al4k((size_t)RROWS * 1536 * 2);
constexpr size_t WS_VT = WS_KN + al4k((size_t)RROWS * 1024 * 2);
constexpr size_t WS_KRR = WS_VT + al4k((size_t)RROWS * 1024 * 2);
constexpr size_t WS_QKC = WS_KRR + al4k((size_t)RROWS * 64 * 2);
constexpr size_t WS_GATES = WS_QKC + al4k((size_t)RROWS * 2048 * 2);
constexpr size_t WS_RSTD = WS_GATES + al4k((size_t)RROWS * 16 * 4);
constexpr size_t WS_ATT = WS_RSTD + al4k((size_t)RROWS * 2 * 4);
constexpr size_t WS_HRAW = WS_ATT + al4k((size_t)RROWS * 1024 * 2);
constexpr size_t WS_HM = WS_HRAW + al4k((size_t)RROWS * 2048 * 2);
constexpr size_t WS_MIX_END = WS_HM + al4k((size_t)RROWS * 2048 * 2);
constexpr size_t WS_TBUF = WS_Q;
constexpr size_t WS_Y = WS_QKC;
static_assert((size_t)RROWS * 2048 * 2 <= WS_VT - WS_Q, "tbuf overlay");
constexpr size_t WS_XG = WS_SCR;
constexpr size_t WS_HBUF = WS_XG + al4k((size_t)PROWS * 2048 * 2);
constexpr size_t WS_LOGIT = WS_HBUF + al4k((size_t)PROWS * 512 * 2);
constexpr size_t WS_SELE = WS_LOGIT + al4k((size_t)RROWS * 64 * 4);
constexpr size_t WS_SELW = WS_SELE + al4k((size_t)RROWS * 8 * 4);
constexpr size_t WS_LOC = WS_SELW + al4k((size_t)RROWS * 8 * 4);
constexpr size_t WS_POS = WS_LOC + al4k((size_t)RROWS * 8 * 4);
constexpr size_t WS_CNT = WS_POS + al4k((size_t)RROWS * 8 * 4);
constexpr size_t WS_TILEE = WS_CNT + al4k((size_t)256 * 64 * 4);
constexpr size_t WS_TOK = WS_TILEE + al4k((size_t)(MAXTILES + 8) * 4);
constexpr size_t WS_MOE_END = WS_TOK + al4k((size_t)PROWS * 4);
constexpr size_t WS_WBRA8 = WS_W13 + al4k((size_t)65 * 1024 * 2048), WS_WBRB8 = WS_WBRA8 + al4k((size_t)2048 * 1024), WS_WOUT8 = WS_WBRB8 + al4k((size_t)2048 * 2048);
static_assert(WS_WOUT8 + (size_t)2048 * 2048 <= WS_W2, "fp8 weight copies");
constexpr size_t WS_ATT8 = WS_H + al4k((size_t)RROWS * DM * 2), WS_HM8 = WS_ATT8 + al4k((size_t)NREAL * 1024);
static_assert(WS_HM8 + (size_t)NREAL * 2048 <= WS_HB, "fp8 activations");
constexpr size_t WS_Y8 = WS_HRAW;
constexpr size_t WS_END = WS_MIX_END > WS_MOE_END ? WS_MIX_END : WS_MOE_END;
static_assert(WS_END < ((size_t)2000 << 20), "workspace budget");

constexpr int RING_BYTES = 131072, MISC_OFF = 135168, EPI_OFF = MISC_OFF + 512, EPI_SLAB = 16 * 144, MAIL_OFF = EPI_OFF + 8 * EPI_SLAB, TILET_OFF = MAIL_OFF + 8 * 256, LDS_BYTES = 159744;
static_assert(TILET_OFF + (MAXTILES + 8) * 4 <= LDS_BYTES, "LDS map");

DI int lane_id() { int l; asm volatile("v_mbcnt_lo_u32_b32 %0, -1, 0\n\tv_mbcnt_hi_u32_b32 %0, -1, %0" : "=v"(l)); return l; }
DI unsigned pk2(float a, float b) { f32x2 v = {a, b}; bf16x2v r = __builtin_convertvector(v, bf16x2v); return __builtin_bit_cast(unsigned, r); }
DI float bf2f(unsigned short u) { return __uint_as_float(((unsigned)u) << 16); }
DI float bflo(unsigned u) { return __uint_as_float(u << 16); }
DI float bfhi(unsigned u) { return __uint_as_float(u & 0xffff0000u); }
template <int CTRL, int ROWMASK = 0xF, bool BC = true> DI float dpp_mov(float old, float x) { return __builtin_bit_cast(float, __builtin_amdgcn_update_dpp(__builtin_bit_cast(int, old), __builtin_bit_cast(int, x), CTRL, ROWMASK, 0xF, BC)); }
DI float rlane(float x, int k) { return __builtin_bit_cast(float, __builtin_amdgcn_readlane(__builtin_bit_cast(int, x), k)); }
DI float grp8_sum(float v) { v += dpp_mov<0xB1>(0.f, v); v += dpp_mov<0x4E>(0.f, v); v += dpp_mov<0x141>(0.f, v); return v; }
DI float grp8_max(float v) { v = fmaxf(v, dpp_mov<0xB1>(v, v)); v = fmaxf(v, dpp_mov<0x4E>(v, v)); v = fmaxf(v, dpp_mov<0x141>(v, v)); return v; }
DI float wave_sum(float v) { v = grp8_sum(v); v += dpp_mov<0x140>(0.f, v); return (rlane(v, 0) + rlane(v, 16)) + (rlane(v, 32) + rlane(v, 48)); }
DI float wave_max(float v) { v = grp8_max(v); v = fmaxf(v, dpp_mov<0x140>(v, v)); return fmaxf(fmaxf(rlane(v, 0), rlane(v, 16)), fmaxf(rlane(v, 32), rlane(v, 48))); }
DI float wave_scan_sum(float x) {
    x += dpp_mov<0x111, 0xF, false>(0.f, x); x += dpp_mov<0x112, 0xF, false>(0.f, x); x += dpp_mov<0x114, 0xF, false>(0.f, x); x += dpp_mov<0x118, 0xF, false>(0.f, x);
    x += dpp_mov<0x142, 0xA, false>(0.f, x); x += dpp_mov<0x143, 0xC, false>(0.f, x); return x; }
DI float wave_scan_max(float x) { const float ninf = -__builtin_inff();
    x = fmaxf(x, dpp_mov<0x111, 0xF, false>(ninf, x)); x = fmaxf(x, dpp_mov<0x112, 0xF, false>(ninf, x)); x = fmaxf(x, dpp_mov<0x114, 0xF, false>(ninf, x)); x = fmaxf(x, dpp_mov<0x118, 0xF, false>(ninf, x));
    x = fmaxf(x, dpp_mov<0x142, 0xA, false>(ninf, x)); x = fmaxf(x, dpp_mov<0x143, 0xC, false>(ninf, x)); return x; }
DI float sigmoidf_(float x) { return __builtin_amdgcn_rcpf(1.f + __builtin_amdgcn_exp2f(-1.44269504f * x)); }
#define LDS_WAIT() asm volatile("s_waitcnt lgkmcnt(0)" ::: "memory")
#define VM_WAIT() asm volatile("s_waitcnt vmcnt(0)" ::: "memory")

#define XB_TMO      128
#define XB_XCNT(j)  (256  + 64 * (j))
#define XB_XSUB(j)  (1280 + 64 * (j))
#define XB_XGEN(j)  (2304 + 64 * (j))
#define XB_TOP      3328
#define XB_TOPGEN   3392
#define XCD_BAR_WORDS 3456
#define XB_SPIN_CAP (1u << 18)
DI unsigned xb_ld(unsigned* p)              { return __hip_atomic_load(p, __ATOMIC_RELAXED, __HIP_MEMORY_SCOPE_AGENT); }
DI unsigned xb_add(unsigned* p, unsigned v) { return __hip_atomic_fetch_add(p, v, __ATOMIC_RELAXED, __HIP_MEMORY_SCOPE_AGENT); }
DI unsigned xb_xcc_id() { return (unsigned)__builtin_amdgcn_s_getreg((3 << 11) | 20) & 0xFu; }
#define XB_SPIN(cond, bar) do { unsigned _sp = 0; while (cond) { __builtin_amdgcn_s_sleep(1); \
    if ((++_sp & 255u) == 0u) { if (xb_ld(&(bar)[XB_TMO])) break; if (_sp > XB_SPIN_CAP) { atomicAdd(&(bar)[XB_TMO], 1u); break; } } } } while (0)
struct XcdBarrier { unsigned* bar; unsigned x; volatile LAS unsigned* st; };
DI XcdBarrier xcd_barrier_post(unsigned* bar, volatile LAS unsigned* st) {
    XcdBarrier b; b.bar = bar; b.x = xb_xcc_id(); b.st = st;
    if (threadIdx.x == 0) (void)xb_add(&bar[XB_XCNT(b.x)], 1u);
    return b;
}
DI void xcd_barrier_complete(unsigned* bar, unsigned x, unsigned& nloc, unsigned& nx) {
    const unsigned G = gridDim.x * gridDim.y * gridDim.z;
    unsigned sum, cnt, mine, sp = 0u;
    for (;;) {
        sum = 0u; cnt = 0u; mine = 0u;
#pragma unroll
        for (unsigned j = 0; j < 16; ++j) { const unsigned c = xb_ld(&bar[XB_XCNT(j)]); sum += c; cnt += (c > 0u) ? 1u : 0u; mine = (j == x) ? c : mine; }
        if (sum == G) break;
        __builtin_amdgcn_s_sleep(1);
        if ((++sp & 255u) == 0u) { if (xb_ld(&bar[XB_TMO])) break; if (sp > XB_SPIN_CAP) { atomicAdd(&bar[XB_TMO], 1u); break; } }
    }
    nloc = mine > 0u ? mine : 1u; nx = cnt > 0u ? cnt : 1u;
}
DI void xcd_barrier(const XcdBarrier& b, const bool thread0) {
    asm volatile("s_waitcnt vmcnt(0)" ::: "memory");
    __syncthreads();
    if (thread0) {
        unsigned* bar = b.bar;
        __builtin_amdgcn_s_waitcnt(0);
        unsigned nloc = b.st[0], nx = b.st[1];
        if (nloc == 0u) { xcd_barrier_complete(bar, b.x, nloc, nx); b.st[0] = nloc; b.st[1] = nx; }
        const unsigned old = xb_add(&bar[XB_XSUB(b.x)], 1u);
        const unsigned gen = old / nloc;
        if (old + 1u == (gen + 1u) * nloc) {
            __builtin_amdgcn_fence(__ATOMIC_RELEASE, "agent");
            asm volatile("s_waitcnt vmcnt(0)" ::: "memory");
            const unsigned og = xb_add(&bar[XB_TOP], 1u);
            const unsigned tg = og / nx;
            if (og + 1u == (tg + 1u) * nx) xb_add(&bar[XB_TOPGEN], 1u);
            else XB_SPIN(xb_ld(&bar[XB_TOPGEN]) == tg, bar);
            __builtin_amdgcn_fence(__ATOMIC_ACQUIRE, "agent");
            xb_add(&bar[XB_XGEN(b.x)], 1u);
            asm volatile("s_waitcnt vmcnt(0)" ::: "memory");
        } else {
            XB_SPIN(xb_ld(&bar[XB_XGEN(b.x)]) == gen, bar);
            __builtin_amdgcn_fence(__ATOMIC_ACQUIRE, "agent");
            asm volatile("s_waitcnt vmcnt(0)" ::: "memory");
        }
    }
    __syncthreads();
}

namespace pg8 {
constexpr int BM = 256, BK = 64, HALF = 128, HTB = HALF * BK * 2, STAGE_BYTES = 8 * HTB, NXCD = 8, WGM = 8;
__host__ __device__ __forceinline__ int lds_byte(int r, int c) { const int st = (r >> 4) * 2 + (c >> 5), rr = r & 15, cc = c & 31, ob = rr * 64 + cc * 2; return st * 1024 + (ob ^ (((ob >> 9) & 1) << 5)); }
__host__ __device__ __forceinline__ void stage_rc(int b, int& R, int& C) { const int st = b / 1024, sb = b % 1024, swz = sb ^ (((sb >> 9) & 1) << 5); R = (st >> 1) * 16 + swz / 64; C = (st & 1) * 32 + (swz % 64) / 2; }
__host__ __device__ __forceinline__ int perm32(int rho) { const int n = rho >> 4, i = rho & 15; return 8 * (i >> 2) + 4 * n + (i & 3); }
struct Unit { int pm, pn; unsigned ua, ub; };
typedef f32x4 Acc[2][2][4][2];
typedef f32x16 Acc32[2][2][2];

DI int xcd_remap(int L, int n) { const int q = n / NXCD, r = n % NXCD, xcd = L % NXCD, off = L / NXCD; return (xcd < r ? xcd * (q + 1) : r * (q + 1) + (xcd - r) * q) + off; }

template <int ldaB, int ldbB, int nM, int nN> struct StaticOrder {
    static constexpr int nwg = nM * nN; const char* A; const char* B; int G, c;
    DI void init(const void* A_, const void* B_, int G_, int c_) { A = (const char*)A_; B = (const char*)B_; G = G_; c = c_; }
    DI bool next(int i, Unit& u) const {
        const int L = i * G + c; if (L >= nwg) return false;
        const int wgid = xcd_remap(L, nwg);
        const int nig = WGM * nN, gid = wgid / nig, fm = gid * WGM, gsz = (nM - fm) < WGM ? (nM - fm) : WGM;
        u.pm = fm + ((wgid % nig) % gsz); u.pn = (wgid % nig) / gsz;
        u.ua = (unsigned)u.pm * (unsigned)(256 * ldaB); u.ub = (unsigned)u.pn * (unsigned)(256 * ldbB); return true;
    }
};

typedef int v8i32 __attribute__((ext_vector_type(8)));
typedef float f32x8 __attribute__((ext_vector_type(8)));
template <int ldaB, int ldbB, int KB, bool GATHER = false, bool FP8 = false, int SCA = 127, int SCB = 127, class Epi, class Sched>
DI void gemm_phase(LAS unsigned char* lds, const int tid, const Sched& S, const Epi& E) {
    const int wid = __builtin_amdgcn_readfirstlane(tid >> 6), lane = tid & 63, wr = wid >> 2, wc = wid & 3, fr = lane & 15, fq = lane >> 4;
    constexpr int nt = KB / 128;
    unsigned voffA[2], voffB[2]; int stR[2], stC = 0;
#pragma unroll
    for (int i = 0; i < 2; ++i) { int R, C; stage_rc(tid * 16 + i * 8192, R, C); const int rho = R & 31; const int Rb = 64 * (R >> 5) + (FP8 ? 16 * ((rho >> 2) & 1) + 4 * (rho >> 3) + (rho & 3) : perm32(rho));
        const int Cs = (FP8 && (R & 16)) ? (C ^ 8) : C;
        voffA[i] = (unsigned)(R * ldaB + Cs * 2); voffB[i] = (unsigned)(Rb * ldbB + Cs * 2); stR[i] = R; stC = Cs; }
    constexpr size_t kstep = (size_t)(BK * 2);
    constexpr size_t hstA = (size_t)HALF * ldaB, hstB = (size_t)32 * ldbB;
    const unsigned ldsw = (unsigned)wid * 1024u;
    const int l31 = lane & 31, hh = lane >> 5;
    const int aoff0 = FP8 ? lds_byte(wr * 64 + l31, hh * 16) : lds_byte(wr * 64 + fr, fq * 8);
    const int boff0 = FP8 ? lds_byte(wc * 32 + l31, hh * 16) : lds_byte(wc * 32 + fr, fq * 8);
    const int sw16 = (l31 & 16) ? 16 : 0, aoffL = aoff0 + sw16, aoffH = aoff0 + 16 - sw16, boffL = boff0 + sw16, boffH = boff0 + 16 - sw16;
#define PG8_SA(b, h) (((b) * 2 + (h)) * HTB)
#define PG8_SB(b, h) ((4 + (b) * 2 + (h)) * HTB)
#define PG8_STAGE(bufoff, gbase, uoff, voff) do { _Pragma("unroll") for (int _i = 0; _i < 2; ++_i) \
        __builtin_amdgcn_global_load_lds((const unsigned*)((gbase) + (unsigned)((voff)[_i] + (unsigned)(uoff))), (LAS unsigned*)(lds + (bufoff) + ldsw + _i * 8192), 16, 0, 0); } while (0)
#define PG8_STAGE1(bufoff, gbase, uoff, voff0, step) do { _Pragma("unroll") for (int _i = 0; _i < 2; ++_i) \
        __builtin_amdgcn_global_load_lds((const unsigned*)((gbase) + (unsigned)((voff0) + (unsigned)(uoff) + (unsigned)(_i * (step)))), (LAS unsigned*)(lds + (bufoff) + ldsw + _i * 8192), 16, 0, 0); } while (0)
#define PG8_STAGE_A(bufoff, h, nx, kb) do { if constexpr (GATHER) { unsigned _o[2]; _o[0] = (nx) ? on[h][0] : oc[h][0]; _o[1] = (nx) ? on[h][1] : oc[h][1]; PG8_STAGE(bufoff, gA, (kb), _o); } \
        else { PG8_STAGE1(bufoff, gA, ((nx) ? nA : cA) + (unsigned)(kb) + (unsigned)((h) ? hstA : 0), voffA[0], 64 * ldaB); } } while (0)
typedef int v16i32_ __attribute__((ext_vector_type(16)));
#define PG8_LD8(p0, p1) __builtin_bit_cast(v8i32, __builtin_shufflevector(*(const LAS u32x4*)(p0), *(const LAS u32x4*)(p1), 0, 1, 2, 3, 4, 5, 6, 7))
#define PG8_CAT16(a, b) __builtin_shufflevector((a), (b), 0, 1, 2, 3, 4, 5, 6, 7, 8, 9, 10, 11, 12, 13, 14, 15)
#define PG8_LDA(dst, b, h) do { _Pragma("unroll") for (int mm = 0; mm < 2; ++mm) { if constexpr (FP8) dst[mm] = PG8_CAT16(PG8_LD8(lds + PG8_SA(b, h) + aoffL + mm * 4096, lds + PG8_SA(b, h) + aoffH + mm * 4096), PG8_LD8(lds + PG8_SA(b, h) + aoffL + mm * 4096 + 1024, lds + PG8_SA(b, h) + aoffH + mm * 4096 + 1024)); \
        else dst[mm] = PG8_CAT16(PG8_LD8(lds + PG8_SA(b, h) + aoff0 + (2 * mm) * 2048, lds + PG8_SA(b, h) + aoff0 + 1024 + (2 * mm) * 2048), PG8_LD8(lds + PG8_SA(b, h) + aoff0 + (2 * mm + 1) * 2048, lds + PG8_SA(b, h) + aoff0 + 1024 + (2 * mm + 1) * 2048)); } } while (0)
#define PG8_LDB(dst, b, h) do { if constexpr (FP8) dst = PG8_CAT16(PG8_LD8(lds + PG8_SB(b, h) + boffL, lds + PG8_SB(b, h) + boffH), PG8_LD8(lds + PG8_SB(b, h) + boffL + 1024, lds + PG8_SB(b, h) + boffH + 1024)); \
        else dst = PG8_CAT16(PG8_LD8(lds + PG8_SB(b, h) + boff0, lds + PG8_SB(b, h) + boff0 + 1024), PG8_LD8(lds + PG8_SB(b, h) + boff0 + 2048, lds + PG8_SB(b, h) + boff0 + 1024 + 2048)); } while (0)
#define PG8_H8(x, i) ((i) == 0 ? __builtin_shufflevector((x), (x), 0, 1, 2, 3, 4, 5, 6, 7) : __builtin_shufflevector((x), (x), 8, 9, 10, 11, 12, 13, 14, 15))
#define PG8_LO(x) __builtin_bit_cast(bf16x8, __builtin_shufflevector((x), (x), 0, 1, 2, 3))
#define PG8_HI(x) __builtin_bit_cast(bf16x8, __builtin_shufflevector((x), (x), 4, 5, 6, 7))
#define PG8_MMA(ai, bj, At, Bt) do { __builtin_amdgcn_s_setprio(1); \
        if constexpr (FP8) { _Pragma("unroll") for (int mi = 0; mi < 2; ++mi) _Pragma("unroll") for (int ks = 0; ks < 2; ++ks) \
            acc32[ai][bj][mi] = __builtin_amdgcn_mfma_scale_f32_32x32x64_f8f6f4(PG8_H8(Bt, ks), PG8_H8(At[mi], ks), acc32[ai][bj][mi], 0, 0, 0, (int)((unsigned)SCB * 0x01010101u), 0, (int)((unsigned)SCA * 0x01010101u)); } \
        else { _Pragma("unroll") for (int m = 0; m < 4; ++m) _Pragma("unroll") for (int n = 0; n < 2; ++n) { const v8i32 a8_ = PG8_H8(At[m >> 1], m & 1), b8_ = PG8_H8(Bt, n); \
               acc[ai][bj][m][n] = __builtin_amdgcn_mfma_f32_16x16x32_bf16(PG8_LO(b8_), PG8_LO(a8_), acc[ai][bj][m][n], 0, 0, 0); \
               acc[ai][bj][m][n] = __builtin_amdgcn_mfma_f32_16x16x32_bf16(PG8_HI(b8_), PG8_HI(a8_), acc[ai][bj][m][n], 0, 0, 0); } } \
        __builtin_amdgcn_s_setprio(0); } while (0)
#define PG8_WAIT_V(n) asm volatile("s_waitcnt vmcnt(" #n ")" ::: "memory")
#define PG8_WAIT_L(n) asm volatile("s_waitcnt lgkmcnt(" #n ")" ::: "memory")
#define PG8_BAR __builtin_amdgcn_s_barrier()
#define PG8_SCHED __builtin_amdgcn_sched_barrier(0)
    Unit cur, nxt; int ui = 0;
    if (!S.next(0, cur)) return;
    f32x4 acc[2][2][4][2]; f32x16 acc32[2][2][2];
#define PG8_ZERO_ACC() do { if constexpr (FP8) { _Pragma("unroll") for (int a = 0; a < 2; ++a) _Pragma("unroll") for (int b = 0; b < 2; ++b) _Pragma("unroll") for (int m = 0; m < 2; ++m) _Pragma("unroll") for (int i = 0; i < 16; ++i) acc32[a][b][m][i] = 0.f; } \
        else { _Pragma("unroll") for (int a = 0; a < 2; ++a) _Pragma("unroll") for (int b = 0; b < 2; ++b) _Pragma("unroll") for (int m = 0; m < 4; ++m) _Pragma("unroll") for (int n = 0; n < 2; ++n) acc[a][b][m][n] = (f32x4){0.f, 0.f, 0.f, 0.f}; } } while (0)
    PG8_ZERO_ACC();
    v16i32_ At[2], B0, B1;
    const char* gA = S.A; const char* gB = S.B;
    unsigned cA = cur.ua, cB = cur.ub, nA = cA;
    unsigned oc[2][2], on[2][2];
    if constexpr (GATHER) {
#pragma unroll
        for (int h = 0; h < 2; ++h)
#pragma unroll
            for (int i = 0; i < 2; ++i) { oc[h][i] = (unsigned)S.tok(cur, h * HALF + stR[i]) * (unsigned)ldaB + (unsigned)(stC * 2); on[h][i] = oc[h][i]; }
    }
    PG8_STAGE1(PG8_SB(0, 0), gB, cB, voffB[0], 128 * ldbB); PG8_STAGE1(PG8_SB(0, 1), gB, cB + (unsigned)hstB, voffB[0], 128 * ldbB); PG8_STAGE_A(PG8_SA(0, 0), 0, false, 0); PG8_STAGE_A(PG8_SA(0, 1), 1, false, 0);
    if (wr == 1) PG8_BAR;
    PG8_WAIT_V(2); PG8_BAR;
    PG8_STAGE1(PG8_SB(1, 0), gB, cB + (unsigned)kstep, voffB[0], 128 * ldbB); PG8_STAGE_A(PG8_SA(1, 0), 0, false, kstep); PG8_STAGE1(PG8_SB(1, 1), gB, cB + (unsigned)(hstB + kstep), voffB[0], 128 * ldbB);
    PG8_WAIT_V(6); PG8_BAR;
    for (;;) {
        const bool has_next = S.next(ui + 1, nxt);
        nA = has_next ? nxt.ua : cA; const unsigned nB = has_next ? nxt.ub : cB;
        if constexpr (GATHER) { if (!has_next) {
#pragma unroll
            for (int h = 0; h < 2; ++h)
#pragma unroll
                for (int i = 0; i < 2; ++i) on[h][i] = oc[h][i]; } }
        if constexpr (GATHER) { if (has_next) { const int* tp = S.tokp(nxt) + 16 * (wid >> 1) + (lane & 15);
            if (lane < 16) {
#pragma unroll
                for (int h = 0; h < 2; ++h)
#pragma unroll
                    for (int i = 0; i < 2; ++i) __builtin_amdgcn_global_load_lds((const unsigned*)(tp + h * HALF + i * 64), (LAS unsigned*)(lds + MAIL_OFF + wid * 256 + (h * 2 + i) * 64), 4, 0, 0); } } }
#pragma unroll 1
        for (int t = 0; t < nt; t += 2) {
            const bool last = (t == nt - 2);
            if constexpr (GATHER) { if (last && has_next) {
#pragma unroll
                for (int h = 0; h < 2; ++h)
#pragma unroll
                    for (int i = 0; i < 2; ++i) on[h][i] = *(const volatile LAS unsigned*)(lds + MAIL_OFF + wid * 256 + (h * 2 + i) * 64 + (lane >> 2) * 4) * (unsigned)ldaB + (unsigned)(stC * 2); } }
            const unsigned k1 = (unsigned)(t + 1) * (unsigned)kstep, k2 = last ? 0u : (unsigned)(t + 2) * (unsigned)kstep, k3 = k2 + (unsigned)kstep;
            const unsigned b2 = last ? nB : cB + (unsigned)(t + 2) * (unsigned)kstep, b3 = b2 + (unsigned)kstep;
            PG8_LDB(B0, 0, 0); PG8_LDB(B1, 0, 1); PG8_SCHED; PG8_LDA(At, 0, 0); PG8_STAGE_A(PG8_SA(1, 1), 1, false, k1);
            PG8_WAIT_V(8); PG8_WAIT_L(0); PG8_BAR; PG8_MMA(0, 0, At, B0); PG8_MMA(0, 1, At, B1); PG8_BAR; PG8_SCHED;
            PG8_LDA(At, 0, 1); PG8_STAGE1(PG8_SB(0, 0), gB, b2, voffB[0], 128 * ldbB); PG8_STAGE1(PG8_SB(0, 1), gB, b2 + (unsigned)hstB, voffB[0], 128 * ldbB); PG8_STAGE_A(PG8_SA(0, 0), 0, last, k2);
            PG8_WAIT_V(8); PG8_WAIT_L(0); PG8_BAR; PG8_MMA(1, 0, At, B0); PG8_MMA(1, 1, At, B1); PG8_BAR; PG8_SCHED;
            PG8_LDB(B0, 1, 0); PG8_LDB(B1, 1, 1); PG8_SCHED; PG8_LDA(At, 1, 0); PG8_STAGE_A(PG8_SA(0, 1), 1, last, k2);
            PG8_WAIT_V(8); PG8_WAIT_L(0); PG8_BAR; PG8_MMA(0, 0, At, B0); PG8_MMA(0, 1, At, B1); PG8_BAR; PG8_SCHED;
            PG8_LDA(At, 1, 1); PG8_STAGE1(PG8_SB(1, 0), gB, b3, voffB[0], 128 * ldbB); PG8_STAGE1(PG8_SB(1, 1), gB, b3 + (unsigned)hstB, voffB[0], 128 * ldbB); PG8_STAGE_A(PG8_SA(1, 0), 0, last, k3);
            PG8_WAIT_V(8); PG8_WAIT_L(0); PG8_BAR; PG8_MMA(1, 0, At, B0); PG8_MMA(1, 1, At, B1); PG8_BAR; PG8_SCHED;
        }
        if (wr == 0) PG8_BAR;
        { int t2 = lane_id(); asm volatile("" : "+v"(t2)); if constexpr (FP8) E(acc32, cur, wr, wc, t2 & 31, t2 >> 5); else E(acc, cur, wr, wc, t2 & 15, t2 >> 4); }
        if (!has_next) break;
        PG8_ZERO_ACC();
        cur = nxt; cA = nA; cB = nB; ++ui;
        if constexpr (GATHER) {
#pragma unroll
            for (int h = 0; h < 2; ++h)
#pragma unroll
                for (int i = 0; i < 2; ++i) oc[h][i] = on[h][i]; }
        if (wr == 1) PG8_BAR;
    }
    PG8_WAIT_V(0);
    PG8_BAR;
#undef PG8_SA
#undef PG8_SB
#undef PG8_STAGE
#undef PG8_STAGE_A
#undef PG8_LDA
#undef PG8_LDB
#undef PG8_MMA
#undef PG8_LD8
#undef PG8_LO
#undef PG8_HI
#undef PG8_CAT16
#undef PG8_H8
#undef PG8_ZERO_ACC
#undef PG8_WAIT_V
#undef PG8_WAIT_L
#undef PG8_BAR
#undef PG8_SCHED
}
}
using pg8::Unit;
using pg8::Acc;

struct Params { const float* in[28]; float* out; unsigned char* ws; int ph_lo, ph_hi; };
enum { I_X = 0, I_META, I_LNIN_G, I_LNIN_B, I_WIN, I_BIN, I_QNG, I_KVNG, I_WUQ, I_WUKV, I_CONVW, I_CONVB, I_MLNG, I_WBRA, I_WBRB, I_WOUT, I_LN1G, I_LN1B, I_WROUTER, I_EBIAS, I_W1, I_W3, I_W2, I_WS1, I_WS3, I_WS2, I_LN2G, I_LN2B };

typedef const __attribute__((address_space(4))) Params* PK;
DI PK kargs() { PK p = (PK)__builtin_amdgcn_kernarg_segment_ptr(); asm volatile("" : "+s"(p)); return p; }
struct Frame {
    LAS unsigned char* lds; int tid, lane, wave, vcu, G; unsigned char* ws; unsigned* ctl;
};

DI int rowmap_in(int n) {
        if (n < 1024) return n;
        if (n < 1088) return ZC_S + (n - 1024);
        if (n < 7232) return n - 64;
        if (n < 7248) return ZC_S + 64 + (n - 7232);
        return n - 80;
}
DI int rowmap(int mode, int n) {
    switch (mode) {
    case 1: return rowmap_in(n);
    case 99: {
        if (n < 1024) return n;
        if (n < 1088) return ZC_S + (n - 1024);
        if (n < 7232) return n - 64;
        if (n < 7248) return ZC_S + 64 + (n - 7232);
        return n - 80;
    }
    case 5: { const int r = rowmap_in(n); return (r >= ZC_F8 && r < ZC_S) ? r - ZC_F8 : -1; }
    case 2: { const int h = n >> 8, j = n & 255; return j < 128 ? h * 128 + j : 1024 + h * 128 + (j - 128); }
    case 3: return (n >> 7) * 256 + ((n >> 5) & 3) * 64 + (n & 31);
    case 4: return (n >> 7) * 256 + ((n >> 5) & 3) * 64 + 32 + (n & 31);
    default: return n;
    }
}
constexpr int CV_STRIDE = 65, CV_WAVE_BYTES = 64 * CV_STRIDE * 4;
DI void conv_load(f32x4 (&v)[16], const float* W, int K, int N, int item, int lane, bool real = true) {
    const int nblk = (N + 63) / 64, kb = item / nblk, nb = item % nblk, k0 = 64 * kb, n0 = 64 * nb;
    const int nc = n0 + 4 * (lane & 15); const bool okc = nc < N;
    const int ncl = okc ? nc : 0;
#pragma unroll
    for (int i = 0; i < 16; ++i) { const int kk = 4 * i + (lane >> 4); v[i] = __builtin_nontemporal_load((const f32x4*)(W + (real ? (size_t)(k0 + kk) * N + ncl : (size_t)0))); }
}
template <bool F8> DI void conv_finish(const f32x4 (&v)[16], int K, int N, bf16* WT, int mode, const float* kscale, float sc, LAS float* scr, int item, int lane, unsigned char* WT8 = nullptr) {
    const int nblk = (N + 63) / 64, kb = item / nblk, nb = item % nblk, k0 = 64 * kb, n0 = 64 * nb;
    const bool okc = n0 + 4 * (lane & 15) < N;
#pragma unroll
    for (int i = 0; i < 16; ++i) { const int kk = 4 * i + (lane >> 4); LAS float* d = scr + kk * CV_STRIDE + 4 * (lane & 15); d[0] = okc ? v[i][0] : 0.f; d[1] = okc ? v[i][1] : 0.f; d[2] = okc ? v[i][2] : 0.f; d[3] = okc ? v[i][3] : 0.f; }
    LDS_WAIT(); asm volatile("" ::: "memory");
    const int c = lane & 7;
    float ks[8];
#pragma unroll
    for (int q = 0; q < 8; ++q) ks[q] = kscale ? kscale[k0 + 8 * c + q] * sc : sc;
#pragma unroll
    for (int j = 0; j < 8; ++j) { const int n = (lane >> 3) + 8 * j; const LAS float* s = scr + (8 * c) * CV_STRIDE + n;
        if (F8) { u32x2 o8; int w0 = 0, w1 = 0;
            w0 = __builtin_amdgcn_cvt_pk_fp8_f32(s[0 * CV_STRIDE] * ks[0], s[1 * CV_STRIDE] * ks[1], w0, false); w0 = __builtin_amdgcn_cvt_pk_fp8_f32(s[2 * CV_STRIDE] * ks[2], s[3 * CV_STRIDE] * ks[3], w0, true);
            w1 = __builtin_amdgcn_cvt_pk_fp8_f32(s[4 * CV_STRIDE] * ks[4], s[5 * CV_STRIDE] * ks[5], w1, false); w1 = __builtin_amdgcn_cvt_pk_fp8_f32(s[6 * CV_STRIDE] * ks[6], s[7 * CV_STRIDE] * ks[7], w1, true);
            o8.x = (unsigned)w0; o8.y = (unsigned)w1;
            const int rw = (n0 + n < N) ? rowmap(mode, n0 + n) : -1;
            if (rw >= 0) *(u32x2*)((unsigned char*)WT + (size_t)rw * K + k0 + 8 * c) = o8; }
        else { u32x4 o; o.x = pk2(s[0 * CV_STRIDE] * ks[0], s[1 * CV_STRIDE] * ks[1]); o.y = pk2(s[2 * CV_STRIDE] * ks[2], s[3 * CV_STRIDE] * ks[3]); o.z = pk2(s[4 * CV_STRIDE] * ks[4], s[5 * CV_STRIDE] * ks[5]); o.w = pk2(s[6 * CV_STRIDE] * ks[6], s[7 * CV_STRIDE] * ks[7]);
            if (n0 + n < N) *(u32x4*)(WT + (size_t)rowmap(mode, n0 + n) * K + k0 + 8 * c) = o;
            if (WT8) { int w0 = 0, w1 = 0;
                w0 = __builtin_amdgcn_cvt_pk_fp8_f32(s[0 * CV_STRIDE] * 64.f, s[1 * CV_STRIDE] * 64.f, w0, false); w0 = __builtin_amdgcn_cvt_pk_fp8_f32(s[2 * CV_STRIDE] * 64.f, s[3 * CV_STRIDE] * 64.f, w0, true);
                w1 = __builtin_amdgcn_cvt_pk_fp8_f32(s[4 * CV_STRIDE] * 64.f, s[5 * CV_STRIDE] * 64.f, w1, false); w1 = __builtin_amdgcn_cvt_pk_fp8_f32(s[6 * CV_STRIDE] * 64.f, s[7 * CV_STRIDE] * 64.f, w1, true);
                if (n0 + n < N) *(u32x2*)(WT8 + (size_t)(n0 + n) * K + k0 + 8 * c) = (u32x2){(unsigned)w0, (unsigned)w1}; } } }
    LDS_WAIT(); asm volatile("" ::: "memory");
}
template <bool F8 = false> DI void conv_matrix(const Frame& F, const float* W, int K, int N, bf16* WT, int mode, const float* kscale, float sc, int nsub, size_t sstride, size_t dstride, int& rot, int nb0 = 0, int nbe = -1, unsigned char* WT8 = nullptr) {
    LAS float* scr = (LAS float*)(F.lds + F.wave * CV_WAVE_BYTES);
    const int NGW = F.G * NW; int gw = F.vcu * NW + F.wave - rot; if (gw < 0) gw += NGW;
    const int nblk = (N + 63) / 64, nb1 = (nbe < 0 ? nblk : nbe) - nb0, per = (K / 64) * nb1, total = per * nsub;
    rot = (rot + total) % NGW;
#define CV_DECODE(it_, sub_, r_) const int sub_ = (it_) / per, r0_##r_ = (it_) - sub_ * per, r_ = (r0_##r_ / nb1) * nblk + nb0 + (r0_##r_ % nb1)
    f32x4 va[16], vb[16];
    int it = gw;
    if (it < total) { CV_DECODE(it, s0, r0); conv_load(va, W + (size_t)s0 * sstride, K, N, r0, F.lane); }
#pragma unroll 1
    for (; it < total; it += 2 * NGW) {
        CV_DECODE(it, sA, rA);
        const int itb = it + NGW, itc = it + 2 * NGW;
        { const int itq = itb < total ? itb : it; CV_DECODE(itq, sB, rB); conv_load(vb, W + (size_t)sB * sstride, K, N, rB, F.lane, itb < total); }
        conv_finish<F8>(va, K, N, F8 ? (bf16*)((unsigned char*)WT + (size_t)sA * dstride) : WT + (size_t)sA * dstride, mode, kscale, sc, scr, rA, F.lane, WT8);
        { const int itq = itc < total ? itc : it; CV_DECODE(itq, sC, rC); conv_load(va, W + (size_t)sC * sstride, K, N, rC, F.lane, itc < total); }
        if (itb < total) { CV_DECODE(itb, sB2, rB2); conv_finish<F8>(vb, K, N, F8 ? (bf16*)((unsigned char*)WT + (size_t)sB2 * dstride) : WT + (size_t)sB2 * dstride, mode, kscale, sc, scr, rB2, F.lane, WT8); }
    }
#undef CV_DECODE
}
#ifndef MOE_FP8
#define MOE_FP8 1
#endif
constexpr float W8SCALE = MOE_FP8 ? 64.f : 1.f;
constexpr float H8SCALE = MOE_FP8 ? 8.f : 1.f;
DI void convert_layer(const Frame& F, PK P, int l) {
    unsigned char* ws = F.ws; int rot = 0;
    conv_matrix(F, P->in[I_WIN] + (size_t)l * DM * INW, DM, INW, (bf16*)(ws + WS_WIN), 1, nullptr, 1.f, 1, 0, 0, rot, 0, (ZC_F8 + 64) / 64);
    conv_matrix(F, P->in[I_WIN] + (size_t)l * DM * INW, DM, INW, (bf16*)(ws + WS_WIN), 1, nullptr, 1.f, 1, 0, 0, rot, 113, 114);
    conv_matrix<true>(F, P->in[I_WIN] + (size_t)l * DM * INW, DM, INW, (bf16*)(ws + WS_WIN8), 5, nullptr, 64.f, 1, 0, 0, rot, (ZC_F8 + 64) / 64);
    conv_matrix(F, P->in[I_WUQ] + (size_t)l * 512 * 1536, 512, 1536, (bf16*)(ws + WS_WUQ), 0, P->in[I_QNG] + l * 512, QSCALE, 1, 0, 0, rot);
    conv_matrix(F, P->in[I_WUKV] + (size_t)l * 512 * 2048, 512, 2048, (bf16*)(ws + WS_WKV), 2, P->in[I_KVNG] + l * 512, 1.f, 1, 0, 0, rot);
    conv_matrix(F, P->in[I_WBRA] + (size_t)l * 1024 * 2048, 1024, 2048, (bf16*)(ws + WS_WBRA), 0, nullptr, 1.f, 1, 0, 0, rot, 0, -1, ws + WS_WBRA8);
    conv_matrix(F, P->in[I_WBRB] + (size_t)l * 2048 * 2048, 2048, 2048, (bf16*)(ws + WS_WBRB), 0, nullptr, 1.f, 1, 0, 0, rot, 0, -1, ws + WS_WBRB8);
    conv_matrix(F, P->in[I_WOUT] + (size_t)l * 2048 * 2048, 2048, 2048, (bf16*)(ws + WS_WOUT), 0, nullptr, 1.f, 1, 0, 0, rot, 0, -1, ws + WS_WOUT8);
    conv_matrix(F, P->in[I_WROUTER] + (size_t)l * 2048 * 64, 2048, 64, (bf16*)(ws + WS_WR), 0, nullptr, 1.f, 1, 0, 0, rot);
    conv_matrix<MOE_FP8 != 0>(F, P->in[I_W1] + (size_t)l * 64 * 2048 * 512, 2048, 512, (bf16*)(ws + WS_W13), 3, nullptr, W8SCALE, 64, (size_t)2048 * 512, (size_t)1024 * 2048, rot);
    conv_matrix<MOE_FP8 != 0>(F, P->in[I_W3] + (size_t)l * 64 * 2048 * 512, 2048, 512, (bf16*)(ws + WS_W13), 4, nullptr, W8SCALE, 64, (size_t)2048 * 512, (size_t)1024 * 2048, rot);
    conv_matrix<MOE_FP8 != 0>(F, P->in[I_W2] + (size_t)l * 64 * 512 * 2048, 512, 2048, (bf16*)(ws + WS_W2), 0, nullptr, W8SCALE, 64, (size_t)512 * 2048, (size_t)2048 * 512, rot);
    conv_matrix<MOE_FP8 != 0>(F, P->in[I_WS1] + (size_t)l * 2048 * 512, 2048, 512, (bf16*)((unsigned char*)(ws + WS_W13) + (size_t)64 * 1024 * 2048 * (MOE_FP8 ? 1 : 2)), 3, nullptr, W8SCALE, 1, 0, 0, rot);
    conv_matrix<MOE_FP8 != 0>(F, P->in[I_WS3] + (size_t)l * 2048 * 512, 2048, 512, (bf16*)((unsigned char*)(ws + WS_W13) + (size_t)64 * 1024 * 2048 * (MOE_FP8 ? 1 : 2)), 4, nullptr, W8SCALE, 1, 0, 0, rot);
    conv_matrix<MOE_FP8 != 0>(F, P->in[I_WS2] + (size_t)l * 512 * 2048, 512, 2048, (bf16*)((unsigned char*)(ws + WS_W2) + (size_t)64 * 2048 * 512 * (MOE_FP8 ? 1 : 2)), 0, nullptr, W8SCALE, 1, 0, 0, rot);
    float* br = (float*)(ws + WS_BIAS); const float* bi = P->in[I_BIN] + (size_t)l * INW;
    for (int i = (F.vcu * NT + F.tid); i < ZW; i += F.G * NT) {
        int n;
        if (i < 1024) n = i; else if (i < 7168) n = i + 64; else if (i < ZC_S) n = i + 80; else if (i < ZC_S + 64) n = 1024 + (i - ZC_S); else if (i < ZC_S + 80) n = 7232 + (i - ZC_S - 64); else n = -1;
        br[i] = n >= 0 ? bi[n] : 0.f; }
}

DI u32x4 pack8(const f32x4& a, const f32x4& b) { u32x4 w; w.x = pk2(a[0], a[1]); w.y = pk2(a[2], a[3]); w.z = pk2(b[0], b[1]); w.w = pk2(b[2], b[3]); return w; }
#define LNCOL(lane, j) (8 * ((lane) + 64 * (j)))
DI u32x2 pack8_fp8(const f32x4& a, const f32x4& b) { int w0 = 0, w1 = 0; w0 = __builtin_amdgcn_cvt_pk_fp8_f32(a[0], a[1], w0, false); w0 = __builtin_amdgcn_cvt_pk_fp8_f32(a[2], a[3], w0, true); w1 = __builtin_amdgcn_cvt_pk_fp8_f32(b[0], b[1], w1, false); w1 = __builtin_amdgcn_cvt_pk_fp8_f32(b[2], b[3], w1, true); return (u32x2){(unsigned)w0, (unsigned)w1}; }
DI void ln_store(f32x4 (&v)[8], const float* g, const float* b, bf16* hbrow, int lane, unsigned char* h8row = nullptr) {
    float s = 0.f;
#pragma unroll
    for (int j = 0; j < 8; ++j) s += (v[j].x + v[j].y) + (v[j].z + v[j].w);
    const float mean = wave_sum(s) * (1.f / DM); float s2 = 0.f;
#pragma unroll
    for (int j = 0; j < 8; ++j) { v[j] = v[j] - mean; s2 += (v[j].x * v[j].x + v[j].y * v[j].y) + (v[j].z * v[j].z + v[j].w * v[j].w); }
    const float rstd = 1.f / sqrtf(wave_sum(s2) * (1.f / DM) + LN_EPS);
#pragma unroll
    for (int j = 0; j < 4; ++j) { const int c = LNCOL(lane, j);
        const f32x4 o0 = v[2 * j] * rstd * *(const f32x4*)(g + c) + *(const f32x4*)(b + c), o1 = v[2 * j + 1] * rstd * *(const f32x4*)(g + c + 4) + *(const f32x4*)(b + c + 4);
        v[2 * j] = o0; v[2 * j + 1] = o1;
        *(u32x4*)(hbrow + c) = pack8(o0, o1);
        if (h8row) *(u32x2*)(h8row + c) = pack8_fp8(o0, o1); }
}

DI void fp8_selftest(const Frame& F);
DI void phase_prologue(const Frame& F, PK P) {
    unsigned char* ws = F.ws;
    float* rt = (float*)(ws + WS_ROPE);
    for (int i = F.vcu * NT + F.tid; i < TP * 32; i += F.G * NT) { const int t = i >> 5, f = i & 31;
        const float invf = 1.0f / powf(10000.0f, (float)(2 * f) * (1.0f / 64.0f)); const float ang = (float)t * invf; float sn, cs; sincosf(ang, &sn, &cs);
        rt[t * 64 + f] = cs; rt[t * 64 + 32 + f] = sn; }
    bf16* hb = (bf16*)(ws + WS_HB);
    const int gw = F.vcu * NW + F.wave, NGW = F.G * NW;
    { f32x4 nx[8]; const float* x = P->in[I_X];
      if (gw < NREAL) {
#pragma unroll
          for (int j = 0; j < 4; ++j) { const int c = LNCOL(F.lane, j); nx[2 * j] = *(const f32x4*)(x + (size_t)gw * DM + c); nx[2 * j + 1] = *(const f32x4*)(x + (size_t)gw * DM + c + 4); } }
      for (int r = gw; r < NREAL; r += NGW) { f32x4 v[8];
#pragma unroll
          for (int j = 0; j < 8; ++j) v[j] = nx[j];
          if (r + NGW < NREAL) {
#pragma unroll
              for (int j = 0; j < 4; ++j) { const int c = LNCOL(F.lane, j); nx[2 * j] = *(const f32x4*)(x + (size_t)(r + NGW) * DM + c); nx[2 * j + 1] = *(const f32x4*)(x + (size_t)(r + NGW) * DM + c + 4); } }
          ln_store(v, P->in[I_LNIN_G], P->in[I_LNIN_B], hb + (size_t)r * DM, F.lane, ws + WS_HB8 + (size_t)r * DM); } }
    for (int r = NREAL + gw; r < RROWS; r += NGW) { f32x4 v[8];
        const float* src;
        { const int pp = (r - NREAL) & 63;
            if (pp < PADL) {
#pragma unroll
                for (int j = 0; j < 4; ++j) { const int c = LNCOL(F.lane, j); *(u32x4*)(hb + (size_t)r * DM + c) = (u32x4){0u, 0u, 0u, 0u}; *(u32x2*)(ws + WS_HB8 + (size_t)r * DM + c) = (u32x2){0u, 0u}; }
                continue; }
            src = P->in[I_META] + (size_t)(pp - PADL) * DM; }
#pragma unroll
        for (int j = 0; j < 4; ++j) { const int c = LNCOL(F.lane, j); v[2 * j] = *(const f32x4*)(src + c); v[2 * j + 1] = *(const f32x4*)(src + c + 4); }
        ln_store(v, P->in[I_LNIN_G], P->in[I_LNIN_B], hb + (size_t)r * DM, F.lane, ws + WS_HB8 + (size_t)r * DM); }
    convert_layer(F, P, 0);
    fp8_selftest(F);
}

#define EPI_ROWS(ai, m) (u.pm * 256 + (ai) * 128 + wr * 64 + (m) * 16 + fr)
#define EPI_COL0 (wc * 64 + 8 * fq)
DI void unpack8(const u32x4& w, f32x4& a, f32x4& b) { a = (f32x4){bflo(w.x), bfhi(w.x), bflo(w.y), bfhi(w.y)}; b = (f32x4){bflo(w.z), bfhi(w.z), bflo(w.w), bfhi(w.w)}; }
DI void st_rows64(LAS unsigned char* slab, int lane, int fr, int fq, const u32x4& w0, const u32x4& w1, bf16* g0, size_t ldc) {
    *(LAS u32x4*)(slab + fr * 144 + fq * 16) = w0; *(LAS u32x4*)(slab + fr * 144 + 64 + fq * 16) = w1;
    LDS_WAIT();
    const int rr = lane >> 3, cc = lane & 7;
    const u32x4 a = *(const LAS u32x4*)(slab + rr * 144 + cc * 16), b = *(const LAS u32x4*)(slab + (8 + rr) * 144 + cc * 16);
    LDS_WAIT();
    *(u32x4*)(g0 + (unsigned)(rr * (int)ldc + cc * 8)) = a; *(u32x4*)(g0 + (unsigned)((8 + rr) * (int)ldc + cc * 8)) = b;
}
DI void st_rows32(LAS unsigned char* slab, int lane, int fr, int fq, const u32x4& w0, bf16* g0, size_t ldc) {
    *(LAS u32x4*)(slab + fr * 80 + fq * 16) = w0;
    LDS_WAIT();
    const int rr = lane >> 2, cc = lane & 3;
    const u32x4 a = *(const LAS u32x4*)(slab + rr * 80 + cc * 16);
    LDS_WAIT();
    *(u32x4*)(g0 + (unsigned)(rr * (int)ldc + cc * 8)) = a;
}
#define EPI_SLABP (slab0 + (wr * 4 + wc) * EPI_SLAB)
#define EPI_ROW0(ai, m) (u.pm * 256 + (ai) * 128 + wr * 64 + (m) * 16)
#define EPI_LANE (fr + 16 * fq)
DI f32x4 sig4(const f32x4& x) { return (f32x4){sigmoidf_(x[0]), sigmoidf_(x[1]), sigmoidf_(x[2]), sigmoidf_(x[3])}; }

struct EpiInProj { static constexpr bool PROBE2 = false;
    bf16* z; float* zs; const float* bias; LAS unsigned char* slab0;
    DI void operator()(const Acc& acc, const Unit& u, int wr, int wc, int fr, int fq) const {
        const int colt = u.pn * 256 + EPI_COL0;
        f32x4 bv[2][2];
#pragma unroll
        for (int bj = 0; bj < 2; ++bj)
#pragma unroll
            for (int n = 0; n < 2; ++n) bv[bj][n] = *(const f32x4*)(bias + colt + bj * 32 + 4 * n);
        if (u.pn < 44) {
#pragma unroll
            for (int ai = 0; ai < 2; ++ai)
#pragma unroll
                for (int m = 0; m < 4; ++m) st_rows64(EPI_SLABP, EPI_LANE, fr, fq, pack8(acc[ai][0][m][0] + bv[0][0], acc[ai][0][m][1] + bv[0][1]), pack8(acc[ai][1][m][0] + bv[1][0], acc[ai][1][m][1] + bv[1][1]),
                                                       z + (size_t)EPI_ROW0(ai, m) * ZW + u.pn * 256 + wc * 64, ZW);
        } else {
#pragma unroll
            for (int ai = 0; ai < 2; ++ai)
#pragma unroll
                for (int m = 0; m < 4; ++m) { float* rowp = zs + (size_t)EPI_ROWS(ai, m) * 128 + EPI_COL0;
                    if (wc < 2) {
#pragma unroll
                        for (int bj = 0; bj < 2; ++bj) { *(f32x4*)(rowp + bj * 32) = acc[ai][bj][m][0] + bv[bj][0]; *(f32x4*)(rowp + bj * 32 + 4) = acc[ai][bj][m][1] + bv[bj][1]; } } }
        }
    }
};
struct EpiRowScale { static constexpr bool PROBE2 = false;
    bf16* out; int ldc; const float* rs; int rs_stride; LAS unsigned char* slab0;
    DI void operator()(const Acc& acc, const Unit& u, int wr, int wc, int fr, int fq) const {
        const int colt = u.pn * 256 + EPI_COL0;
#pragma unroll
        for (int ai = 0; ai < 2; ++ai)
#pragma unroll
            for (int m = 0; m < 4; ++m) { const int row = EPI_ROWS(ai, m); const float s = rs[(size_t)row * rs_stride];
                st_rows64(EPI_SLABP, EPI_LANE, fr, fq, pack8(acc[ai][0][m][0] * s, acc[ai][0][m][1] * s), pack8(acc[ai][1][m][0] * s, acc[ai][1][m][1] * s), out + (size_t)EPI_ROW0(ai, m) * ldc + u.pn * 256 + wc * 64, ldc); }
    }
};
struct EpiColScale { static constexpr bool PROBE2 = false;
    bf16* out; int ldc; const float* cs; int cs_stride; LAS unsigned char* slab0;
    DI void operator()(const Acc& acc, const Unit& u, int wr, int wc, int fr, int fq) const {
        const int colt = u.pn * 256 + EPI_COL0;
        f32x4 sv[2][2];
#pragma unroll
        for (int bj = 0; bj < 2; ++bj)
#pragma unroll
            for (int n = 0; n < 2; ++n)
#pragma unroll
                for (int q = 0; q < 4; ++q) sv[bj][n][q] = cs[(size_t)(colt + bj * 32 + 4 * n + q) * cs_stride];
#pragma unroll
        for (int ai = 0; ai < 2; ++ai)
#pragma unroll
            for (int m = 0; m < 4; ++m) st_rows64(EPI_SLABP, EPI_LANE, fr, fq, pack8(acc[ai][0][m][0] * sv[0][0], acc[ai][0][m][1] * sv[0][1]), pack8(acc[ai][1][m][0] * sv[1][0], acc[ai][1][m][1] * sv[1][1]),
                                                   out + (size_t)EPI_ROW0(ai, m) * ldc + u.pn * 256 + wc * 64, ldc);
    }
};
template <int ADD> struct EpiGate { static constexpr bool PROBE2 = false;
    bf16* out; const bf16* gate; const bf16* prev; LAS unsigned char* slab0;
    DI void operator()(const Acc& acc, const Unit& u, int wr, int wc, int fr, int fq) const {
        const int colt = u.pn * 256 + EPI_COL0;
#pragma unroll
        for (int ai = 0; ai < 2; ++ai)
#pragma unroll
            for (int m = 0; m < 4; ++m) { const int row = EPI_ROWS(ai, m); u32x4 ow[2];
#pragma unroll
                for (int bj = 0; bj < 2; ++bj) { const int col = colt + bj * 32;
                    const u32x4 gw = *(const u32x4*)(gate + (size_t)row * ZW + col); f32x4 g0, g1; unpack8(gw, g0, g1);
                    f32x4 o0 = sig4(g0) * acc[ai][bj][m][0], o1 = sig4(g1) * acc[ai][bj][m][1];
                    if (ADD) { const u32x4 pw = *(const u32x4*)(prev + (size_t)row * DM + col); f32x4 p0, p1; unpack8(pw, p0, p1); o0 += p0; o1 += p1; }
                    ow[bj] = pack8(o0, o1); }
                st_rows64(EPI_SLABP, EPI_LANE, fr, fq, ow[0], ow[1], out + (size_t)EPI_ROW0(ai, m) * DM + u.pn * 256 + wc * 64, DM); }
    }
};
struct EpiResid { static constexpr bool PROBE2 = false;
    const bf16* hb; bf16* r; LAS unsigned char* slab0;
    DI void operator()(const Acc& acc, const Unit& u, int wr, int wc, int fr, int fq) const {
        const int colt = u.pn * 256 + EPI_COL0;
#pragma unroll
        for (int ai = 0; ai < 2; ++ai)
#pragma unroll
            for (int m = 0; m < 4; ++m) { const int row = EPI_ROWS(ai, m); u32x4 ow[2];
#pragma unroll
                for (int bj = 0; bj < 2; ++bj) { const u32x4 hw = *(const u32x4*)(hb + (size_t)row * DM + colt + bj * 32); f32x4 h0, h1; unpack8(hw, h0, h1);
                    ow[bj] = pack8(h0 * ALPHA + acc[ai][bj][m][0], h1 * ALPHA + acc[ai][bj][m][1]); }
                st_rows64(EPI_SLABP, EPI_LANE, fr, fq, ow[0], ow[1], r + (size_t)EPI_ROW0(ai, m) * DM + u.pn * 256 + wc * 64, DM); }
    }
};
struct EpiRouter { static constexpr bool PROBE2 = false;
    float* lg;
    DI void operator()(const Acc& acc, const Unit& u, int wr, int wc, int fr, int fq) const {
        if (wc == 0) {
#pragma unroll
            for (int ai = 0; ai < 2; ++ai)
#pragma unroll
                for (int m = 0; m < 4; ++m) { float* rowp = lg + (size_t)EPI_ROWS(ai, m) * 64 + EPI_COL0;
#pragma unroll
                    for (int bj = 0; bj < 2; ++bj) { *(f32x4*)(rowp + bj * 32) = acc[ai][bj][m][0]; *(f32x4*)(rowp + bj * 32 + 4) = acc[ai][bj][m][1]; } }
        }
    }
};
DI void st_rows32b(LAS unsigned char* slab, int lane, int fr, int fq, const u32x2& w0, unsigned char* g0, size_t ldc) {
    *(LAS u32x2*)(slab + fr * 40 + fq * 8) = w0;
    LDS_WAIT();
    const int rr = lane >> 2, cc = lane & 3;
    const u32x2 a = *(const LAS u32x2*)(slab + rr * 40 + cc * 8);
    LDS_WAIT();
    *(u32x2*)(g0 + (unsigned)(rr * (int)ldc + cc * 8)) = a;
}
struct EpiSwiGLU { static constexpr bool PROBE2 = false;
    unsigned char* hbuf; LAS unsigned char* slab0;
    DI void operator()(const Acc& acc, const Unit& u, int wr, int wc, int fr, int fq) const {
#pragma unroll
        for (int ai = 0; ai < 2; ++ai)
#pragma unroll
            for (int m = 0; m < 4; ++m) { f32x4 o[2];
#pragma unroll
                for (int n = 0; n < 2; ++n) { const f32x4 a = acc[ai][0][m][n], b = acc[ai][1][m][n]; o[n] = a * sig4(a) * b; }
#if MOE_FP8
                int w0 = 0, w1 = 0;
                w0 = __builtin_amdgcn_cvt_pk_fp8_f32(o[0][0], o[0][1], w0, false); w0 = __builtin_amdgcn_cvt_pk_fp8_f32(o[0][2], o[0][3], w0, true);
                w1 = __builtin_amdgcn_cvt_pk_fp8_f32(o[1][0], o[1][1], w1, false); w1 = __builtin_amdgcn_cvt_pk_fp8_f32(o[1][2], o[1][3], w1, true);
                st_rows32b(EPI_SLABP, EPI_LANE, fr, fq, (u32x2){(unsigned)w0, (unsigned)w1}, hbuf + (size_t)EPI_ROW0(ai, m) * DEXP + u.pn * 128 + wc * 32, DEXP);
#else
                st_rows32(EPI_SLABP, EPI_LANE, fr, fq, pack8(o[0], o[1]), (bf16*)hbuf + (size_t)EPI_ROW0(ai, m) * DEXP + u.pn * 128 + wc * 32, DEXP);
#endif
            }
    }
};
struct EpiPlain { static constexpr bool PROBE2 = true;
    bf16* out; int ldc; LAS unsigned char* slab0;
    DI void operator()(const Acc& acc, const Unit& u, int wr, int wc, int fr, int fq) const {
#pragma unroll
        for (int ai = 0; ai < 2; ++ai)
#pragma unroll
            for (int m = 0; m < 4; ++m) st_rows64(EPI_SLABP, EPI_LANE, fr, fq, pack8(acc[ai][0][m][0], acc[ai][0][m][1]), pack8(acc[ai][1][m][0], acc[ai][1][m][1]), out + (size_t)EPI_ROW0(ai, m) * ldc + u.pn * 256 + wc * 64, ldc);
    }
};

DI void st_rows64_32(LAS unsigned char* slab, int lane, int l31, int hh, const u32x4 (&w)[2][2], bf16* g0, int ldc) {
#pragma unroll
    for (int hf = 0; hf < 2; ++hf) {
        if ((l31 >> 4) == hf) { LAS unsigned char* d = slab + (l31 & 15) * 144 + hh * 32;
            *(LAS u32x4*)(d) = w[0][0]; *(LAS u32x4*)(d + 16) = w[0][1]; *(LAS u32x4*)(d + 64) = w[1][0]; *(LAS u32x4*)(d + 80) = w[1][1]; }
        LDS_WAIT();
        const int rr = lane >> 3, cc = lane & 7;
        const u32x4 a = *(const LAS u32x4*)(slab + rr * 144 + cc * 16), b = *(const LAS u32x4*)(slab + (8 + rr) * 144 + cc * 16);
        LDS_WAIT();
        *(u32x4*)(g0 + (unsigned)((16 * hf + rr) * ldc + cc * 8)) = a; *(u32x4*)(g0 + (unsigned)((16 * hf + 8 + rr) * ldc + cc * 8)) = b;
    }
}
DI void st_rows64b_32(LAS unsigned char* slab, int lane, int l31, int hh, const u32x4 (&w)[2], unsigned char* g0, int ldc) {
#pragma unroll
    for (int hf = 0; hf < 2; ++hf) {
        if ((l31 >> 4) == hf) { LAS unsigned char* d = slab + (l31 & 15) * 80 + hh * 16; *(LAS u32x4*)(d) = w[0]; *(LAS u32x4*)(d + 32) = w[1]; }
        LDS_WAIT();
        const int rr = lane >> 2, cc = lane & 3;
        const u32x4 a = *(const LAS u32x4*)(slab + rr * 80 + cc * 16);
        LDS_WAIT();
        *(u32x4*)(g0 + (unsigned)((16 * hf + rr) * ldc + cc * 16)) = a;
    }
}
DI u32x4 pack16_fp8(const f32x16& a, float sc) { u32x4 w;
#pragma unroll
    for (int g = 0; g < 4; ++g) { int ww = 0; ww = __builtin_amdgcn_cvt_pk_fp8_f32(__builtin_amdgcn_fmed3f(a[4 * g] * sc, -448.f, 448.f), __builtin_amdgcn_fmed3f(a[4 * g + 1] * sc, -448.f, 448.f), ww, false);
        ww = __builtin_amdgcn_cvt_pk_fp8_f32(__builtin_amdgcn_fmed3f(a[4 * g + 2] * sc, -448.f, 448.f), __builtin_amdgcn_fmed3f(a[4 * g + 3] * sc, -448.f, 448.f), ww, true); w[g] = (unsigned)ww; }
    return w; }
constexpr float Y8SCALE = 128.f;
struct EpiPlain8 {
    unsigned char* out; LAS unsigned char* slab0;
    DI void operator()(const pg8::Acc32& acc, const Unit& u, int wr, int wc, int l31, int hh) const {
#pragma unroll
        for (int ai = 0; ai < 2; ++ai)
#pragma unroll
            for (int mi = 0; mi < 2; ++mi) { u32x4 w[2];
#pragma unroll
                for (int bj = 0; bj < 2; ++bj) w[bj] = pack16_fp8(acc[ai][bj][mi], Y8SCALE);
                st_rows64b_32(EPI_SLABP, l31 + 32 * hh, l31, hh, w, out + (size_t)(u.pm * 256 + ai * 128 + wr * 64 + mi * 32) * DM + u.pn * 256 + wc * 64, DM); }
    }
};
struct EpiSwiGLU8 {
    unsigned char* hbuf;
    DI void operator()(const pg8::Acc32& acc, const Unit& u, int wr, int wc, int l31, int hh) const {
#pragma unroll
        for (int ai = 0; ai < 2; ++ai)
#pragma unroll
            for (int mi = 0; mi < 2; ++mi) { const f32x16& a = acc[ai][0][mi]; const f32x16& b = acc[ai][1][mi]; u32x4 w;
#pragma unroll
                for (int g = 0; g < 4; ++g) { float o[4];
#pragma unroll
                    for (int j = 0; j < 4; ++j) { const float x = a[4 * g + j]; o[j] = __builtin_amdgcn_fmed3f(x * sigmoidf_(x) * (b[4 * g + j] * H8SCALE), -448.f, 448.f); }
                    int ww = 0; ww = __builtin_amdgcn_cvt_pk_fp8_f32(o[0], o[1], ww, false); ww = __builtin_amdgcn_cvt_pk_fp8_f32(o[2], o[3], ww, true); w[g] = (unsigned)ww; }
                *(u32x4*)(hbuf + (size_t)(u.pm * 256 + ai * 128 + wr * 64 + mi * 32) * DEXP + (unsigned)(l31 * DEXP + u.pn * 128 + wc * 32 + hh * 16)) = w; }
    }
};
struct EpiInProj8 {
    bf16* z; const float* bias; LAS unsigned char* slab0;
    DI void operator()(const pg8::Acc32& acc, const Unit& u, int wr, int wc, int l31, int hh) const {
        const int col0 = ZC_F8 + u.pn * 256 + wc * 64;
        f32x4 bv[2][4];
#pragma unroll
        for (int bj = 0; bj < 2; ++bj)
#pragma unroll
            for (int g = 0; g < 4; ++g) bv[bj][g] = *(const f32x4*)(bias + col0 + bj * 32 + hh * 16 + 4 * g);
#pragma unroll
        for (int ai = 0; ai < 2; ++ai)
#pragma unroll
            for (int mi = 0; mi < 2; ++mi) { u32x4 w[2][2];
#pragma unroll
                for (int bj = 0; bj < 2; ++bj) { const f32x16& a = acc[ai][bj][mi];
                    w[bj][0] = pack8((f32x4){a[0], a[1], a[2], a[3]} + bv[bj][0], (f32x4){a[4], a[5], a[6], a[7]} + bv[bj][1]);
                    w[bj][1] = pack8((f32x4){a[8], a[9], a[10], a[11]} + bv[bj][2], (f32x4){a[12], a[13], a[14], a[15]} + bv[bj][3]); }
                st_rows64_32(EPI_SLABP, l31 + 32 * hh, l31, hh, w, z + (size_t)(u.pm * 256 + ai * 128 + wr * 64 + mi * 32) * ZW + col0, ZW); }
    }
};
constexpr float A8SCALE = 8.f, ATT8SCALE = 16.f;
template <int ADD, int OUT8> struct EpiGate8 {
    void* out; const bf16* gate; const bf16* prev; LAS unsigned char* slab0;
    DI void operator()(const pg8::Acc32& acc, const Unit& u, int wr, int wc, int l31, int hh) const {
        const int colw = u.pn * 256 + wc * 64;
#pragma unroll
        for (int ai = 0; ai < 2; ++ai)
#pragma unroll
            for (int mi = 0; mi < 2; ++mi) { const int row0 = u.pm * 256 + ai * 128 + wr * 64 + mi * 32, row = row0 + l31; f32x16 o[2];
#pragma unroll
                for (int bj = 0; bj < 2; ++bj) { const int col = colw + bj * 32 + hh * 16; const f32x16& a = acc[ai][bj][mi];
                    f32x4 g[4]; { const u32x4 w0 = *(const u32x4*)(gate + (size_t)row * ZW + col), w1 = *(const u32x4*)(gate + (size_t)row * ZW + col + 8); unpack8(w0, g[0], g[1]); unpack8(w1, g[2], g[3]); }
                    f32x4 p[4];
                    if (ADD) { const u32x4 w0 = *(const u32x4*)(prev + (size_t)row * DM + col), w1 = *(const u32x4*)(prev + (size_t)row * DM + col + 8); unpack8(w0, p[0], p[1]); unpack8(w1, p[2], p[3]); }
#pragma unroll
                    for (int q = 0; q < 4; ++q) { const f32x4 s = sig4(g[q]);
#pragma unroll
                        for (int j = 0; j < 4; ++j) o[bj][4 * q + j] = ADD ? p[q][j] + s[j] * a[4 * q + j] : s[j] * a[4 * q + j]; } }
                if (OUT8) { u32x4 w[2]; w[0] = pack16_fp8(o[0], A8SCALE); w[1] = pack16_fp8(o[1], A8SCALE);
                    st_rows64b_32(EPI_SLABP, l31 + 32 * hh, l31, hh, w, (unsigned char*)out + (size_t)row0 * DM + colw, DM); }
                else { u32x4 w[2][2];
#pragma unroll
                    for (int bj = 0; bj < 2; ++bj) { const f32x16& v = o[bj];
                        w[bj][0] = pack8((f32x4){v[0], v[1], v[2], v[3]}, (f32x4){v[4], v[5], v[6], v[7]}); w[bj][1] = pack8((f32x4){v[8], v[9], v[10], v[11]}, (f32x4){v[12], v[13], v[14], v[15]}); }
                    st_rows64_32(EPI_SLABP, l31 + 32 * hh, l31, hh, w, (bf16*)out + (size_t)row0 * DM + colw, DM); } }
    }
};
struct EpiResid8 {
    const bf16* hb; bf16* r; LAS unsigned char* slab0;
    DI void operator()(const pg8::Acc32& acc, const Unit& u, int wr, int wc, int l31, int hh) const {
        const int colw = u.pn * 256 + wc * 64;
#pragma unroll
        for (int ai = 0; ai < 2; ++ai)
#pragma unroll
            for (int mi = 0; mi < 2; ++mi) { const int row0 = u.pm * 256 + ai * 128 + wr * 64 + mi * 32, row = row0 + l31; u32x4 w[2][2];
#pragma unroll
                for (int bj = 0; bj < 2; ++bj) { const int col = colw + bj * 32 + hh * 16; const f32x16& a = acc[ai][bj][mi];
                    f32x4 h[4]; { const u32x4 w0 = *(const u32x4*)(hb + (size_t)row * DM + col), w1 = *(const u32x4*)(hb + (size_t)row * DM + col + 8); unpack8(w0, h[0], h[1]); unpack8(w1, h[2], h[3]); }
                    w[bj][0] = pack8(h[0] * ALPHA + (f32x4){a[0], a[1], a[2], a[3]}, h[1] * ALPHA + (f32x4){a[4], a[5], a[6], a[7]});
                    w[bj][1] = pack8(h[2] * ALPHA + (f32x4){a[8], a[9], a[10], a[11]}, h[3] * ALPHA + (f32x4){a[12], a[13], a[14], a[15]}); }
                st_rows64_32(EPI_SLABP, l31 + 32 * hh, l31, hh, w, r + (size_t)row0 * DM + colw, DM); }
    }
};
struct InProjOrderA : pg8::StaticOrder<DM * 2, DM * 2, RROWS / 256, NT_BF + 1> {
    DI bool next(int i, Unit& u) const { if (!pg8::StaticOrder<DM * 2, DM * 2, RROWS / 256, NT_BF + 1>::next(i, u)) return false; if (u.pn == NT_BF) { u.pn = 44; u.ub = 44u * 256u * (unsigned)(DM * 2); } return true; }
};
struct InProjOrder8 { static constexpr int nM = RROWS / 256, nN = NT_F8, nwg = nM * nN, nA = (RROWS / 256) * (NT_BF + 1);
    const char* A; const char* B; int G, c, heavy, R0;
    DI void init(const void* A_, const void* B_, int G_, int c_) { A = (const char*)A_; B = (const char*)B_; G = G_; c = c_; heavy = nA % G_;
        const int light = G_ - heavy; int r0 = (nwg - (8 * light) / 5 + G_ / 2) / G_; if (r0 < 0) r0 = 0; R0 = ((r0 * G_) % 8 == 0) ? r0 : 0; }
    DI bool next(int i, Unit& u) const {
        int L, wgid;
        if (i < R0) { L = i * G + c; wgid = pg8::xcd_remap(L, R0 * G); }
        else { if (c < heavy) return false; L = R0 * G + (i - R0) * (G - heavy) + (c - heavy); if (L >= nwg) return false; wgid = L; }
        const int nig = pg8::WGM * nN, gid = wgid / nig, fm = gid * pg8::WGM, gsz = (nM - fm) < pg8::WGM ? (nM - fm) : pg8::WGM;
        u.pm = fm + ((wgid % nig) % gsz); u.pn = (wgid % nig) / gsz;
        u.ua = (unsigned)u.pm * (unsigned)(256 * DM); u.ub = (unsigned)u.pn * (unsigned)(256 * DM); return true;
    }
};
template <int NJ, int KKB, bool GATHER> struct MoeOrder {
    const char* A; const char* B; const volatile LAS int* tileL; const int* tokI; int ntr, nunits, G, c;
    DI void init(const void* A_, const void* B_, const int* tab, const int* tok_, LAS unsigned char* lds, int tid, int G_, int c_) {
        A = (const char*)A_; B = (const char*)B_; tokI = tok_; G = G_; c = c_;
        LAS int* tl = (LAS int*)(lds + TILET_OFF);
        const int n0 = tab[0];
#pragma clang loop vectorize(disable) unroll(disable)
        for (int i = tid; i < n0 + 8; i += NT) tl[i] = tab[i];
        __syncthreads();
        tileL = (const volatile LAS int*)tl; ntr = __builtin_amdgcn_readfirstlane(n0); nunits = (ntr + NSHT) * NJ; }
    DI bool next(int i, Unit& u) const {
        const int L = i * G + c; if (L >= nunits) return false;
        const int Lr = pg8::xcd_remap(L, nunits), tau = Lr / NJ, j = Lr - tau * NJ;
        const int e = tau < ntr ? __builtin_amdgcn_readfirstlane(tileL[8 + tau]) : 64;
        u.pm = tau; u.pn = j;
        u.ua = GATHER ? 0u : (unsigned)tau * (unsigned)(256 * KKB);
        u.ub = (unsigned)(e * NJ + j) * (unsigned)(256 * KKB); return true;
    }
    DI int tok(const Unit& u, int row) const { return tokI[u.pm * 256 + row]; }
    DI const int* tokp(const Unit& u) const { return tokI + u.pm * 256; }
};

DI void phase_prep(const Frame& F, PK P, int l) {
    unsigned char* ws = F.ws;
    const bf16* z = (const bf16*)(ws + WS_Z); const float* zs = (const float*)(ws + WS_ZS); const float* rope = (const float*)(ws + WS_ROPE);
    bf16* krr = (bf16*)(ws + WS_KRR); bf16* qkc = (bf16*)(ws + WS_QKC); float* gates = (float*)(ws + WS_GATES); float* rstd = (float*)(ws + WS_RSTD);
    const float* cw = P->in[I_CONVW] + (size_t)l * 4 * 2048; const float* cb = P->in[I_CONVB] + (size_t)l * 2048;
    const int gw = F.vcu * NW + F.wave, NGW = F.G * NW, lane = F.lane;
    u32x4 nq = {0u, 0u, 0u, 0u}, nk = nq;
    if (gw < RROWS) { nq = *(const u32x4*)(z + (size_t)gw * ZW + ZC_CQ + 8 * lane); nk = *(const u32x4*)(z + (size_t)gw * ZW + ZC_CKV + 8 * lane); }
    for (int r = gw; r < RROWS; r += NGW) {
        const int b = r < NREAL ? (r >> 12) : ((r - NREAL) >> 6), p = r < NREAL ? 64 + (r & 4095) : ((r - NREAL) & 63), t = p - PADL;
        {
            const u32x4 wq = nq, wk = nk;
            if (r + NGW < RROWS) { nq = *(const u32x4*)(z + (size_t)(r + NGW) * ZW + ZC_CQ + 8 * lane); nk = *(const u32x4*)(z + (size_t)(r + NGW) * ZW + ZC_CKV + 8 * lane); }
            f32x4 a0, a1, b0, b1; unpack8(wq, a0, a1); unpack8(wk, b0, b1);
            float sq = 0.f, sk = 0.f;
#pragma unroll
            for (int j = 0; j < 4; ++j) { sq += a0[j] * a0[j] + a1[j] * a1[j]; sk += b0[j] * b0[j] + b1[j] * b1[j]; }
            sq = wave_sum(sq); sk = wave_sum(sk);
            if (lane == 0) { rstd[(size_t)r * 2] = 1.f / sqrtf(sq * (1.f / 512.f) + RMS_EPS); rstd[(size_t)r * 2 + 1] = 1.f / sqrtf(sk * (1.f / 512.f) + RMS_EPS); }
        }
        if (lane < 32) {
            const int tt = t < 0 ? 0 : t; const float x1 = zs[(size_t)r * 128 + lane], x2 = zs[(size_t)r * 128 + 32 + lane], c = rope[tt * 64 + lane], s = rope[tt * 64 + 32 + lane];
            float o1 = x1 * c - x2 * s, o2 = x1 * s + x2 * c; if (t < 0) { o1 = 0.f; o2 = 0.f; }
            krr[(size_t)r * 64 + lane] = (bf16)(pk2(o1, 0.f) & 0xffffu); krr[(size_t)r * 64 + 32 + lane] = (bf16)(pk2(o2, 0.f) & 0xffffu);
        }
        if (lane < 8) {
            const float mi = zs[(size_t)r * 128 + 64 + lane], mf = zs[(size_t)r * 128 + 72 + lane];
            float lf = fminf(mf, 0.f) - log1pf(expf(-fabsf(mf))), ig = mi;
            if (t < 0) { lf = 0.f; ig = -1e30f; }
            gates[(size_t)r * 16 + lane] = lf; gates[(size_t)r * 16 + 8 + lane] = ig;
        }
    }
    for (int task = gw; task < NBATCH * 65 * 4; task += NGW) {
        const int ci = task >> 2, qd = task & 3, b = ci / 65, c = ci - b * 65, c0 = (qd * 64 + lane) * 8;
        const size_t row0 = (size_t)chunk_row0(b, c);
        f32x4 w[4][2], bia[2];
#pragma unroll
        for (int jj = 0; jj < 4; ++jj) { w[jj][0] = *(const f32x4*)(cw + jj * 2048 + c0); w[jj][1] = *(const f32x4*)(cw + jj * 2048 + c0 + 4); }
        bia[0] = *(const f32x4*)(cb + c0); bia[1] = *(const f32x4*)(cb + c0 + 4);
        f32x4 xm[3][2];
#pragma unroll
        for (int j = 0; j < 3; ++j) { xm[j][0] = (f32x4){0.f, 0.f, 0.f, 0.f}; xm[j][1] = (f32x4){0.f, 0.f, 0.f, 0.f}; }
        if (c >= 1) { const size_t rp = (size_t)chunk_row0(b, c - 1) + 61;
#pragma unroll
            for (int j = 0; j < 3; ++j) { const u32x4 xw = *(const u32x4*)(z + (rp + j) * ZW + ZC_MQ + c0); unpack8(xw, xm[j][0], xm[j][1]); } }
        const float sc = c0 >= 1024 ? 0.08838834764831845f : 1.f;
        u32x4 xn[8];
#pragma unroll
        for (int i = 0; i < 8; ++i) xn[i] = *(const u32x4*)(z + (row0 + i) * ZW + ZC_MQ + c0);
#pragma unroll 1
        for (int i0 = 0; i0 < 64; i0 += 8) {
            u32x4 xr[8];
#pragma unroll
            for (int i = 0; i < 8; ++i) xr[i] = xn[i];
            if (i0 + 8 < 64) {
#pragma unroll
                for (int i = 0; i < 8; ++i) xn[i] = *(const u32x4*)(z + (row0 + i0 + 8 + i) * ZW + ZC_MQ + c0); }
#pragma unroll
            for (int i = 0; i < 8; ++i) { f32x4 x0, x1; unpack8(xr[i], x0, x1);
                if (c == 0 && i0 + i < PADL) { x0 = (f32x4){0.f, 0.f, 0.f, 0.f}; x1 = x0; }
                f32x4 a0 = bia[0] + w[0][0] * xm[0][0] + w[1][0] * xm[1][0] + w[2][0] * xm[2][0] + w[3][0] * x0;
                f32x4 a1 = bia[1] + w[0][1] * xm[0][1] + w[1][1] * xm[1][1] + w[2][1] * xm[2][1] + w[3][1] * x1;
                xm[0][0] = xm[1][0]; xm[0][1] = xm[1][1]; xm[1][0] = xm[2][0]; xm[1][1] = xm[2][1]; xm[2][0] = x0; xm[2][1] = x1;
                a0 = a0 * sig4(a0) * sc; a1 = a1 * sig4(a1) * sc;
                *(u32x4*)(qkc + (row0 + i0 + i) * 2048 + c0) = pack8(a0, a1); }
        }
    }
}

constexpr int ML_VW = 64, ML_NVT = ML_VW / 16, ML_NNT = ML_NVT + 1, ML_VR = 16 * ML_NNT;
constexpr int ML_SQ = 0, ML_SK = 17408, ML_SKT = 34816, ML_SVT = 53248, ML_SP = ML_SVT + ML_VR * 144, ML_CTB = ML_VR * 272, ML_SCT = ML_SP + 64 * 144, ML_SCAL = ML_SCT + 2 * ML_CTB, ML_SCB = 336 * 4;
constexpr int ML_SVTE = ML_SCAL + 2 * ML_SCB;
static_assert(ML_SVTE + ML_VR * 144 <= MISC_OFF, "mLSTM LDS map");
DI bf16x8 ldfrag(LAS unsigned char* L, int base, int stride, int row, int kb) { return *(const LAS bf16x8*)(L + base + row * stride + kb); }
DI bf16 f2b(float x) { return (bf16)(pk2(x, 0.f) & 0xffffu); }
#define MFMA16(a, b, c) __builtin_amdgcn_mfma_f32_16x16x32_bf16((a), (b), (c), 0, 0, 0)
#define MFMA32(a, b, c) __builtin_amdgcn_mfma_f32_32x32x16_bf16((a), (b), (c), 0, 0, 0)

DI float mlstm_scan(LAS float* SC, float lf, float ig, int lane, float mprev) {
    const float bs = wave_scan_sum(lf);
    const float g = rlane(bs, 63);
    const float u = ig - bs;
    const float pm = wave_scan_max(u);
    const float M = fmaxf(pm, mprev);
    const float a = g + u, amax = wave_max(a), mnew = fmaxf(g + mprev, amax);
    SC[lane] = u; SC[64 + lane] = M; SC[128 + lane] = __expf(mprev - M); SC[192 + lane] = __expf(a - mnew); SC[256 + lane] = __expf(-(bs + M));
    if (lane == 0) SC[320] = __expf(g + mprev - mnew);
    return mnew;
}

DI void mlstm_task(const Frame& F, int b, int hd, int vs) {
    unsigned char* wsl = F.ws; asm volatile("" : "+s"(wsl));
    const bf16* z = (const bf16*)(wsl + WS_Z); const bf16* qkc = (const bf16*)(wsl + WS_QKC); const float* gates = (const float*)(wsl + WS_GATES); bf16* hraw = (bf16*)(wsl + WS_HRAW);
    LAS unsigned char* L = F.lds; int tid = F.tid; asm volatile("" : "+v"(tid)); const int lane = tid & 63, wave = F.wave, l15 = lane & 15, lq = lane >> 4;
    for (int i = tid; i < 16 * 72; i += NT) { const int r = ML_VW + i / 72, c = i % 72; *(LAS bf16*)(L + ML_SVT + r * 144 + c * 2) = (r == ML_VW) ? (bf16)0x3F80 : (bf16)0; *(LAS bf16*)(L + ML_SVTE + r * 144 + c * 2) = (bf16)0; }
    for (int i = tid; i < 2 * ML_CTB / 4; i += NT) *(LAS unsigned*)(L + ML_SCT + i * 4) = 0u;
    f32x4 accC[2][ML_NNT];
#pragma unroll
    for (int a = 0; a < 2; ++a)
#pragma unroll
        for (int n = 0; n < ML_NNT; ++n) accC[a][n] = (f32x4){0.f, 0.f, 0.f, 0.f};
    const int s0 = (lane & 15) + 16 * (wave & 1), dc = (lane >> 4) + 4 * (wave >> 1), sv = tid >> 3, c8 = tid & 7;
    const bf16* gq = qkc + (size_t)s0 * 2048 + hd * 128 + 8 * dc;
    const bf16* gv = z + (size_t)sv * ZW + ZC_MV + hd * 256 + ML_VW * vs + 8 * c8;
    u32x4 rq0, rq1, rk0, rk1, rv;
#define GAS __attribute__((address_space(1)))
#define ML_ISSUE(c) do { const size_t ro = (size_t)chunk_row0(b, (c)); rq0 = *(const GAS u32x4*)(gq + ro * 2048); rq1 = *(const GAS u32x4*)(gq + (ro + 32) * 2048); rk0 = *(const GAS u32x4*)(gq + ro * 2048 + 1024); rk1 = *(const GAS u32x4*)(gq + (ro + 32) * 2048 + 1024); \
        rv = *(const GAS u32x4*)(gv + ro * ZW); } while (0)
#define ML_KT(kv, s) do { _Pragma("unroll") for (int e = 0; e < 4; ++e) { *(LAS bf16*)(L + ML_SKT + (8 * dc + 2 * e) * 144 + ((s) ^ ((dc & 3) << 4)) * 2) = (bf16)((kv)[e] & 0xffffu); *(LAS bf16*)(L + ML_SKT + (8 * dc + 2 * e + 1) * 144 + ((s) ^ ((dc & 3) << 4)) * 2) = (bf16)((kv)[e] >> 16); } } while (0)
#define ML_COMMIT_E(SCn) do { const float ea_ = (SCn)[192 + sv]; \
        _Pragma("unroll") for (int e = 0; e < 4; ++e) { *(LAS bf16*)(L + ML_SVTE + (8 * c8 + 2 * e) * 144 + (sv ^ ((c8 & 3) << 4)) * 2) = f2b(bflo(rv[e]) * ea_); *(LAS bf16*)(L + ML_SVTE + (8 * c8 + 2 * e + 1) * 144 + (sv ^ ((c8 & 3) << 4)) * 2) = f2b(bfhi(rv[e]) * ea_); } \
        if (c8 == 0) *(LAS bf16*)(L + ML_SVTE + ML_VW * 144 + sv * 2) = f2b(ea_); } while (0)
#define ML_COMMIT() do { *(LAS u32x4*)(L + ML_SQ + s0 * 272 + dc * 16) = rq0; *(LAS u32x4*)(L + ML_SQ + (s0 + 32) * 272 + dc * 16) = rq1; *(LAS u32x4*)(L + ML_SK + s0 * 272 + dc * 16) = rk0; *(LAS u32x4*)(L + ML_SK + (s0 + 32) * 272 + dc * 16) = rk1; \
        ML_KT(rk0, s0); ML_KT(rk1, s0 + 32); \
        { _Pragma("unroll") for (int e = 0; e < 4; ++e) { *(LAS bf16*)(L + ML_SVT + (8 * c8 + 2 * e) * 144 + (sv ^ ((c8 & 3) << 4)) * 2) = (bf16)(rv[e] & 0xffffu); *(LAS bf16*)(L + ML_SVT + (8 * c8 + 2 * e + 1) * 144 + (sv ^ ((c8 & 3) << 4)) * 2) = (bf16)(rv[e] >> 16); } } } while (0)
    ML_ISSUE(0);
    float mrun = 0.f;
    float lfn = 0.f, ign = 0.f;
#define ML_GATES(c) do { const size_t rg_ = (size_t)chunk_row0(b, (c)) + lane; lfn = *(const GAS float*)(gates + rg_ * 16 + hd); ign = *(const GAS float*)(gates + rg_ * 16 + 8 + hd); } while (0)
    if (wave == 7) { ML_GATES(0); mrun = mlstm_scan((LAS float*)(L + ML_SCAL), lfn, ign, lane, 0.f); ML_GATES(1); }
    __syncthreads();
    ML_COMMIT(); ML_COMMIT_E((LAS float*)(L + ML_SCAL));
    __syncthreads();
    int cur = 0;
#pragma unroll 1
    for (int c = 0; c < 65; ++c) {
        const size_t r0 = (size_t)chunk_row0(b, c);
        LAS float* SC = (LAS float*)(L + ML_SCAL + (c & 1) * ML_SCB);
        if (c + 1 < 65) ML_ISSUE(c + 1);
#pragma unroll
        for (int q = 0; q < 2; ++q) { const int tile = 2 * wave + q, tt = tile >> 2, st = tile & 3; f32x4 acc = (f32x4){0.f, 0.f, 0.f, 0.f};
            if (st <= tt) {
#pragma unroll
                for (int kk = 0; kk < 4; ++kk) acc = MFMA16(ldfrag(L, ML_SQ, 272, tt * 16 + l15, kk * 64 + lq * 16), ldfrag(L, ML_SK, 272, st * 16 + l15, kk * 64 + lq * 16), acc); }
            const int s = st * 16 + l15; const float us = SC[s];
#pragma unroll
            for (int rg = 0; rg < 4; ++rg) { const int t = tt * 16 + 4 * lq + rg; const float v = (s <= t) ? acc[rg] * __expf(us - SC[64 + t]) : 0.f;
                *(LAS bf16*)(L + ML_SP + t * 144 + s * 2) = f2b(v); } }
        if (wave == 7 && c + 1 < 65) { mrun = mlstm_scan((LAS float*)(L + ML_SCAL + ((c + 1) & 1) * ML_SCB), lfn, ign, lane, mrun); if (c + 2 < 65) ML_GATES(c + 2); }
        __syncthreads();
        if (wave < 4) {
            const int tt = wave; f32x4 a1[ML_NNT], a2[ML_NNT];
#pragma unroll
            for (int n = 0; n < ML_NNT; ++n) { a1[n] = (f32x4){0.f, 0.f, 0.f, 0.f}; a2[n] = (f32x4){0.f, 0.f, 0.f, 0.f}; }
#pragma unroll
            for (int kk = 0; kk < 2; ++kk) { const bf16x8 A = ldfrag(L, ML_SP, 144, tt * 16 + l15, kk * 64 + lq * 16);
#pragma unroll
                for (int n = 0; n < ML_NNT; ++n) a1[n] = MFMA16(ldfrag(L, ML_SVT, 144, n * 16 + l15, (kk * 64 + lq * 16) ^ ((((n * 16 + l15) >> 3) & 3) << 5)), A, a1[n]); }
#pragma unroll
            for (int kk = 0; kk < 4; ++kk) { const bf16x8 A = ldfrag(L, ML_SQ, 272, tt * 16 + l15, kk * 64 + lq * 16);
#pragma unroll
                for (int n = 0; n < ML_NNT; ++n) a2[n] = MFMA16(ldfrag(L, ML_SCT + cur * ML_CTB, 272, n * 16 + l15, kk * 64 + lq * 16), A, a2[n]); }
            const int t = tt * 16 + l15; const float ein = SC[128 + t], emr = SC[256 + t];
            const float rd = a1[ML_NVT][0] + ein * a2[ML_NVT][0];
            const float den = __shfl(rd, l15); const float dn = 1.f / fmaxf(fabsf(den), emr);
            bf16* op = hraw + (r0 + t) * 2048 + hd * 256 + ML_VW * vs + 4 * lq;
#pragma unroll
            for (int n = 0; n < ML_NVT; ++n) { const f32x4 o = (a1[n] + a2[n] * ein) * dn; u32x2 w; w.x = pk2(o[0], o[1]); w.y = pk2(o[2], o[3]); *(GAS u32x2*)(op + 16 * n) = w; }
        } else {
            const int w4 = wave - 4; const float decay = SC[320]; const int nxt = cur ^ 1;
            bf16x8 Bf[2][ML_NNT];
#pragma unroll
            for (int kk = 0; kk < 2; ++kk)
#pragma unroll
                for (int n = 0; n < ML_NNT; ++n) { const int sw = (kk * 32 + lq * 8) ^ ((((n * 16 + l15) >> 3) & 3) << 4);
                    Bf[kk][n] = *(const LAS bf16x8*)(L + ML_SVTE + (n * 16 + l15) * 144 + sw * 2); }
#pragma unroll
            for (int di = 0; di < 2; ++di) { const int dt = 2 * w4 + di;
#pragma unroll
                for (int n = 0; n < ML_NNT; ++n) accC[di][n] = accC[di][n] * decay;
#pragma unroll
                for (int kk = 0; kk < 2; ++kk) { const bf16x8 A = ldfrag(L, ML_SKT, 144, dt * 16 + l15, (kk * 64 + lq * 16) ^ ((((dt * 16 + l15) >> 3) & 3) << 5));
#pragma unroll
                    for (int n = 0; n < ML_NNT; ++n) accC[di][n] = MFMA16(A, Bf[kk][n], accC[di][n]); }
#pragma unroll
                for (int n = 0; n < ML_NNT; ++n) { u32x2 w; w.x = pk2(accC[di][n][0], accC[di][n][1]); w.y = pk2(accC[di][n][2], accC[di][n][3]);
                    *(LAS u32x2*)(L + ML_SCT + nxt * ML_CTB + (n * 16 + l15) * 272 + (dt * 16 + 4 * lq) * 2) = w; } }
        }
        __syncthreads();
        if (c + 1 < 65) { ML_COMMIT(); ML_COMMIT_E((LAS float*)(L + ML_SCAL + ((c + 1) & 1) * ML_SCB)); }
        __syncthreads();
        cur ^= 1;
    }
#undef ML_ISSUE
#undef ML_GATES
#undef ML_KT
#undef ML_COMMIT
#undef ML_COMMIT_E
}

constexpr int AT_KB = 64 * 384, AT_BUF = AT_KB + 128 * 128, AT_NBUF = 3;
#ifndef AT_STAGGER
#define AT_STAGGER 6
#endif
#ifndef AT_OLD
#define AT_OLD 1
#endif
DI void attn_item(const Frame& F, int b, int hd, int G) {
    unsigned char* wsl = F.ws; asm volatile("" : "+s"(wsl));
    const bf16* q = (const bf16*)(wsl + WS_Q); const bf16* kn = (const bf16*)(wsl + WS_KN); const bf16* krr = (const bf16*)(wsl + WS_KRR); const bf16* vt = (const bf16*)(wsl + WS_VT);
    const float* rope = (const float*)(wsl + WS_ROPE); bf16* att = (bf16*)(wsl + WS_ATT);
    LAS unsigned char* L = F.lds; int tid = F.tid; asm volatile("" : "+v"(tid)); const int lane = tid & 63, wave = F.wave, l31 = lane & 31, hh = lane >> 5;
    const int qbase = (G == 0) ? 0 : 64 + 256 * (G - 1), nq = (G == 0) ? 2 : 8, nk = (G == 0) ? 1 : 1 + 4 * G;
    const size_t qrow0 = (G == 0) ? (size_t)(NREAL + 64 * b) : (size_t)(b * SEQ + 256 * (G - 1));
    const bool act = wave < nq;
    const int qp = qbase + 32 * wave + l31, qmax = qbase + 32 * wave + 31;
    const size_t qr = qrow0 + 32 * wave + l31;
    const char* gbase = (const char*)kn;
    unsigned srcK[3], srcV[2]; bool isr[3];
#pragma unroll
    for (int i = 0; i < 3; ++i) { const int ci = 64 * (wave * 3 + i) + lane, key = ci / 24, cp = ci - key * 24, c = (cp & ~7) | ((cp & 7) ^ ((key >> 1) & 7));
        isr[i] = c >= 16;
        srcK[i] = isr[i] ? (unsigned)((const char*)(krr + (size_t)key * 64 + 8 * (c - 16)) - gbase) : (unsigned)((const char*)(kn + (size_t)key * 1024 + hd * 128 + 8 * c) - gbase); }
#pragma unroll
    for (int i = 0; i < 2; ++i) { const int ci = 64 * (wave * 2 + i) + lane, dv = ci >> 3, cp = ci & 7, c = cp ^ ((dv >> 1) & 7);
        srcV[i] = (unsigned)((const char*)(vt + (size_t)(hd * 128 + dv) * RROWS + 8 * c) - gbase); }
#define AT_ISSUE(kt) do { const unsigned ko = (unsigned)chunk_row0(b, (kt)); const int bo_ = ((kt) % AT_NBUF) * AT_BUF; \
        _Pragma("unroll") for (int i_ = 0; i_ < 3; ++i_) __builtin_amdgcn_global_load_lds((const unsigned*)(gbase + (unsigned)(srcK[i_] + ko * (isr[i_] ? 128u : 2048u))), (LAS unsigned*)(L + bo_ + (wave * 3 + i_) * 1024), 16, 0, 0); \
        _Pragma("unroll") for (int i_ = 0; i_ < 2; ++i_) __builtin_amdgcn_global_load_lds((const unsigned*)(gbase + (unsigned)(srcV[i_] + ko * 2u)), (LAS unsigned*)(L + bo_ + AT_KB + (wave * 2 + i_) * 1024), 16, 0, 0); } while (0)
    AT_ISSUE(0);
    if (nk > 1) AT_ISSUE(1);
    bf16x8 Qf[12];
    if (act) { const bf16* qrow = q + qr * 1536 + hd * 192 + 8 * hh;
#pragma unroll
      for (int s = 0; s < 12; ++s) Qf[s] = *(const GAS bf16x8*)(qrow + 16 * s);
      int t = qp - PADL; if (t < 0) t = 0;
#pragma unroll
      for (int s2 = 0; s2 < 2; ++s2) { const int i0 = 16 * s2 + 8 * hh;
          const f32x4 c0 = *(const GAS f32x4*)(rope + t * 64 + i0), c1 = *(const GAS f32x4*)(rope + t * 64 + i0 + 4), s0 = *(const GAS f32x4*)(rope + t * 64 + 32 + i0), s1 = *(const GAS f32x4*)(rope + t * 64 + 32 + i0 + 4);
          const u32x4 w1 = __builtin_bit_cast(u32x4, Qf[8 + s2]), w2 = __builtin_bit_cast(u32x4, Qf[10 + s2]);
          f32x4 x10, x11, x20, x21; unpack8(w1, x10, x11); unpack8(w2, x20, x21);
          const f32x4 o10 = x10 * c0 - x20 * s0, o11 = x11 * c1 - x21 * s1, o20 = x10 * s0 + x20 * c0, o21 = x11 * s1 + x21 * c1;
          Qf[8 + s2] = __builtin_bit_cast(bf16x8, pack8(o10, o11)); Qf[10 + s2] = __builtin_bit_cast(bf16x8, pack8(o20, o21)); } }
    else {
#pragma unroll
      for (int s = 0; s < 12; ++s) Qf[s] = (bf16x8){0, 0, 0, 0, 0, 0, 0, 0}; }
    f32x16 O[4];
    { float z0 = 0.f; asm volatile("" : "+v"(z0));
#pragma unroll
      for (int d = 0; d < 4; ++d)
#pragma unroll
        for (int i = 0; i < 16; ++i) O[d][i] = z0; }
    float m = -INFINITY, lsum = 0.f;
    const int pi = (l31 & 0x13) | ((l31 & 4) << 1) | ((l31 & 8) >> 1);
    int koff[4];
#pragma unroll
    for (int j = 0; j < 4; ++j) koff[j] = pi * 384 + (((2 * j + hh) ^ ((pi >> 1) & 7)) << 4);
    const int vbase = AT_KB + l31 * 128, vx = (l31 >> 1) & 7;
    asm volatile("s_waitcnt vmcnt(0)" ::: "memory");
#pragma unroll 1
    for (int kt = 0; kt < nk; ++kt) {
        const int bo = (kt % AT_NBUF) * AT_BUF;
        if (kt > 0) { if (kt + 1 < nk) asm volatile("s_waitcnt vmcnt(5)" ::: "memory"); else asm volatile("s_waitcnt vmcnt(0)" ::: "memory"); }
        __builtin_amdgcn_s_barrier();
        asm volatile("" ::: "memory");
        const bool busy = act && 64 * kt <= qmax;
        if (!busy && kt + 2 < nk) AT_ISSUE(kt + 2);
        if (busy) {
            f32x16 S0, S1; bf16x8 Pf0[2], Pf1[2];
            const f32x16 zc = {0.f, 0.f, 0.f, 0.f, 0.f, 0.f, 0.f, 0.f, 0.f, 0.f, 0.f, 0.f, 0.f, 0.f, 0.f, 0.f};
            bf16x8 Kg[12];
            {   bf16x8 Kf[12];
#pragma unroll
                for (int s = 0; s < 12; ++s) Kf[s] = *(const LAS bf16x8*)(L + bo + (s >> 2) * 128 + koff[s & 3]);
                S0 = MFMA32(Kf[0], Qf[0], zc);
#pragma unroll
                for (int s = 1; s < 12; ++s) S0 = MFMA32(Kf[s], Qf[s], S0);
#pragma unroll
                for (int s = 0; s < 4; ++s) Kg[s] = *(const LAS bf16x8*)(L + bo + 32 * 384 + (s >> 2) * 128 + koff[s & 3]);
                __builtin_amdgcn_sched_group_barrier(0x100, 6, 0);
#pragma unroll
                for (int i = 0; i < 10; ++i) { __builtin_amdgcn_sched_group_barrier(0x008, 1, 0); __builtin_amdgcn_sched_group_barrier(0x100, 1, 0); }
                __builtin_amdgcn_sched_group_barrier(0x008, 2, 0);
            }
            __builtin_amdgcn_sched_barrier(0);
            const bool diag = 64 * kt + 63 > qbase + 32 * wave || kt == 0;
            if (diag) {
#pragma unroll
                for (int i = 0; i < 16; ++i) { const int kp = 64 * kt + (i & 3) + 4 * ((i >> 2) & 1) + 8 * hh + 16 * (i >> 3); if (kp > qp || kp < PADL) S0[i] = -INFINITY; } }
            const float mu = (m == -INFINITY) ? 0.f : m;
            bf16x8 Vf[2][4], Vg[2][4];
            float mx, rs;
            {
#pragma unroll
                for (int s = 4; s < 12; ++s) Kg[s] = *(const LAS bf16x8*)(L + bo + 32 * 384 + (s >> 2) * 128 + koff[s & 3]);
                S1 = MFMA32(Kg[0], Qf[0], zc);
#pragma unroll
                for (int s = 1; s < 12; ++s) S1 = MFMA32(Kg[s], Qf[s], S1);
#pragma unroll
                for (int s2 = 0; s2 < 2; ++s2)
#pragma unroll
                    for (int d = 0; d < 4; ++d) Vf[s2][d] = *(const LAS bf16x8*)(L + bo + d * 32 * 128 + vbase + (((2 * s2 + hh) ^ vx) << 4));
                { const float m0 = fmaxf(fmaxf(S0[0], S0[1]), fmaxf(S0[2], S0[3])), m1 = fmaxf(fmaxf(S0[4], S0[5]), fmaxf(S0[6], S0[7])), m2 = fmaxf(fmaxf(S0[8], S0[9]), fmaxf(S0[10], S0[11])), m3 = fmaxf(fmaxf(S0[12], S0[13]), fmaxf(S0[14], S0[15]));
                  mx = fmaxf(fmaxf(m0, m1), fmaxf(m2, m3)); }
#pragma unroll
                for (int i = 0; i < 16; ++i) S0[i] = __builtin_amdgcn_exp2f(S0[i] - mu);
                rs = (((S0[0] + S0[1]) + (S0[2] + S0[3])) + ((S0[4] + S0[5]) + (S0[6] + S0[7]))) + (((S0[8] + S0[9]) + (S0[10] + S0[11])) + ((S0[12] + S0[13]) + (S0[14] + S0[15])));
#pragma unroll
                for (int s2 = 0; s2 < 2; ++s2) { u32x4 w; w.x = pk2(S0[8 * s2], S0[8 * s2 + 1]); w.y = pk2(S0[8 * s2 + 2], S0[8 * s2 + 3]); w.z = pk2(S0[8 * s2 + 4], S0[8 * s2 + 5]); w.w = pk2(S0[8 * s2 + 6], S0[8 * s2 + 7]); Pf0[s2] = __builtin_bit_cast(bf16x8, w); }
                __builtin_amdgcn_sched_group_barrier(0x100, 4, 0);
#pragma unroll
                for (int i = 0; i < 4; ++i) { __builtin_amdgcn_sched_group_barrier(0x008, 1, 0); __builtin_amdgcn_sched_group_barrier(0x100, 1, 0); __builtin_amdgcn_sched_group_barrier(0x002, 5, 0); }
#pragma unroll
                for (int i = 0; i < 8; ++i) { __builtin_amdgcn_sched_group_barrier(0x008, 1, 0); __builtin_amdgcn_sched_group_barrier(0x100, 1, 0); __builtin_amdgcn_sched_group_barrier(0x002, 5, 0); }
                asm volatile("" : "+v"(Pf0[0]), "+v"(Pf0[1]), "+v"(rs), "+v"(mx));
            }
            __builtin_amdgcn_sched_barrier(0);
            if (diag) {
#pragma unroll
                for (int i = 0; i < 16; ++i) { const int kp = 64 * kt + 32 + (i & 3) + 4 * ((i >> 2) & 1) + 8 * hh + 16 * (i >> 3); if (kp > qp || kp < PADL) S1[i] = -INFINITY; } }
            {
#pragma unroll
                for (int s2 = 0; s2 < 2; ++s2)
#pragma unroll
                    for (int d = 0; d < 4; ++d) O[d] = MFMA32(Vf[s2][d], Pf0[s2], O[d]);
#pragma unroll
                for (int s2 = 0; s2 < 2; ++s2)
#pragma unroll
                    for (int d = 0; d < 4; ++d) Vg[s2][d] = *(const LAS bf16x8*)(L + bo + d * 32 * 128 + vbase + (((4 + 2 * s2 + hh) ^ vx) << 4));
                { const float m0 = fmaxf(fmaxf(S1[0], S1[1]), fmaxf(S1[2], S1[3])), m1 = fmaxf(fmaxf(S1[4], S1[5]), fmaxf(S1[6], S1[7])), m2 = fmaxf(fmaxf(S1[8], S1[9]), fmaxf(S1[10], S1[11])), m3 = fmaxf(fmaxf(S1[12], S1[13]), fmaxf(S1[14], S1[15]));
                  mx = fmaxf(mx, fmaxf(fmaxf(m0, m1), fmaxf(m2, m3))); }
#pragma unroll
                for (int i = 0; i < 16; ++i) S1[i] = __builtin_amdgcn_exp2f(S1[i] - mu);
#pragma unroll
                for (int i = 0; i < 8; ++i) { __builtin_amdgcn_sched_group_barrier(0x008, 1, 0); __builtin_amdgcn_sched_group_barrier(0x100, 1, 0); __builtin_amdgcn_sched_group_barrier(0x002, 6, 0); }
                asm volatile("" : "+v"(S1), "+v"(mx));
            }
            __builtin_amdgcn_sched_barrier(0);
            rs += (((S1[0] + S1[1]) + (S1[2] + S1[3])) + ((S1[4] + S1[5]) + (S1[6] + S1[7]))) + (((S1[8] + S1[9]) + (S1[10] + S1[11])) + ((S1[12] + S1[13]) + (S1[14] + S1[15])));
#pragma unroll
            for (int s2 = 0; s2 < 2; ++s2) { u32x4 w; w.x = pk2(S1[8 * s2], S1[8 * s2 + 1]); w.y = pk2(S1[8 * s2 + 2], S1[8 * s2 + 3]); w.z = pk2(S1[8 * s2 + 4], S1[8 * s2 + 5]); w.w = pk2(S1[8 * s2 + 6], S1[8 * s2 + 7]); Pf1[s2] = __builtin_bit_cast(bf16x8, w); }
            __builtin_amdgcn_sched_barrier(0);
#pragma unroll
            for (int s2 = 0; s2 < 2; ++s2)
#pragma unroll
                for (int d = 0; d < 4; ++d) O[d] = MFMA32(Vg[s2][d], Pf1[s2], O[d]);
            __builtin_amdgcn_sched_barrier(0);
            if (kt + 2 < nk) AT_ISSUE(kt + 2);
            lsum += rs;
            { const u32x2 sw = __builtin_amdgcn_permlane32_swap(__builtin_bit_cast(unsigned, mx), __builtin_bit_cast(unsigned, mx), false, false); mx = fmaxf(__builtin_bit_cast(float, sw[0]), __builtin_bit_cast(float, sw[1])); }
            if (__any(mx > m + 8.f)) { const float mn = fmaxf(m, mx), f = (mn == -INFINITY) ? 1.f : __builtin_amdgcn_exp2f(mu - mn); lsum *= f; m = mn;
#pragma unroll
                for (int d = 0; d < 4; ++d)
#pragma unroll
                    for (int i = 0; i < 16; ++i) O[d][i] *= f; }
        }
    }
#undef AT_ISSUE
    if (act) {
        const float ltot = lsum + __shfl_xor(lsum, 32), inv = ltot > 0.f ? 1.f / ltot : 0.f;
        if (G == 0) {
            bf16* orow = att + qr * 1024 + hd * 128;
#pragma unroll
            for (int d = 0; d < 4; ++d)
#pragma unroll
                for (int g = 0; g < 4; ++g) { u32x2 w; w.x = pk2(O[d][4 * g] * inv, O[d][4 * g + 1] * inv); w.y = pk2(O[d][4 * g + 2] * inv, O[d][4 * g + 3] * inv);
                    *(GAS u32x2*)(orow + 32 * d + 8 * g + 4 * hh) = w; }
        } else {
            unsigned char* orow8 = wsl + WS_ATT8 + qr * 1024 + hd * 128 + 16 * hh; const float sc = inv * ATT8SCALE;
#pragma unroll
            for (int d = 0; d < 4; ++d) { unsigned pc[4];
#pragma unroll
                for (int g = 0; g < 4; ++g) { int ww = 0;
                    ww = __builtin_amdgcn_cvt_pk_fp8_f32(__builtin_amdgcn_fmed3f(O[d][4 * g] * sc, -448.f, 448.f), __builtin_amdgcn_fmed3f(O[d][4 * g + 1] * sc, -448.f, 448.f), ww, false);
                    ww = __builtin_amdgcn_cvt_pk_fp8_f32(__builtin_amdgcn_fmed3f(O[d][4 * g + 2] * sc, -448.f, 448.f), __builtin_amdgcn_fmed3f(O[d][4 * g + 3] * sc, -448.f, 448.f), ww, true); pc[g] = (unsigned)ww; }
                const u32x2 s02 = __builtin_amdgcn_permlane32_swap(pc[0], pc[2], false, false), s13 = __builtin_amdgcn_permlane32_swap(pc[1], pc[3], false, false);
                *(GAS u32x4*)(orow8 + 32 * d) = (u32x4){s02[0], s02[1], s13[0], s13[1]}; }
        }
    }
    __builtin_amdgcn_s_barrier();
}

constexpr int CW_ATTQ = 8256;
DI void phase_mix(const Frame& F, int l) {
#ifndef REPMASK
#define REPMASK 0u
#endif
    volatile LAS int* qslot = (volatile LAS int*)(F.lds + MAIL_OFF);
    const bool spread = (F.G == 256);
    for (int task = spread ? ((F.vcu & 1) ? 128 : (F.vcu >> 1)) : F.vcu; task < 128; task += F.G) {
        const int bh = task >> 2, b = bh >> 3, hd = bh & 7;
        for (int rp = 0; rp < 1 + (int)((REPMASK >> 15) & 1u); ++rp) mlstm_task(F, b, hd, task & 3);
    }
    unsigned* qhead = F.ctl + CW_ATTQ + 64 * l;
    for (;;) {
        if (F.tid == 0) qslot[0] = (int)__hip_atomic_fetch_add(qhead, 1u, __ATOMIC_RELAXED, __HIP_MEMORY_SCOPE_AGENT);
        __syncthreads();
        const int item = __builtin_amdgcn_readfirstlane(qslot[0]);
        __syncthreads();
        if (item >= 32 * 17) break;
        const int G = item < 512 ? 16 - (item >> 5) : 0, bh = item & 31;
        attn_item(F, bh >> 3, bh & 7, G);
    }
}

DI void pass_hmnorm(const Frame& F, PK P, int l) {
    unsigned char* ws = F.ws; const bf16* hraw = (const bf16*)(ws + WS_HRAW); const bf16* z = (const bf16*)(ws + WS_Z); bf16* hm = (bf16*)(ws + WS_HM);
    const float* g = P->in[I_MLNG] + (size_t)l * 2048;
    const int gw = F.vcu * NW + F.wave, NGW = F.G * NW, lane = F.lane;
    u32x4 nh[4], nz[4];
    if (gw < RROWS) {
#pragma unroll
        for (int qd = 0; qd < 4; ++qd) { nh[qd] = *(const u32x4*)(hraw + (size_t)gw * 2048 + 32 * lane + 8 * qd); nz[qd] = *(const u32x4*)(z + (size_t)gw * ZW + ZC_MO + 32 * lane + 8 * qd); } }
    for (int r = gw; r < RROWS; r += NGW) {
        f32x4 x[8]; float ss = 0.f; u32x4 cz[4];
#pragma unroll
        for (int qd = 0; qd < 4; ++qd) { unpack8(nh[qd], x[2 * qd], x[2 * qd + 1]); cz[qd] = nz[qd]; }
        if (r + NGW < RROWS) {
#pragma unroll
            for (int qd = 0; qd < 4; ++qd) { nh[qd] = *(const u32x4*)(hraw + (size_t)(r + NGW) * 2048 + 32 * lane + 8 * qd); nz[qd] = *(const u32x4*)(z + (size_t)(r + NGW) * ZW + ZC_MO + 32 * lane + 8 * qd); } }
#pragma unroll
        for (int i = 0; i < 8; ++i) ss += (x[i][0] * x[i][0] + x[i][1] * x[i][1]) + (x[i][2] * x[i][2] + x[i][3] * x[i][3]);
        ss = grp8_sum(ss);
        const float rs = 1.f / sqrtf(ss * (1.f / 256.f) + RMS_EPS);
#pragma unroll
        for (int qd = 0; qd < 4; ++qd) { f32x4 m0, m1; unpack8(cz[qd], m0, m1);
            const f32x4 g0 = *(const f32x4*)(g + 32 * lane + 8 * qd), g1 = *(const f32x4*)(g + 32 * lane + 8 * qd + 4);
            x[2 * qd] = x[2 * qd] * rs * g0 * sig4(m0); x[2 * qd + 1] = x[2 * qd + 1] * rs * g1 * sig4(m1);
            if (r >= NREAL) *(u32x4*)(hm + (size_t)r * 2048 + 32 * lane + 8 * qd) = pack8(x[2 * qd], x[2 * qd + 1]); }
        if (r < NREAL) { unsigned char* h8 = ws + WS_HM8 + (size_t)r * 2048 + 32 * lane;
#pragma unroll
            for (int hf = 0; hf < 2; ++hf) { u32x4 w;
#pragma unroll
                for (int q2 = 0; q2 < 4; ++q2) { const f32x4 v = x[4 * hf + q2]; int ww = 0;
                    ww = __builtin_amdgcn_cvt_pk_fp8_f32(__builtin_amdgcn_fmed3f(v[0] * A8SCALE, -448.f, 448.f), __builtin_amdgcn_fmed3f(v[1] * A8SCALE, -448.f, 448.f), ww, false);
                    ww = __builtin_amdgcn_cvt_pk_fp8_f32(__builtin_amdgcn_fmed3f(v[2] * A8SCALE, -448.f, 448.f), __builtin_amdgcn_fmed3f(v[3] * A8SCALE, -448.f, 448.f), ww, true); w[q2] = (unsigned)ww; }
                *(u32x4*)(h8 + 16 * hf) = w; } }
    }
}

template <int MODE, int K> DI void mini_meta_gemm(const Frame& F, const bf16* A, const bf16* Bt) {
    unsigned char* ws = F.ws;
    if (F.vcu >= 128) return;
    const int lane = F.lane, l15 = lane & 15, lq = lane >> 4, n0 = F.vcu * 16;
    constexpr int KW = K / 8;
    const bf16* ap = A + (size_t)(NREAL + PADL + l15) * K + F.wave * KW + 8 * lq; const bf16* bp = Bt + (size_t)(n0 + l15) * K + F.wave * KW + 8 * lq;
    f32x4 acc = (f32x4){0.f, 0.f, 0.f, 0.f};
#pragma unroll
    for (int kk = 0; kk < KW / 32; ++kk) acc = MFMA16(*(const bf16x8*)(bp + kk * 32), *(const bf16x8*)(ap + kk * 32), acc);
    LAS f32x4* red = (LAS f32x4*)F.lds;
    red[F.wave * 64 + lane] = acc;
    __syncthreads();
    if (F.wave == 0) {
#pragma unroll
        for (int w = 1; w < 8; ++w) acc += red[w * 64 + lane];
        const int col = n0 + 4 * lq; const size_t r0 = (size_t)(NREAL + PADL + l15);
        if (MODE == 2) { const bf16* hb = (const bf16*)(ws + WS_HB); bf16* rr = (bf16*)(ws + WS_H); const u32x2 hw = *(const u32x2*)(hb + r0 * DM + col);
            const f32x4 o = (f32x4){bflo(hw.x), bfhi(hw.x), bflo(hw.y), bfhi(hw.y)} * ALPHA + acc; u32x2 w; w.x = pk2(o[0], o[1]); w.y = pk2(o[2], o[3]);
#pragma unroll
            for (int b = 0; b < NBATCH; ++b) *(u32x2*)(rr + (r0 + 64 * b) * DM + col) = w; }
        else { const bf16* z = (const bf16*)(ws + WS_Z); bf16* tb = (bf16*)(ws + WS_TBUF); bf16* y = (bf16*)(ws + WS_Y);
            const u32x2 gw = *(const u32x2*)(z + r0 * ZW + (MODE == 0 ? ZC_GA : ZC_GB) + col);
            f32x4 o = (f32x4){sigmoidf_(bflo(gw.x)), sigmoidf_(bfhi(gw.x)), sigmoidf_(bflo(gw.y)), sigmoidf_(bfhi(gw.y))} * acc;
            if (MODE == 1) { const u32x2 pw = *(const u32x2*)(tb + r0 * DM + col); o += (f32x4){bflo(pw.x), bfhi(pw.x), bflo(pw.y), bfhi(pw.y)}; }
            u32x2 w; w.x = pk2(o[0], o[1]); w.y = pk2(o[2], o[3]); bf16* dst = MODE == 0 ? tb : y;
#pragma unroll
            for (int b = 0; b < NBATCH; ++b) *(u32x2*)(dst + (r0 + 64 * b) * DM + col) = w; }
    }
    __syncthreads();
}

typedef int v8i __attribute__((ext_vector_type(8)));
constexpr int CW_FP8BAD = 8192;
DI void fp8_selftest(const Frame& F) {
    if (F.vcu != 0 || F.wave != 0) return;
    const int l = F.lane, i = l & 15, kb = l >> 4;
    v8i A, B;
#pragma unroll
    for (int q = 0; q < 8; ++q) { int wa = 0, wb = 0; float av[4], bv[4];
#pragma unroll
        for (int e = 0; e < 4; ++e) { const int k = 32 * kb + 4 * q + e; av[e] = (float)(((i * 7 + k * 3) % 9) - 4); bv[e] = (float)(((k * 5 + i * 11) % 7) - 3); }
        wa = __builtin_amdgcn_cvt_pk_fp8_f32(av[0], av[1], wa, false); wa = __builtin_amdgcn_cvt_pk_fp8_f32(av[2], av[3], wa, true);
        wb = __builtin_amdgcn_cvt_pk_fp8_f32(bv[0], bv[1], wb, false); wb = __builtin_amdgcn_cvt_pk_fp8_f32(bv[2], bv[3], wb, true);
        A[q] = wa; B[q] = wb; }
    f32x4 c = (f32x4){0.f, 0.f, 0.f, 0.f};
    c = __builtin_amdgcn_mfma_scale_f32_16x16x128_f8f6f4(A, B, c, 0, 0, 0, 0x7F7F7F7F, 0, 0x7F7F7F7F);
    bool bad = false;
#pragma unroll
    for (int rg = 0; rg < 4; ++rg) { const int ii = 4 * (l >> 4) + rg, jj = l & 15; int ref = 0;
        for (int k = 0; k < 128; ++k) ref += (((ii * 7 + k * 3) % 9) - 4) * (((k * 5 + jj * 11) % 7) - 3);
        bad |= (c[rg] != (float)ref); }
    f32x4 c2 = (f32x4){0.f, 0.f, 0.f, 0.f};
    c2 = __builtin_amdgcn_mfma_scale_f32_16x16x128_f8f6f4(A, B, c2, 0, 0, 0, 0x7F7F7F7F, 0, 0x79797979);
#pragma unroll
    for (int rg = 0; rg < 4; ++rg) bad |= (c2[rg] * 64.f != c[rg]);
    { const int i3 = l & 31, kb3 = l >> 5; v8i A3, B3;
#pragma unroll
      for (int q = 0; q < 8; ++q) { int wa = 0, wb = 0; float av[4], bv[4];
#pragma unroll
          for (int e = 0; e < 4; ++e) { const int k = 32 * kb3 + 4 * q + e; av[e] = (float)(((i3 * 7 + k * 3) % 9) - 4); bv[e] = (float)(((k * 5 + i3 * 11) % 7) - 3); }
          wa = __builtin_amdgcn_cvt_pk_fp8_f32(av[0], av[1], wa, false); wa = __builtin_amdgcn_cvt_pk_fp8_f32(av[2], av[3], wa, true);
          wb = __builtin_amdgcn_cvt_pk_fp8_f32(bv[0], bv[1], wb, false); wb = __builtin_amdgcn_cvt_pk_fp8_f32(bv[2], bv[3], wb, true);
          A3[q] = wa; B3[q] = wb; }
      f32x16 c3;
#pragma unroll
      for (int i = 0; i < 16; ++i) c3[i] = 0.f;
      c3 = __builtin_amdgcn_mfma_scale_f32_32x32x64_f8f6f4(A3, B3, c3, 0, 0, 0, 0x7F7F7F7F, 0, 0x7F7F7F7F);
#pragma unroll
      for (int rg = 0; rg < 16; ++rg) { const int ii = (rg & 3) + 8 * (rg >> 2) + 4 * (l >> 5), jj = l & 31; int ref = 0;
          for (int k = 0; k < 64; ++k) ref += (((ii * 7 + k * 3) % 9) - 4) * (((k * 5 + jj * 11) % 7) - 3);
          bad |= (c3[rg] != (float)ref); } }
    if (__any(bad) && l == 0) F.ctl[CW_FP8BAD] = 1u;
}

constexpr int RT_LSTR = 68;
DI void phase_ln1_route(const Frame& F, PK P, int l) {
    unsigned char* ws = F.ws; LAS unsigned char* L = F.lds;
    const bf16* rr = (const bf16*)(ws + WS_H); bf16* hb = (bf16*)(ws + WS_HB);
    const float* eb = P->in[I_EBIAS] + (size_t)l * 64;
    int* selE = (int*)(ws + WS_SELE); float* selW = (float*)(ws + WS_SELW); int* locG = (int*)(ws + WS_LOC); int* cntT = (int*)(ws + WS_CNT);
    LAS unsigned long long* colp = (LAS unsigned long long*)L; LAS unsigned long long* col = (LAS unsigned long long*)(L + 4096); LAS int* colhi = (LAS int*)(L + 4608); LAS int* sE = (LAS int*)(L + 5120); LAS float* red = (LAS float*)(L + 8192);
    const float ebv = eb[F.lane];
    const int lane = F.lane;
    { int* tokI = (int*)(ws + WS_TOK); for (int i = F.vcu * NT + F.tid; i < PROWS; i += F.G * NT) tokI[i] = 0; }
    for (int wg = F.vcu; wg < 256; wg += F.G) {
        { u32x4 nx[4];
#pragma unroll
          for (int j = 0; j < 4; ++j) nx[j] = *(const u32x4*)(rr + (size_t)(65 * wg + F.wave) * DM + LNCOL(lane, j));
          for (int i = F.wave; i < 65; i += NW) { const int r = 65 * wg + i; f32x4 v[8];
#pragma unroll
            for (int j = 0; j < 4; ++j) unpack8(nx[j], v[2 * j], v[2 * j + 1]);
            if (i + NW < 65) {
#pragma unroll
                for (int j = 0; j < 4; ++j) nx[j] = *(const u32x4*)(rr + (size_t)(r + NW) * DM + LNCOL(lane, j)); }
            ln_store(v, P->in[I_LN1G] + (size_t)l * DM, P->in[I_LN1B] + (size_t)l * DM, hb + (size_t)r * DM, lane, MOE_FP8 ? ws + WS_HB8 + (size_t)r * DM : nullptr); } }
        __syncthreads();
        { const int l15 = lane & 15, lq = lane >> 4, kq = F.wave >> 1, nh = F.wave & 1;
          const bf16* wp = (const bf16*)(ws + WS_WR) + (size_t)(32 * nh + l15) * DM + kq * 512 + 8 * lq;
          const bf16* tp = hb + (size_t)(65 * wg) * DM + kq * 512 + 8 * lq;
          unsigned to[5];
#pragma unroll
          for (int t = 0; t < 5; ++t) { const int tr = t * 16 + l15; to[t] = (unsigned)((tr < 65 ? tr : 64) * DM); }
          f32x4 acc[5][2];
#pragma unroll
          for (int t = 0; t < 5; ++t) { acc[t][0] = (f32x4){0.f, 0.f, 0.f, 0.f}; acc[t][1] = (f32x4){0.f, 0.f, 0.f, 0.f}; }
#pragma unroll 1
          for (int k0 = 0; k0 < 512; k0 += 128) { bf16x8 wf[4][2], tf[4][5];
#pragma unroll
              for (int s = 0; s < 4; ++s) { wf[s][0] = *(const bf16x8*)(wp + k0 + 32 * s); wf[s][1] = *(const bf16x8*)(wp + 16 * DM + k0 + 32 * s);
#pragma unroll
                  for (int t = 0; t < 5; ++t) tf[s][t] = *(const bf16x8*)(tp + to[t] + k0 + 32 * s); }
#pragma unroll
              for (int s = 0; s < 4; ++s)
#pragma unroll
                  for (int t = 0; t < 5; ++t) { acc[t][0] = MFMA16(wf[s][0], tf[s][t], acc[t][0]); acc[t][1] = MFMA16(wf[s][1], tf[s][t], acc[t][1]); } }
#pragma unroll
          for (int t = 0; t < 5; ++t)
#pragma unroll
              for (int c = 0; c < 2; ++c) *(LAS f32x4*)(red + (kq * 80 + t * 16 + l15) * RT_LSTR + 32 * nh + 16 * c + 4 * lq) = acc[t][c]; }
        __syncthreads();
        unsigned long long mycol = 0ull; int myhi = 0;
        for (int i = F.wave; i < 65; i += NW) { const int r = 65 * wg + i;
            const float lgv = (red[i * RT_LSTR + lane] + red[(80 + i) * RT_LSTR + lane]) + (red[(160 + i) * RT_LSTR + lane] + red[(240 + i) * RT_LSTR + lane]);
            const float s = 1.f / (1.f + expf(-lgv)), bsc = s + ebv;
            const float m1 = grp8_max(bsc);
            const unsigned long long eqb = __ballot(bsc == m1);
            const unsigned gb = (unsigned)(eqb >> (lane & 56)) & 0xFFu;
            const bool first = (lane & 7) == (__ffs((int)gb) - 1);
            const float m2 = grp8_max(first ? -INFINITY : bsc);
            const float gs = m1 + m2;
            int grank = 0; const int g = lane >> 3;
#pragma unroll
            for (int g2 = 0; g2 < 8; ++g2) { const float v = rlane(gs, 8 * g2); grank += (v > gs || (v == gs && g2 < g)) ? 1 : 0; }
            float rem = grank < 4 ? bsc : -INFINITY; int rank = 8;
#pragma unroll
            for (int k = 0; k < 8; ++k) { const float m = wave_max(rem); const unsigned long long bb = __ballot(rem == m); const int win = (int)__builtin_ctzll(bb); if (lane == win) { rank = k; rem = -INFINITY; } }
            const bool chosen = rank < 8;
            const float ssum = wave_sum(chosen ? s : 0.f);
            if (chosen) { selE[(size_t)r * 8 + rank] = lane; selW[(size_t)r * 8 + rank] = s / ssum * 2.5f; sE[i * 8 + rank] = lane; }
            if (i < 64) mycol |= chosen ? (1ull << i) : 0ull; else myhi = chosen ? 1 : 0;
        }
        colp[F.wave * 64 + lane] = mycol; if (F.wave == 0) colhi[lane] = myhi;
        __syncthreads();
        if (F.tid < 64) { unsigned long long c = 0ull;
#pragma unroll
            for (int w = 0; w < NW; ++w) c |= colp[w * 64 + F.tid];
            col[F.tid] = c; cntT[wg * 64 + F.tid] = __popcll(c) + colhi[F.tid]; }
        __syncthreads();
        for (int idx = F.tid; idx < 520; idx += NT) { const int i = idx >> 3, e = sE[idx]; const unsigned long long c = col[e];
            locG[(size_t)(65 * wg + i) * 8 + (idx & 7)] = i < 64 ? __popcll(c & ((1ull << i) - 1ull)) : __popcll(c); }
        __syncthreads();
    }
}
DI void phase_route2(const Frame& F) {
    unsigned char* ws = F.ws; LAS unsigned char* L = F.lds;
    const int* selE = (const int*)(ws + WS_SELE); const int* locG = (const int*)(ws + WS_LOC); const int* cntT = (const int*)(ws + WS_CNT);
    int* posG = (int*)(ws + WS_POS); int* tileE = (int*)(ws + WS_TILEE); int* tokI = (int*)(ws + WS_TOK);
    LAS int* base = (LAS int*)L; const int lane = F.lane;
    for (int wg = F.vcu; wg < 256; wg += F.G) {
        { const int e = F.tid & 63, sl = F.tid >> 6; int tot = 0, pre = 0;
#pragma unroll 8
          for (int w2 = 32 * sl; w2 < 32 * sl + 32; ++w2) { const int c = cntT[w2 * 64 + e]; tot += c; if (w2 < wg) pre += c; }
          base[128 + F.tid] = tot; base[640 + F.tid] = pre; }
        __syncthreads();
        if (F.tid < 64) { const int e = F.tid; int tot = 0, pre = 0;
#pragma unroll
            for (int sl = 0; sl < 8; ++sl) { tot += base[128 + 64 * sl + e]; pre += base[640 + 64 * sl + e]; }
            const int pc = (tot + 255) & ~255; int incl = pc;
#pragma unroll
            for (int o = 1; o < 64; o <<= 1) { const int t = __shfl_up(incl, o); if (lane >= o) incl += t; }
            const int pstart = incl - pc; base[e] = pstart + pre;
            if (e == 63) base[64] = (pstart + pc) >> 8;
            if (wg == 0) { for (int tau = pstart >> 8; tau < ((pstart + pc) >> 8); ++tau) tileE[8 + tau] = e; if (e == 63) tileE[0] = (pstart + pc) >> 8; }
        }
        __syncthreads();
        const int ntr = base[64];
        for (int idx = F.tid; idx < 65 * 8; idx += NT) { const int r = 65 * wg + (idx >> 3); const int dest = base[selE[(size_t)r * 8 + (idx & 7)]] + locG[(size_t)r * 8 + (idx & 7)]; posG[(size_t)r * 8 + (idx & 7)] = dest; tokI[dest] = r; }
        for (int i = F.tid; i < 65; i += NT) { const int r = 65 * wg + i; tokI[ntr * 256 + r] = r; }
        __syncthreads();
    }
}
DI void phase_combine(const Frame& F, PK P, int l) {
    unsigned char* ws = F.ws; bf16* hb = (bf16*)(ws + WS_HB); const unsigned char* ya = (const unsigned char*)(ws + WS_XG);
    const int* posG = (const int*)(ws + WS_POS); const float* selW = (const float*)(ws + WS_SELW); const int* tileE = (const int*)(ws + WS_TILEE);
    const int gw = F.vcu * NW + F.wave, NGW = F.G * NW, lane = F.lane; const int ntr = tileE[0];
    const bool poison = (l == 1) && (__hip_atomic_load(F.ctl + CW_FP8BAD, __ATOMIC_RELAXED, __HIP_MEMORY_SCOPE_AGENT) != 0u);
    int npos = 0; float nw = 0.f; u32x4 nhb[4];
    if (gw < RROWS) { if (lane < 8) { npos = posG[(size_t)gw * 8 + lane]; nw = selW[(size_t)gw * 8 + lane]; }
#pragma unroll
        for (int j = 0; j < 4; ++j) nhb[j] = *(const u32x4*)(hb + (size_t)gw * DM + LNCOL(lane, j)); }
    for (int r = gw; r < RROWS; r += NGW) {
        const int pos = npos; const float w = nw;
        f32x4 v[8];
#pragma unroll
        for (int j = 0; j < 4; ++j) { unpack8(nhb[j], v[2 * j], v[2 * j + 1]); v[2 * j] = v[2 * j] * ALPHA; v[2 * j + 1] = v[2 * j + 1] * ALPHA; }
        if (r + NGW < RROWS) { if (lane < 8) { npos = posG[(size_t)(r + NGW) * 8 + lane]; nw = selW[(size_t)(r + NGW) * 8 + lane]; }
#pragma unroll
            for (int j = 0; j < 4; ++j) nhb[j] = *(const u32x4*)(hb + (size_t)(r + NGW) * DM + LNCOL(lane, j)); }
#pragma unroll
        for (int k = 0; k < 9; ++k) { const int row = k < 8 ? __builtin_amdgcn_readlane(pos, k) : ntr * 256 + r; const float wk = (k < 8 ? rlane(w, k) : 1.f) * (1.f / Y8SCALE);
            const unsigned char* yr = ya + (size_t)row * DM;
#pragma unroll
            for (int j = 0; j < 4; ++j) { const u32x2 yw = *(const u32x2*)(yr + LNCOL(lane, j));
                const f32x2 a0 = __builtin_amdgcn_cvt_pk_f32_fp8((int)yw.x, false), a1 = __builtin_amdgcn_cvt_pk_f32_fp8((int)yw.x, true), a2 = __builtin_amdgcn_cvt_pk_f32_fp8((int)yw.y, false), a3 = __builtin_amdgcn_cvt_pk_f32_fp8((int)yw.y, true);
                v[2 * j] += (f32x4){a0[0], a0[1], a1[0], a1[1]} * wk; v[2 * j + 1] += (f32x4){a2[0], a2[1], a3[0], a3[1]} * wk; } }
        ln_store(v, P->in[I_LN2G] + (size_t)l * DM, P->in[I_LN2B] + (size_t)l * DM, hb + (size_t)r * DM, lane, l == 0 ? ws + WS_HB8 + (size_t)r * DM : nullptr);
        if (l == 1) {
            if (r < NREAL) { float* o = P->out + (size_t)r * DM;
#pragma unroll
                for (int j = 0; j < 4; ++j) { const int c = LNCOL(lane, j); if (poison) { v[2 * j] = (f32x4){NAN, NAN, NAN, NAN}; v[2 * j + 1] = v[2 * j]; } *(f32x4*)(o + c) = v[2 * j]; *(f32x4*)(o + c + 4) = v[2 * j + 1]; } } }
    }
}

constexpr int NPHASE = 25;
#ifndef PHMASK
#define PHMASK 0xFFFFFFFFu
#endif
#define EN(j) ((PHMASK >> (j)) & 1u)
#ifndef REPMASK
#define REPMASK 0u
#endif
#define REP(j) for (int rep_ = 0; rep_ < 1 + (int)((REPMASK >> (j)) & 1u); ++rep_)
#define IN(k) (lo <= (k) && (k) < hi)
#define PHASE_BEGIN PK P = kargs(); unsigned char* ws = P->ws; Frame F = F0; asm volatile("" : "+s"(F.wave), "+s"(F.vcu), "+s"(F.G)); F.lane = lane_id(); asm volatile("" : "+v"(F.lane)); F.tid = F.wave * 64 + F.lane; F.ws = ws; F.ctl = (unsigned*)(ws + WS_CTL); \
        LAS unsigned char* ring = F.lds; const int G = F.G; int cid = (int)blockIdx.x; asm volatile("" : "+s"(cid)); (void)ring; (void)G; (void)cid;
#define SEAM(k) do { if (IN(k) && IN((k) + 1)) { PK Pb = kargs(); XcdBarrier bar; bar.bar = (unsigned*)(Pb->ws + WS_CTL); bar.x = xb_xcc_id(); bar.st = MISC + 8; xcd_barrier(bar, F0.wave == 0 && lane_id() == 0); } } while (0)


template <int L> DI void run_layer(const Frame& F0, volatile LAS unsigned* MISC, const int lo, const int hi) {
    constexpr int l = L;
        constexpr int pb = 1 + 12 * L;
        if (EN(0) && IN(pb + 0)) REP(0) { PHASE_BEGIN;
            { InProjOrderA S; S.init(ws + WS_HB, ws + WS_WIN, G, cid);
              EpiInProj E{(bf16*)(ws + WS_Z), (float*)(ws + WS_ZS), (const float*)(ws + WS_BIAS), F.lds + EPI_OFF};
              pg8::gemm_phase<DM * 2, DM * 2, DM * 2>(ring, F.tid, S, E); }
            { PHASE_BEGIN;
              InProjOrder8 S; S.init(ws + WS_HB8, ws + WS_WIN8, G, cid);
              EpiInProj8 E{(bf16*)(ws + WS_Z), (const float*)(ws + WS_BIAS), F.lds + EPI_OFF};
              pg8::gemm_phase<DM, DM, DM, false, true, 127, 121>(ring, F.tid, S, E); }
        } SEAM(pb + 0);
        if (EN(1) && IN(pb + 1)) REP(1) { PHASE_BEGIN; phase_prep(F, P, l); } SEAM(pb + 1);
        if (EN(2) && IN(pb + 2)) REP(2) {
            { PHASE_BEGIN; pg8::StaticOrder<ZW * 2, 1024, RROWS / 256, 6> S; S.init(ws + WS_Z + (size_t)ZC_CQ * 2, ws + WS_WUQ, G, cid);
              EpiRowScale E{(bf16*)(ws + WS_Q), 1536, (const float*)(ws + WS_RSTD), 2, F.lds + EPI_OFF}; pg8::gemm_phase<ZW * 2, 1024, 1024>(ring, F.tid, S, E); }
            { PHASE_BEGIN; pg8::StaticOrder<ZW * 2, 1024, RROWS / 256, 4> S; S.init(ws + WS_Z + (size_t)ZC_CKV * 2, ws + WS_WKV, G, (cid + G - (RROWS / 256 * 6) % G) % G);
              EpiRowScale E{(bf16*)(ws + WS_KN), 1024, (const float*)(ws + WS_RSTD) + 1, 2, F.lds + EPI_OFF}; pg8::gemm_phase<ZW * 2, 1024, 1024>(ring, F.tid, S, E); }
            { PHASE_BEGIN; pg8::StaticOrder<1024, ZW * 2, 4, RROWS / 256> S; S.init(ws + WS_WKV + (size_t)1024 * 512 * 2, ws + WS_Z + (size_t)ZC_CKV * 2, G, (cid + 2 * G - (RROWS / 256 * 10) % G) % G);
              EpiColScale E{(bf16*)(ws + WS_VT), RROWS, (const float*)(ws + WS_RSTD) + 1, 2, F.lds + EPI_OFF}; pg8::gemm_phase<1024, ZW * 2, 1024>(ring, F.tid, S, E); }
        } SEAM(pb + 2);
        if (EN(3) && IN(pb + 3)) REP(3) { PHASE_BEGIN; phase_mix(F, l); } SEAM(pb + 3);
        if (EN(4) && IN(pb + 4)) REP(4) {
            { PHASE_BEGIN; pass_hmnorm(F, P, l); }
            { PHASE_BEGIN; mini_meta_gemm<0, 1024>(F, (const bf16*)(ws + WS_ATT), (const bf16*)(ws + WS_WBRA)); }
            { PHASE_BEGIN; pg8::StaticOrder<1024, 1024, NREAL / 256, 8> S; S.init(ws + WS_ATT8, ws + WS_WBRA8, G, cid);
              EpiGate8<0, 0> E{(void*)(ws + WS_TBUF), (const bf16*)(ws + WS_Z) + ZC_GA, nullptr, F.lds + EPI_OFF}; pg8::gemm_phase<1024, 1024, 1024, false, true, 123, 121>(ring, F.tid, S, E); }
        } SEAM(pb + 4);
        if (EN(5) && IN(pb + 5)) REP(5) { PHASE_BEGIN;
            mini_meta_gemm<1, DM>(F, (const bf16*)(ws + WS_HM), (const bf16*)(ws + WS_WBRB));
            pg8::StaticOrder<DM, DM, NREAL / 256, 8> S; S.init(ws + WS_HM8, ws + WS_WBRB8, G, cid);
            EpiGate8<1, 1> E{(void*)(ws + WS_Y8), (const bf16*)(ws + WS_Z) + ZC_GB, (const bf16*)(ws + WS_TBUF), F.lds + EPI_OFF}; pg8::gemm_phase<DM, DM, DM, false, true, 124, 121>(ring, F.tid, S, E);
        } SEAM(pb + 5);
        if (EN(6) && IN(pb + 6)) REP(6) { PHASE_BEGIN;
            mini_meta_gemm<2, DM>(F, (const bf16*)(ws + WS_Y), (const bf16*)(ws + WS_WOUT));
            pg8::StaticOrder<DM, DM, NREAL / 256, 8> S; S.init(ws + WS_Y8, ws + WS_WOUT8, G, cid);
            EpiResid8 E{(const bf16*)(ws + WS_HB), (bf16*)(ws + WS_H), F.lds + EPI_OFF}; pg8::gemm_phase<DM, DM, DM, false, true, 124, 121>(ring, F.tid, S, E);
        } SEAM(pb + 6);
        if (EN(7) && IN(pb + 7)) REP(7) { PHASE_BEGIN; phase_ln1_route(F, P, l); } SEAM(pb + 7);
        if (EN(8) && IN(pb + 8)) REP(8) { PHASE_BEGIN; phase_route2(F); } SEAM(pb + 8);
        if (EN(9) && IN(pb + 9)) REP(9) { PHASE_BEGIN;
#if MOE_FP8
            MoeOrder<4, 2048, true> S; S.init(ws + WS_HB8, ws + WS_W13, (const int*)(ws + WS_TILEE), (const int*)(ws + WS_TOK), F.lds, F.tid, G, cid);
            EpiSwiGLU8 E{(unsigned char*)(ws + WS_HBUF)}; pg8::gemm_phase<DM, DM, DM, true, true, 127, 121>(ring, F.tid, S, E);
#else
            MoeOrder<4, 4096, true> S; S.init(ws + WS_HB, ws + WS_W13, (const int*)(ws + WS_TILEE), (const int*)(ws + WS_TOK), F.lds, F.tid, G, cid);
            EpiSwiGLU E{(unsigned char*)(ws + WS_HBUF), F.lds + EPI_OFF}; pg8::gemm_phase<DM * 2, DM * 2, DM * 2, true>(ring, F.tid, S, E);
#endif
        } SEAM(pb + 9);
        if (EN(10) && IN(pb + 10)) REP(10) { PHASE_BEGIN;
#if MOE_FP8
            MoeOrder<8, 512, false> S; S.init(ws + WS_HBUF, ws + WS_W2, (const int*)(ws + WS_TILEE), (const int*)(ws + WS_TOK), F.lds, F.tid, G, cid);
            EpiPlain8 E{(unsigned char*)(ws + WS_XG), F.lds + EPI_OFF}; pg8::gemm_phase<512, 512, 512, false, true, 124, 121>(ring, F.tid, S, E);
#else
            MoeOrder<8, 1024, false> S; S.init(ws + WS_HBUF, ws + WS_W2, (const int*)(ws + WS_TILEE), (const int*)(ws + WS_TOK), F.lds, F.tid, G, cid);
            EpiPlain E{(bf16*)(ws + WS_XG), DM, F.lds + EPI_OFF}; pg8::gemm_phase<1024, 1024, 1024, false, false>(ring, F.tid, S, E);
#endif
        } SEAM(pb + 10);
        if (EN(11) && IN(pb + 11)) REP(11) { { PHASE_BEGIN; phase_combine(F, P, l); } if (l == 0) { PHASE_BEGIN; convert_layer(F, P, 1); } } SEAM(pb + 11);
    }

__global__ void __launch_bounds__(NT, 2) mega_fwd(Params Pv) {
    extern __shared__ __attribute__((aligned(16))) unsigned char lds_raw[];
    Frame F0;
    F0.lds = (LAS unsigned char*)lds_raw;
    F0.tid = 0; F0.lane = 0; F0.wave = __builtin_amdgcn_readfirstlane((int)threadIdx.x >> 6);
    F0.G = gridDim.x; { const int bx = blockIdx.x; F0.vcu = (F0.G % 8 == 0) ? (bx % 8) * (F0.G / 8) + bx / 8 : bx; }
    F0.ws = nullptr; F0.ctl = nullptr;
    volatile LAS unsigned* MISC = (volatile LAS unsigned*)(F0.lds + MISC_OFF);
    if (threadIdx.x < 32) MISC[threadIdx.x] = 0u;
    __syncthreads();
    const int lo = Pv.ph_lo, hi = Pv.ph_hi;
    if (hi - lo > 1) { PK P = kargs(); (void)xcd_barrier_post((unsigned*)(P->ws + WS_CTL), MISC + 8); }
    if (EN(14) && IN(0)) REP(14) { PHASE_BEGIN; phase_prologue(F, P); } SEAM(0);
    run_layer<0>(F0, MISC, lo, hi);
    run_layer<1>(F0, MISC, lo, hi);
}


#ifndef MK_PER_PHASE
#define MK_PER_PHASE 0
#endif
extern "C" void kernel_launch(void* const* d_in, const int* in_sizes, int n_in, void* d_out, int out_size, void* d_ws, size_t ws_size, hipStream_t stream) {
    static int grid = 0;
    if (grid == 0) {
        if (n_in != 28 || ws_size < WS_END) { fprintf(stderr, "kernel_launch: unexpected inputs (n_in %d, ws %zu, need %zu)\n", n_in, ws_size, (size_t)WS_END); grid = -1; return; }
        int dev = 0, cus = 0;
        if (hipGetDevice(&dev) != hipSuccess || hipDeviceGetAttribute(&cus, hipDeviceAttributeMultiprocessorCount, dev) != hipSuccess) { grid = -1; return; }
        if (hipFuncSetAttribute((const void*)mega_fwd, hipFuncAttributeMaxDynamicSharedMemorySize, LDS_BYTES) != hipSuccess) { grid = -1; return; }
        int per_cu = 0;
        (void)hipOccupancyMaxActiveBlocksPerMultiprocessor(&per_cu, (const void*)mega_fwd, NT, LDS_BYTES);
        (void)hipGetLastError();
        grid = cus;
    }
    if (grid < 0) return;
    (void)hipMemsetAsync((char*)d_ws + WS_CTL, 0, 65536, stream);
    Params p{};
    for (int i = 0; i < 28; ++i) p.in[i] = (const float*)d_in[i];
    p.out = (float*)d_out; p.ws = (unsigned char*)d_ws;
#if MK_PER_PHASE
    for (int ph = 0; ph < NPHASE; ++ph) { p.ph_lo = ph; p.ph_hi = ph + 1; hipLaunchKernelGGL(mega_fwd, dim3(grid), dim3(NT), LDS_BYTES, stream, p); }
#else
    p.ph_lo = 0; p.ph_hi = NPHASE; hipLaunchKernelGGL(mega_fwd, dim3(grid), dim3(NT), LDS_BYTES, stream, p);
#endif
}
```

```cpp
#include <hip/hip_runtime.h>
#include <stdint.h>
#include <stdio.h>

#define LAS __attribute__((address_space(3)))
typedef unsigned short bf16;
typedef short bf16x8 __attribute__((ext_vector_type(8)));
typedef float f32x2 __attribute__((ext_vector_type(2)));
typedef float f32x4 __attribute__((ext_vector_type(4)));
typedef float f32x16 __attribute__((ext_vector_type(16)));
typedef unsigned u32x2 __attribute__((ext_vector_type(2)));
typedef unsigned u32x4 __attribute__((ext_vector_type(4)));
typedef __bf16 bf16x2v __attribute__((ext_vector_type(2)));
#define DI __device__ __forceinline__

constexpr int DM = 2048, NBATCH = 4, SEQ = 4096, NMETA = 16, PADL = 48, TP = 4160, RROWS = NBATCH * TP, NREAL = NBATCH * SEQ;
__host__ __device__ __forceinline__ int chunk_row0(int b, int c) { return c == 0 ? NREAL + 64 * b : b * SEQ + 64 * (c - 1); }
constexpr int INW = 11344, ZW = 11520;
constexpr int ZC_CQ = 0, ZC_CKV = 512, ZC_MQ = 1024, ZC_MK = 2048, ZC_MV = 3072, ZC_MO = 5120, ZC_GA = 7168, ZC_GB = 9216, ZC_S = 11264;
constexpr int NEXP = 64, DEXP = 512, TOPK = 8;
#ifndef ZC_F8_START
#define ZC_F8_START ZC_MQ
#endif
constexpr int ZC_F8 = ZC_F8_START, NT_BF = ZC_F8 / 256, NT_F8 = (ZC_S - ZC_F8) / 256;
constexpr int MAXRT = 584, NSHT = RROWS / 256, MAXTILES = MAXRT + NSHT, PROWS = MAXTILES * 256;
constexpr float ALPHA = 1.41421356237f, LN_EPS = 1e-5f, RMS_EPS = 1e-6f;
constexpr float QSCALE = 0.07216878364870322f * 1.4426950408889634f;
constexpr int NW = 8, NT = 512;

constexpr size_t al4k(size_t x) { return (x + 4095) & ~(size_t)4095; }
constexpr size_t WS_CTL = 0, CTL_BYTES = 1u << 20;
constexpr size_t WS_WIN = CTL_BYTES;
constexpr size_t WS_WIN8 = WS_WIN + al4k((size_t)ZW * DM * 2);
constexpr size_t WS_WUQ = WS_WIN8 + al4k((size_t)(ZC_S - ZC_F8) * DM);
constexpr size_t WS_WKV = WS_WUQ + al4k((size_t)1536 * 512 * 2);
constexpr size_t WS_WBRA = WS_WKV + al4k((size_t)2048 * 512 * 2);
constexpr size_t WS_WBRB = WS_WBRA + al4k((size_t)2048 * 1024 * 2);
constexpr size_t WS_WOUT = WS_WBRB + al4k((size_t)2048 * 2048 * 2);
constexpr size_t WS_WR = WS_WOUT + al4k((size_t)2048 * 2048 * 2);
constexpr size_t WS_W13 = WS_WR + al4k((size_t)256 * 2048 * 2);
constexpr size_t WS_W2 = WS_W13 + al4k((size_t)65 * 1024 * 2048 * 2);
constexpr size_t WS_BIAS = WS_W2 + al4k((size_t)65 * 2048 * 512 * 2);
constexpr size_t WS_ROPE = WS_BIAS + al4k((size_t)ZW * 4);
constexpr size_t WS_H = WS_ROPE + al4k((size_t)TP * 64 * 4);
constexpr size_t WS_HB = WS_H + al4k((size_t)RROWS * DM * 4);
constexpr size_t WS_HB8 = WS_HB + al4k((size_t)RROWS * DM * 2);
constexpr size_t WS_SCR = WS_HB8 + al4k((size_t)RROWS * DM);
constexpr size_t WS_Z = WS_SCR;
constexpr size_t WS_ZS = WS_Z + al4k((size_t)RROWS * ZW * 2);
constexpr size_t WS_Q = WS_ZS + al4k((size_t)RROWS * 128 * 4);
constexpr size_t WS_KN = WS_Q + al4k((size_t)RROWS * 1536 * 2);
constexpr size_t WS_VT = WS_KN + al4k((size_t)RROWS * 1024 * 2);
constexpr size_t WS_KRR = WS_VT + al4k((size_t)RROWS * 1024 * 2);
constexpr size_t WS_QKC = WS_KRR + al4k((size_t)RROWS * 64 * 2);
constexpr size_t WS_GATES = WS_QKC + al4k((size_t)RROWS * 2048 * 2);
constexpr size_t WS_RSTD = WS_GATES + al4k((size_t)RROWS * 16 * 4);
constexpr size_t WS_ATT = WS_RSTD + al4k((size_t)RROWS * 2 * 4);
constexpr size_t WS_HRAW = WS_ATT + al4k((size_t)RROWS * 1024 * 2);
constexpr size_t WS_HM = WS_HRAW + al4k((size_t)RROWS * 2048 * 2);
constexpr size_t WS_MIX_END = WS_HM + al4k((size_t)RROWS * 2048 * 2);
constexpr size_t WS_TBUF = WS_Q;
constexpr size_t WS_Y = WS_QKC;
static_assert((size_t)RROWS * 2048 * 2 <= WS_VT - WS_Q, "tbuf overlay");
constexpr size_t WS_XG = WS_SCR;
constexpr size_t WS_HBUF = WS_XG + al4k((size_t)PROWS * 2048 * 2);
constexpr size_t WS_LOGIT = WS_HBUF + al4k((size_t)PROWS * 512 * 2);
constexpr size_t WS_SELE = WS_LOGIT + al4k((size_t)RROWS * 64 * 4);
constexpr size_t WS_SELW = WS_SELE + al4k((size_t)RROWS * 8 * 4);
constexpr size_t WS_LOC = WS_SELW + al4k((size_t)RROWS * 8 * 4);
constexpr size_t WS_POS = WS_LOC + al4k((size_t)RROWS * 8 * 4);
constexpr size_t WS_CNT = WS_POS + al4k((size_t)RROWS * 8 * 4);
constexpr size_t WS_TILEE = WS_CNT + al4k((size_t)256 * 64 * 4);
constexpr size_t WS_TOK = WS_TILEE + al4k((size_t)(MAXTILES + 8) * 4);
constexpr size_t WS_MOE_END = WS_TOK + al4k((size_t)PROWS * 4);
constexpr size_t WS_WBRA8 = WS_W13 + al4k((size_t)65 * 1024 * 2048), WS_WBRB8 = WS_WBRA8 + al4k((size_t)2048 * 1024), WS_WOUT8 = WS_WBRB8 + al4k((size_t)2048 * 2048);
static_assert(WS_WOUT8 + (size_t)2048 * 2048 <= WS_W2, "fp8 weight copies");
constexpr size_t WS_ATT8 = WS_H + al4k((size_t)RROWS * DM * 2), WS_HM8 = WS_ATT8 + al4k((size_t)NREAL * 1024);
static_assert(WS_HM8 + (size_t)NREAL * 2048 <= WS_HB, "fp8 activations");
constexpr size_t WS_Y8 = WS_HRAW;
constexpr size_t WS_END = WS_MIX_END > WS_MOE_END ? WS_MIX_END : WS_MOE_END;
static_assert(WS_END < ((size_t)2000 << 20), "workspace budget");

constexpr int RING_BYTES = 131072, MISC_OFF = 135168, EPI_OFF = MISC_OFF + 512, EPI_SLAB = 16 * 144, MAIL_OFF = EPI_OFF + 8 * EPI_SLAB, TILET_OFF = MAIL_OFF + 8 * 256, LDS_BYTES = 159744;
static_assert(TILET_OFF + (MAXTILES + 8) * 4 <= LDS_BYTES, "LDS map");

DI int lane_id() { int l; asm volatile("v_mbcnt_lo_u32_b32 %0, -1, 0\n\tv_mbcnt_hi_u32_b32 %0, -1, %0" : "=v"(l)); return l; }
DI unsigned pk2(float a, float b) { f32x2 v = {a, b}; bf16x2v r = __builtin_convertvector(v, bf16x2v); return __builtin_bit_cast(unsigned, r); }
DI float bf2f(unsigned short u) { return __uint_as_float(((unsigned)u) << 16); }
DI float bflo(unsigned u) { return __uint_as_float(u << 16); }
DI float bfhi(unsigned u) { return __uint_as_float(u & 0xffff0000u); }
template <int CTRL, int ROWMASK = 0xF, bool BC = true> DI float dpp_mov(float old, float x) { return __builtin_bit_cast(float, __builtin_amdgcn_update_dpp(__builtin_bit_cast(int, old), __builtin_bit_cast(int, x), CTRL, ROWMASK, 0xF, BC)); }
DI float rlane(float x, int k) { return __builtin_bit_cast(float, __builtin_amdgcn_readlane(__builtin_bit_cast(int, x), k)); }
DI float grp8_sum(float v) { v += dpp_mov<0xB1>(0.f, v); v += dpp_mov<0x4E>(0.f, v); v += dpp_mov<0x141>(0.f, v); return v; }
DI float grp8_max(float v) { v = fmaxf(v, dpp_mov<0xB1>(v, v)); v = fmaxf(v, dpp_mov<0x4E>(v, v)); v = fmaxf(v, dpp_mov<0x141>(v, v)); return v; }
DI float wave_sum(float v) { v = grp8_sum(v); v += dpp_mov<0x140>(0.f, v); return (rlane(v, 0) + rlane(v, 16)) + (rlane(v, 32) + rlane(v, 48)); }
DI float wave_max(float v) { v = grp8_max(v); v = fmaxf(v, dpp_mov<0x140>(v, v)); return fmaxf(fmaxf(rlane(v, 0), rlane(v, 16)), fmaxf(rlane(v, 32), rlane(v, 48))); }
DI float wave_scan_sum(float x) {
    x += dpp_mov<0x111, 0xF, false>(0.f, x); x += dpp_mov<0x112, 0xF, false>(0.f, x); x += dpp_mov<0x114, 0xF, false>(0.f, x); x += dpp_mov<0x118, 0xF, false>(0.f, x);
    x += dpp_mov<0x142, 0xA, false>(0.f, x); x += dpp_mov<0x143, 0xC, false>(0.f, x); return x; }
DI float wave_scan_max(float x) { const float ninf = -__builtin_inff();
    x = fmaxf(x, dpp_mov<0x111, 0xF, false>(ninf, x)); x = fmaxf(x, dpp_mov<0x112, 0xF, false>(ninf, x)); x = fmaxf(x, dpp_mov<0x114, 0xF, false>(ninf, x)); x = fmaxf(x, dpp_mov<0x118, 0xF, false>(ninf, x));
    x = fmaxf(x, dpp_mov<0x142, 0xA, false>(ninf, x)); x = fmaxf(x, dpp_mov<0x143, 0xC, false>(ninf, x)); return x; }
DI float sigmoidf_(float x) { return __builtin_amdgcn_rcpf(1.f + __builtin_amdgcn_exp2f(-1.44269504f * x)); }
#define LDS_WAIT() asm volatile("s_waitcnt lgkmcnt(0)" ::: "memory")
#define VM_WAIT() asm volatile("s_waitcnt vmcnt(0)" ::: "memory")

#define XB_TMO      128
#define XB_XCNT(j)  (256  + 64 * (j))
#define XB_XSUB(j)  (1280 + 64 * (j))
#define XB_XGEN(j)  (2304 + 64 * (j))
#define XB_TOP      3328
#define XB_TOPGEN   3392
#define XCD_BAR_WORDS 3456
#define XB_SPIN_CAP (1u << 18)
DI unsigned xb_ld(unsigned* p)              { return __hip_atomic_load(p, __ATOMIC_RELAXED, __HIP_MEMORY_SCOPE_AGENT); }
DI unsigned xb_add(unsigned* p, unsigned v) { return __hip_atomic_fetch_add(p, v, __ATOMIC_RELAXED, __HIP_MEMORY_SCOPE_AGENT); }
DI unsigned xb_xcc_id() { return (unsigned)__builtin_amdgcn_s_getreg((3 << 11) | 20) & 0xFu; }
#define XB_SPIN(cond, bar) do { unsigned _sp = 0; while (cond) { __builtin_amdgcn_s_sleep(1); \
    if ((++_sp & 255u) == 0u) { if (xb_ld(&(bar)[XB_TMO])) break; if (_sp > XB_SPIN_CAP) { atomicAdd(&(bar)[XB_TMO], 1u); break; } } } } while (0)
struct XcdBarrier { unsigned* bar; unsigned x; volatile LAS unsigned* st; };
DI XcdBarrier xcd_barrier_post(unsigned* bar, volatile LAS unsigned* st) {
    XcdBarrier b; b.bar = bar; b.x = xb_xcc_id(); b.st = st;
    if (threadIdx.x == 0) (void)xb_add(&bar[XB_XCNT(b.x)], 1u);
    return b;
}
DI void xcd_barrier_complete(unsigned* bar, unsigned x, unsigned& nloc, unsigned& nx) {
    const unsigned G = gridDim.x * gridDim.y * gridDim.z;
    unsigned sum, cnt, mine, sp = 0u;
    for (;;) {
        sum = 0u; cnt = 0u; mine = 0u;
#pragma unroll
        for (unsigned j = 0; j < 16; ++j) { const unsigned c = xb_ld(&bar[XB_XCNT(j)]); sum += c; cnt += (c > 0u) ? 1u : 0u; mine = (j == x) ? c : mine; }
        if (sum == G) break;
        __builtin_amdgcn_s_sleep(1);
        if ((++sp & 255u) == 0u) { if (xb_ld(&bar[XB_TMO])) break; if (sp > XB_SPIN_CAP) { atomicAdd(&bar[XB_TMO], 1u); break; } }
    }
    nloc = mine > 0u ? mine : 1u; nx = cnt > 0u ? cnt : 1u;
}
DI void xcd_barrier(const XcdBarrier& b, const bool thread0) {
    asm volatile("s_waitcnt vmcnt(0)" ::: "memory");
    __syncthreads();
    if (thread0) {
        unsigned* bar = b.bar;
        __builtin_amdgcn_s_waitcnt(0);
        unsigned nloc = b.st[0], nx = b.st[1];
        if (nloc == 0u) { xcd_barrier_complete(bar, b.x, nloc, nx); b.st[0] = nloc; b.st[1] = nx; }
        const unsigned old = xb_add(&bar[XB_XSUB(b.x)], 1u);
        const unsigned gen = old / nloc;
        if (old + 1u == (gen + 1u) * nloc) {
            __builtin_amdgcn_fence(__ATOMIC_RELEASE, "agent");
            asm volatile("s_waitcnt vmcnt(0)" ::: "memory");
            const unsigned og = xb_add(&bar[XB_TOP], 1u);
            const unsigned tg = og / nx;
            if (og + 1u == (tg + 1u) * nx) xb_add(&bar[XB_TOPGEN], 1u);
            else XB_SPIN(xb_ld(&bar[XB_TOPGEN]) == tg, bar);
            __builtin_amdgcn_fence(__ATOMIC_ACQUIRE, "agent");
            xb_add(&bar[XB_XGEN(b.x)], 1u);
            asm volatile("s_waitcnt vmcnt(0)" ::: "memory");
        } else {
            XB_SPIN(xb_ld(&bar[XB_XGEN(b.x)]) == gen, bar);
            __builtin_amdgcn_fence(__ATOMIC_ACQUIRE, "agent");
            asm volatile("s_waitcnt vmcnt(0)" ::: "memory");
        }
    }
    __syncthreads();
}

namespace pg8 {
constexpr int BM = 256, BK = 64, HALF = 128, HTB = HALF * BK * 2, STAGE_BYTES = 8 * HTB, NXCD = 8, WGM = 8;
__host__ __device__ __forceinline__ int lds_byte(int r, int c) { const int st = (r >> 4) * 2 + (c >> 5), rr = r & 15, cc = c & 31, ob = rr * 64 + cc * 2; return st * 1024 + (ob ^ (((ob >> 9) & 1) << 5)); }
__host__ __device__ __forceinline__ void stage_rc(int b, int& R, int& C) { const int st = b / 1024, sb = b % 1024, swz = sb ^ (((sb >> 9) & 1) << 5); R = (st >> 1) * 16 + swz / 64; C = (st & 1) * 32 + (swz % 64) / 2; }
__host__ __device__ __forceinline__ int perm32(int rho) { const int n = rho >> 4, i = rho & 15; return 8 * (i >> 2) + 4 * n + (i & 3); }
struct Unit { int pm, pn; unsigned ua, ub; };
typedef f32x4 Acc[2][2][4][2];
typedef f32x16 Acc32[2][2][2];

DI int xcd_remap(int L, int n) { const int q = n / NXCD, r = n % NXCD, xcd = L % NXCD, off = L / NXCD; return (xcd < r ? xcd * (q + 1) : r * (q + 1) + (xcd - r) * q) + off; }

template <int ldaB, int ldbB, int nM, int nN> struct StaticOrder {
    static constexpr int nwg = nM * nN; const char* A; const char* B; int G, c;
    DI void init(const void* A_, const void* B_, int G_, int c_) { A = (const char*)A_; B = (const char*)B_; G = G_; c = c_; }
    DI bool next(int i, Unit& u) const {
        const int L = i * G + c; if (L >= nwg) return false;
        const int wgid = xcd_remap(L, nwg);
        const int nig = WGM * nN, gid = wgid / nig, fm = gid * WGM, gsz = (nM - fm) < WGM ? (nM - fm) : WGM;
        u.pm = fm + ((wgid % nig) % gsz); u.pn = (wgid % nig) / gsz;
        u.ua = (unsigned)u.pm * (unsigned)(256 * ldaB); u.ub = (unsigned)u.pn * (unsigned)(256 * ldbB); return true;
    }
};

typedef int v8i32 __attribute__((ext_vector_type(8)));
typedef float f32x8 __attribute__((ext_vector_type(8)));
template <int ldaB, int ldbB, int KB, bool GATHER = false, bool FP8 = false, int SCA = 127, int SCB = 127, class Epi, class Sched>
DI void gemm_phase(LAS unsigned char* lds, const int tid, const Sched& S, const Epi& E) {
    const int wid = __builtin_amdgcn_readfirstlane(tid >> 6), lane = tid & 63, wr = wid >> 2, wc = wid & 3, fr = lane & 15, fq = lane >> 4;
    constexpr int nt = KB / 128;
    unsigned voffA[2], voffB[2]; int stR[2], stC = 0;
#pragma unroll
    for (int i = 0; i < 2; ++i) { int R, C; stage_rc(tid * 16 + i * 8192, R, C); const int rho = R & 31; const int Rb = 64 * (R >> 5) + (FP8 ? 16 * ((rho >> 2) & 1) + 4 * (rho >> 3) + (rho & 3) : perm32(rho));
        const int Cs = (FP8 && (R & 16)) ? (C ^ 8) : C;
        voffA[i] = (unsigned)(R * ldaB + Cs * 2); voffB[i] = (unsigned)(Rb * ldbB + Cs * 2); stR[i] = R; stC = Cs; }
    constexpr size_t kstep = (size_t)(BK * 2);
    constexpr size_t hstA = (size_t)HALF * ldaB, hstB = (size_t)32 * ldbB;
    const unsigned ldsw = (unsigned)wid * 1024u;
    const int l31 = lane & 31, hh = lane >> 5;
    const int aoff0 = FP8 ? lds_byte(wr * 64 + l31, hh * 16) : lds_byte(wr * 64 + fr, fq * 8);
    const int boff0 = FP8 ? lds_byte(wc * 32 + l31, hh * 16) : lds_byte(wc * 32 + fr, fq * 8);
    const int sw16 = (l31 & 16) ? 16 : 0, aoffL = aoff0 + sw16, aoffH = aoff0 + 16 - sw16, boffL = boff0 + sw16, boffH = boff0 + 16 - sw16;
#define PG8_SA(b, h) (((b) * 2 + (h)) * HTB)
#define PG8_SB(b, h) ((4 + (b) * 2 + (h)) * HTB)
#define PG8_STAGE(bufoff, gbase, uoff, voff) do { _Pragma("unroll") for (int _i = 0; _i < 2; ++_i) \
        __builtin_amdgcn_global_load_lds((const unsigned*)((gbase) + (unsigned)((voff)[_i] + (unsigned)(uoff))), (LAS unsigned*)(lds + (bufoff) + ldsw + _i * 8192), 16, 0, 0); } while (0)
#define PG8_STAGE1(bufoff, gbase, uoff, voff0, step) do { _Pragma("unroll") for (int _i = 0; _i < 2; ++_i) \
        __builtin_amdgcn_global_load_lds((const unsigned*)((gbase) + (unsigned)((voff0) + (unsigned)(uoff) + (unsigned)(_i * (step)))), (LAS unsigned*)(lds + (bufoff) + ldsw + _i * 8192), 16, 0, 0); } while (0)
#define PG8_STAGE_A(bufoff, h, nx, kb) do { if constexpr (GATHER) { unsigned _o[2]; _o[0] = (nx) ? on[h][0] : oc[h][0]; _o[1] = (nx) ? on[h][1] : oc[h][1]; PG8_STAGE(bufoff, gA, (kb), _o); } \
        else { PG8_STAGE1(bufoff, gA, ((nx) ? nA : cA) + (unsigned)(kb) + (unsigned)((h) ? hstA : 0), voffA[0], 64 * ldaB); } } while (0)
typedef int v16i32_ __attribute__((ext_vector_type(16)));
#define PG8_LD8(p0, p1) __builtin_bit_cast(v8i32, __builtin_shufflevector(*(const LAS u32x4*)(p0), *(const LAS u32x4*)(p1), 0, 1, 2, 3, 4, 5, 6, 7))
#define PG8_CAT16(a, b) __builtin_shufflevector((a), (b), 0, 1, 2, 3, 4, 5, 6, 7, 8, 9, 10, 11, 12, 13, 14, 15)
#define PG8_LDA(dst, b, h) do { _Pragma("unroll") for (int mm = 0; mm < 2; ++mm) { if constexpr (FP8) dst[mm] = PG8_CAT16(PG8_LD8(lds + PG8_SA(b, h) + aoffL + mm * 4096, lds + PG8_SA(b, h) + aoffH + mm * 4096), PG8_LD8(lds + PG8_SA(b, h) + aoffL + mm * 4096 + 1024, lds + PG8_SA(b, h) + aoffH + mm * 4096 + 1024)); \
        else dst[mm] = PG8_CAT16(PG8_LD8(lds + PG8_SA(b, h) + aoff0 + (2 * mm) * 2048, lds + PG8_SA(b, h) + aoff0 + 1024 + (2 * mm) * 2048), PG8_LD8(lds + PG8_SA(b, h) + aoff0 + (2 * mm + 1) * 2048, lds + PG8_SA(b, h) + aoff0 + 1024 + (2 * mm + 1) * 2048)); } } while (0)
#define PG8_LDB(dst, b, h) do { if constexpr (FP8) dst = PG8_CAT16(PG8_LD8(lds + PG8_SB(b, h) + boffL, lds + PG8_SB(b, h) + boffH), PG8_LD8(lds + PG8_SB(b, h) + boffL + 1024, lds + PG8_SB(b, h) + boffH + 1024)); \
        else dst = PG8_CAT16(PG8_LD8(lds + PG8_SB(b, h) + boff0, lds + PG8_SB(b, h) + boff0 + 1024), PG8_LD8(lds + PG8_SB(b, h) + boff0 + 2048, lds + PG8_SB(b, h) + boff0 + 1024 + 2048)); } while (0)
#define PG8_H8(x, i) ((i) == 0 ? __builtin_shufflevector((x), (x), 0, 1, 2, 3, 4, 5, 6, 7) : __builtin_shufflevector((x), (x), 8, 9, 10, 11, 12, 13, 14, 15))
#define PG8_LO(x) __builtin_bit_cast(bf16x8, __builtin_shufflevector((x), (x), 0, 1, 2, 3))
#define PG8_HI(x) __builtin_bit_cast(bf16x8, __builtin_shufflevector((x), (x), 4, 5, 6, 7))
#define PG8_MMA(ai, bj, At, Bt) do { __builtin_amdgcn_s_setprio(1); \
        if constexpr (FP8) { _Pragma("unroll") for (int mi = 0; mi < 2; ++mi) _Pragma("unroll") for (int ks = 0; ks < 2; ++ks) \
            acc32[ai][bj][mi] = __builtin_amdgcn_mfma_scale_f32_32x32x64_f8f6f4(PG8_H8(Bt, ks), PG8_H8(At[mi], ks), acc32[ai][bj][mi], 0, 0, 0, (int)((unsigned)SCB * 0x01010101u), 0, (int)((unsigned)SCA * 0x01010101u)); } \
        else { _Pragma("unroll") for (int m = 0; m < 4; ++m) _Pragma("unroll") for (int n = 0; n < 2; ++n) { const v8i32 a8_ = PG8_H8(At[m >> 1], m & 1), b8_ = PG8_H8(Bt, n); \
               acc[ai][bj][m][n] = __builtin_amdgcn_mfma_f32_16x16x32_bf16(PG8_LO(b8_), PG8_LO(a8_), acc[ai][bj][m][n], 0, 0, 0); \
               acc[ai][bj][m][n] = __builtin_amdgcn_mfma_f32_16x16x32_bf16(PG8_HI(b8_), PG8_HI(a8_), acc[ai][bj][m][n], 0, 0, 0); } } \
        __builtin_amdgcn_s_setprio(0); } while (0)
#define PG8_WAIT_V(n) asm volatile("s_waitcnt vmcnt(" #n ")" ::: "memory")
#define PG8_WAIT_L(n) asm volatile("s_waitcnt lgkmcnt(" #n ")" ::: "memory")
#define PG8_BAR __builtin_amdgcn_s_barrier()
#define PG8_SCHED __builtin_amdgcn_sched_barrier(0)
    Unit cur, nxt; int ui = 0;
    if (!S.next(0, cur)) return;
    f32x4 acc[2][2][4][2]; f32x16 acc32[2][2][2];
#define PG8_ZERO_ACC() do { if constexpr (FP8) { _Pragma("unroll") for (int a = 0; a < 2; ++a) _Pragma("unroll") for (int b = 0; b < 2; ++b) _Pragma("unroll") for (int m = 0; m < 2; ++m) _Pragma("unroll") for (int i = 0; i < 16; ++i) acc32[a][b][m][i] = 0.f; } \
        else { _Pragma("unroll") for (int a = 0; a < 2; ++a) _Pragma("unroll") for (int b = 0; b < 2; ++b) _Pragma("unroll") for (int m = 0; m < 4; ++m) _Pragma("unroll") for (int n = 0; n < 2; ++n) acc[a][b][m][n] = (f32x4){0.f, 0.f, 0.f, 0.f}; } } while (0)
    PG8_ZERO_ACC();
    v16i32_ At[2], B0, B1;
    const char* gA = S.A; const char* gB = S.B;
    unsigned cA = cur.ua, cB = cur.ub, nA = cA;
    unsigned oc[2][2], on[2][2];
    if constexpr (GATHER) {
#pragma unroll
        for (int h = 0; h < 2; ++h)
#pragma unroll
            for (int i = 0; i < 2; ++i) { oc[h][i] = (unsigned)S.tok(cur, h * HALF + stR[i]) * (unsigned)ldaB + (unsigned)(stC * 2); on[h][i] = oc[h][i]; }
    }
    PG8_STAGE1(PG8_SB(0, 0), gB, cB, voffB[0], 128 * ldbB); PG8_STAGE1(PG8_SB(0, 1), gB, cB + (unsigned)hstB, voffB[0], 128 * ldbB); PG8_STAGE_A(PG8_SA(0, 0), 0, false, 0); PG8_STAGE_A(PG8_SA(0, 1), 1, false, 0);
    if (wr == 1) PG8_BAR;
    PG8_WAIT_V(2); PG8_BAR;
    PG8_STAGE1(PG8_SB(1, 0), gB, cB + (unsigned)kstep, voffB[0], 128 * ldbB); PG8_STAGE_A(PG8_SA(1, 0), 0, false, kstep); PG8_STAGE1(PG8_SB(1, 1), gB, cB + (unsigned)(hstB + kstep), voffB[0], 128 * ldbB);
    PG8_WAIT_V(6); PG8_BAR;
    for (;;) {
        const bool has_next = S.next(ui + 1, nxt);
        nA = has_next ? nxt.ua : cA; const unsigned nB = has_next ? nxt.ub : cB;
        if constexpr (GATHER) { if (!has_next) {
#pragma unroll
            for (int h = 0; h < 2; ++h)
#pragma unroll
                for (int i = 0; i < 2; ++i) on[h][i] = oc[h][i]; } }
        if constexpr (GATHER) { if (has_next) { const int* tp = S.tokp(nxt) + 16 * (wid >> 1) + (lane & 15);
            if (lane < 16) {
#pragma unroll
                for (int h = 0; h < 2; ++h)
#pragma unroll
                    for (int i = 0; i < 2; ++i) __builtin_amdgcn_global_load_lds((const unsigned*)(tp + h * HALF + i * 64), (LAS unsigned*)(lds + MAIL_OFF + wid * 256 + (h * 2 + i) * 64), 4, 0, 0); } } }
#pragma unroll 1
        for (int t = 0; t < nt; t += 2) {
            const bool last = (t == nt - 2);
            if constexpr (GATHER) { if (last && has_next) {
#pragma unroll
                for (int h = 0; h < 2; ++h)
#pragma unroll
                    for (int i = 0; i < 2; ++i) on[h][i] = *(const volatile LAS unsigned*)(lds + MAIL_OFF + wid * 256 + (h * 2 + i) * 64 + (lane >> 2) * 4) * (unsigned)ldaB + (unsigned)(stC * 2); } }
            const unsigned k1 = (unsigned)(t + 1) * (unsigned)kstep, k2 = last ? 0u : (unsigned)(t + 2) * (unsigned)kstep, k3 = k2 + (unsigned)kstep;
            const unsigned b2 = last ? nB : cB + (unsigned)(t + 2) * (unsigned)kstep, b3 = b2 + (unsigned)kstep;
            PG8_LDB(B0, 0, 0); PG8_LDB(B1, 0, 1); PG8_SCHED; PG8_LDA(At, 0, 0); PG8_STAGE_A(PG8_SA(1, 1), 1, false, k1);
            PG8_WAIT_V(8); PG8_WAIT_L(0); PG8_BAR; PG8_MMA(0, 0, At, B0); PG8_MMA(0, 1, At, B1); PG8_BAR; PG8_SCHED;
            PG8_LDA(At, 0, 1); PG8_STAGE1(PG8_SB(0, 0), gB, b2, voffB[0], 128 * ldbB); PG8_STAGE1(PG8_SB(0, 1), gB, b2 + (unsigned)hstB, voffB[0], 128 * ldbB); PG8_STAGE_A(PG8_SA(0, 0), 0, last, k2);
            PG8_WAIT_V(8); PG8_WAIT_L(0); PG8_BAR; PG8_MMA(1, 0, At, B0); PG8_MMA(1, 1, At, B1); PG8_BAR; PG8_SCHED;
            PG8_LDB(B0, 1, 0); PG8_LDB(B1, 1, 1); PG8_SCHED; PG8_LDA(At, 1, 0); PG8_STAGE_A(PG8_SA(0, 1), 1, last, k2);
            PG8_WAIT_V(8); PG8_WAIT_L(0); PG8_BAR; PG8_MMA(0, 0, At, B0); PG8_MMA(0, 1, At, B1); PG8_BAR; PG8_SCHED;
            PG8_LDA(At, 1, 1); PG8_STAGE1(PG8_SB(1, 0), gB, b3, voffB[0], 128 * ldbB); PG8_STAGE1(PG8_SB(1, 1), gB, b3 + (unsigned)hstB, voffB[0], 128 * ldbB); PG8_STAGE_A(PG8_SA(1, 0), 0, last, k3);
            PG8_WAIT_V(8); PG8_WAIT_L(0); PG8_BAR; PG8_MMA(1, 0, At, B0); PG8_MMA(1, 1, At, B1); PG8_BAR; PG8_SCHED;
        }
        if (wr == 0) PG8_BAR;
        { int t2 = lane_id(); asm volatile("" : "+v"(t2)); if constexpr (FP8) E(acc32, cur, wr, wc, t2 & 31, t2 >> 5); else E(acc, cur, wr, wc, t2 & 15, t2 >> 4); }
        if (!has_next) break;
        PG8_ZERO_ACC();
        cur = nxt; cA = nA; cB = nB; ++ui;
        if constexpr (GATHER) {
#pragma unroll
            for (int h = 0; h < 2; ++h)
#pragma unroll
                for (int i = 0; i < 2; ++i) oc[h][i] = on[h][i]; }
        if (wr == 1) PG8_BAR;
    }
    PG8_WAIT_V(0);
    PG8_BAR;
#undef PG8_SA
#undef PG8_SB
#undef PG8_STAGE
#undef PG8_STAGE_A
#undef PG8_LDA
#undef PG8_LDB
#undef PG8_MMA
#undef PG8_LD8
#undef PG8_LO
#undef PG8_HI
#undef PG8_CAT16
#undef PG8_H8
#undef PG8_ZERO_ACC
#undef PG8_WAIT_V
#undef PG8_WAIT_L
#undef PG8_BAR
#undef PG8_SCHED
}
}
using pg8::Unit;
using pg8::Acc;

struct Params { const float* in[28]; float* out; unsigned char* ws; int ph_lo, ph_hi; };
enum { I_X = 0, I_META, I_LNIN_G, I_LNIN_B, I_WIN, I_BIN, I_QNG, I_KVNG, I_WUQ, I_WUKV, I_CONVW, I_CONVB, I_MLNG, I_WBRA, I_WBRB, I_WOUT, I_LN1G, I_LN1B, I_WROUTER, I_EBIAS, I_W1, I_W3, I_W2, I_WS1, I_WS3, I_WS2, I_LN2G, I_LN2B };

typedef const __attribute__((address_space(4))) Params* PK;
DI PK kargs() { PK p = (PK)__builtin_amdgcn_kernarg_segment_ptr(); asm volatile("" : "+s"(p)); return p; }
struct Frame {
    LAS unsigned char* lds; int tid, lane, wave, vcu, G; unsigned char* ws; unsigned* ctl;
};

DI int rowmap_in(int n) {
        if (n < 1024) return n;
        if (n < 1088) return ZC_S + (n - 1024);
        if (n < 7232) return n - 64;
        if (n < 7248) return ZC_S + 64 + (n - 7232);
        return n - 80;
}
DI int rowmap(int mode, int n) {
    switch (mode) {
    case 1: return rowmap_in(n);
    case 99: {
        if (n < 1024) return n;
        if (n < 1088) return ZC_S + (n - 1024);
        if (n < 7232) return n - 64;
        if (n < 7248) return ZC_S + 64 + (n - 7232);
        return n - 80;
    }
    case 5: { const int r = rowmap_in(n); return (r >= ZC_F8 && r < ZC_S) ? r - ZC_F8 : -1; }
    case 2: { const int h = n >> 8, j = n & 255; return j < 128 ? h * 128 + j : 1024 + h * 128 + (j - 128); }
    case 3: return (n >> 7) * 256 + ((n >> 5) & 3) * 64 + (n & 31);
    case 4: return (n >> 7) * 256 + ((n >> 5) & 3) * 64 + 32 + (n & 31);
    default: return n;
    }
}
constexpr int CV_STRIDE = 65, CV_WAVE_BYTES = 64 * CV_STRIDE * 4;
DI void conv_load(f32x4 (&v)[16], const float* W, int K, int N, int item, int lane) {
    const int nblk = (N + 63) / 64, kb = item / nblk, nb = item % nblk, k0 = 64 * kb, n0 = 64 * nb;
    const int nc = n0 + 4 * (lane & 15); const bool okc = nc < N;
#pragma unroll
    for (int i = 0; i < 16; ++i) { const int kk = 4 * i + (lane >> 4); v[i] = okc ? __builtin_nontemporal_load((const f32x4*)(W + (size_t)(k0 + kk) * N + nc)) : (f32x4){0.f, 0.f, 0.f, 0.f}; }
}
template <bool F8> DI void conv_finish(const f32x4 (&v)[16], int K, int N, bf16* WT, int mode, const float* kscale, float sc, LAS float* scr, int item, int lane, unsigned char* WT8 = nullptr) {
    const int nblk = (N + 63) / 64, kb = item / nblk, nb = item % nblk, k0 = 64 * kb, n0 = 64 * nb;
#pragma unroll
    for (int i = 0; i < 16; ++i) { const int kk = 4 * i + (lane >> 4); LAS float* d = scr + kk * CV_STRIDE + 4 * (lane & 15); d[0] = v[i][0]; d[1] = v[i][1]; d[2] = v[i][2]; d[3] = v[i][3]; }
    LDS_WAIT(); asm volatile("" ::: "memory");
    const int c = lane & 7;
    float ks[8];
#pragma unroll
    for (int q = 0; q < 8; ++q) ks[q] = kscale ? kscale[k0 + 8 * c + q] * sc : sc;
#pragma unroll
    for (int j = 0; j < 8; ++j) { const int n = (lane >> 3) + 8 * j; const LAS float* s = scr + (8 * c) * CV_STRIDE + n;
        if (F8) { u32x2 o8; int w0 = 0, w1 = 0;
            w0 = __builtin_amdgcn_cvt_pk_fp8_f32(s[0 * CV_STRIDE] * ks[0], s[1 * CV_STRIDE] * ks[1], w0, false); w0 = __builtin_amdgcn_cvt_pk_fp8_f32(s[2 * CV_STRIDE] * ks[2], s[3 * CV_STRIDE] * ks[3], w0, true);
            w1 = __builtin_amdgcn_cvt_pk_fp8_f32(s[4 * CV_STRIDE] * ks[4], s[5 * CV_STRIDE] * ks[5], w1, false); w1 = __builtin_amdgcn_cvt_pk_fp8_f32(s[6 * CV_STRIDE] * ks[6], s[7 * CV_STRIDE] * ks[7], w1, true);
            o8.x = (unsigned)w0; o8.y = (unsigned)w1;
            const int rw = (n0 + n < N) ? rowmap(mode, n0 + n) : -1;
            if (rw >= 0) *(u32x2*)((unsigned char*)WT + (size_t)rw * K + k0 + 8 * c) = o8; }
        else { u32x4 o; o.x = pk2(s[0 * CV_STRIDE] * ks[0], s[1 * CV_STRIDE] * ks[1]); o.y = pk2(s[2 * CV_STRIDE] * ks[2], s[3 * CV_STRIDE] * ks[3]); o.z = pk2(s[4 * CV_STRIDE] * ks[4], s[5 * CV_STRIDE] * ks[5]); o.w = pk2(s[6 * CV_STRIDE] * ks[6], s[7 * CV_STRIDE] * ks[7]);
            if (n0 + n < N) *(u32x4*)(WT + (size_t)rowmap(mode, n0 + n) * K + k0 + 8 * c) = o;
            if (WT8) { int w0 = 0, w1 = 0;
                w0 = __builtin_amdgcn_cvt_pk_fp8_f32(s[0 * CV_STRIDE] * 64.f, s[1 * CV_STRIDE] * 64.f, w0, false); w0 = __builtin_amdgcn_cvt_pk_fp8_f32(s[2 * CV_STRIDE] * 64.f, s[3 * CV_STRIDE] * 64.f, w0, true);
                w1 = __builtin_amdgcn_cvt_pk_fp8_f32(s[4 * CV_STRIDE] * 64.f, s[5 * CV_STRIDE] * 64.f, w1, false); w1 = __builtin_amdgcn_cvt_pk_fp8_f32(s[6 * CV_STRIDE] * 64.f, s[7 * CV_STRIDE] * 64.f, w1, true);
                if (n0 + n < N) *(u32x2*)(WT8 + (size_t)(n0 + n) * K + k0 + 8 * c) = (u32x2){(unsigned)w0, (unsigned)w1}; } } }
    LDS_WAIT(); asm volatile("" ::: "memory");
}
template <bool F8 = false> DI void conv_matrix(const Frame& F, const float* W, int K, int N, bf16* WT, int mode, const float* kscale, float sc, int nsub, size_t sstride, size_t dstride, int& rot, int nb0 = 0, int nbe = -1, unsigned char* WT8 = nullptr) {
    LAS float* scr = (LAS float*)(F.lds + F.wave * CV_WAVE_BYTES);
    const int NGW = F.G * NW; int gw = F.vcu * NW + F.wave - rot; if (gw < 0) gw += NGW;
    const int nblk = (N + 63) / 64, nb1 = (nbe < 0 ? nblk : nbe) - nb0, per = (K / 64) * nb1, total = per * nsub;
    rot = (rot + total) % NGW;
#define CV_DECODE(it_, sub_, r_) const int sub_ = (it_) / per, r0_##r_ = (it_) - sub_ * per, r_ = (r0_##r_ / nb1) * nblk + nb0 + (r0_##r_ % nb1)
    f32x4 va[16], vb[16];
    int it = gw;
    if (it < total) { CV_DECODE(it, s0, r0); conv_load(va, W + (size_t)s0 * sstride, K, N, r0, F.lane); }
#pragma unroll 1
    for (; it < total; it += 2 * NGW) {
        CV_DECODE(it, sA, rA);
        const int itb = it + NGW, itc = it + 2 * NGW;
        if (itb < total) { CV_DECODE(itb, sB, rB); conv_load(vb, W + (size_t)sB * sstride, K, N, rB, F.lane); }
        conv_finish<F8>(va, K, N, F8 ? (bf16*)((unsigned char*)WT + (size_t)sA * dstride) : WT + (size_t)sA * dstride, mode, kscale, sc, scr, rA, F.lane, WT8);
        if (itc < total) { CV_DECODE(itc, sC, rC); conv_load(va, W + (size_t)sC * sstride, K, N, rC, F.lane); }
        if (itb < total) { CV_DECODE(itb, sB2, rB2); conv_finish<F8>(vb, K, N, F8 ? (bf16*)((unsigned char*)WT + (size_t)sB2 * dstride) : WT + (size_t)sB2 * dstride, mode, kscale, sc, scr, rB2, F.lane, WT8); }
    }
#undef CV_DECODE
}
#ifndef MOE_FP8
#define MOE_FP8 1
#endif
constexpr float W8SCALE = MOE_FP8 ? 64.f : 1.f;
constexpr float H8SCALE = MOE_FP8 ? 8.f : 1.f;
DI void convert_layer(const Frame& F, PK P, int l) {
    unsigned char* ws = F.ws; int rot = 0;
    conv_matrix(F, P->in[I_WIN] + (size_t)l * DM * INW, DM, INW, (bf16*)(ws + WS_WIN), 1, nullptr, 1.f, 1, 0, 0, rot, 0, (ZC_F8 + 64) / 64);
    conv_matrix(F, P->in[I_WIN] + (size_t)l * DM * INW, DM, INW, (bf16*)(ws + WS_WIN), 1, nullptr, 1.f, 1, 0, 0, rot, 113, 114);
    conv_matrix<true>(F, P->in[I_WIN] + (size_t)l * DM * INW, DM, INW, (bf16*)(ws + WS_WIN8), 5, nullptr, 64.f, 1, 0, 0, rot, (ZC_F8 + 64) / 64);
    conv_matrix(F, P->in[I_WUQ] + (size_t)l * 512 * 1536, 512, 1536, (bf16*)(ws + WS_WUQ), 0, P->in[I_QNG] + l * 512, QSCALE, 1, 0, 0, rot);
    conv_matrix(F, P->in[I_WUKV] + (size_t)l * 512 * 2048, 512, 2048, (bf16*)(ws + WS_WKV), 2, P->in[I_KVNG] + l * 512, 1.f, 1, 0, 0, rot);
    conv_matrix(F, P->in[I_WBRA] + (size_t)l * 1024 * 2048, 1024, 2048, (bf16*)(ws + WS_WBRA), 0, nullptr, 1.f, 1, 0, 0, rot, 0, -1, ws + WS_WBRA8);
    conv_matrix(F, P->in[I_WBRB] + (size_t)l * 2048 * 2048, 2048, 2048, (bf16*)(ws + WS_WBRB), 0, nullptr, 1.f, 1, 0, 0, rot, 0, -1, ws + WS_WBRB8);
    conv_matrix(F, P->in[I_WOUT] + (size_t)l * 2048 * 2048, 2048, 2048, (bf16*)(ws + WS_WOUT), 0, nullptr, 1.f, 1, 0, 0, rot, 0, -1, ws + WS_WOUT8);
    conv_matrix(F, P->in[I_WROUTER] + (size_t)l * 2048 * 64, 2048, 64, (bf16*)(ws + WS_WR), 0, nullptr, 1.f, 1, 0, 0, rot);
    conv_matrix<MOE_FP8 != 0>(F, P->in[I_W1] + (size_t)l * 64 * 2048 * 512, 2048, 512, (bf16*)(ws + WS_W13), 3, nullptr, W8SCALE, 64, (size_t)2048 * 512, (size_t)1024 * 2048, rot);
    conv_matrix<MOE_FP8 != 0>(F, P->in[I_W3] + (size_t)l * 64 * 2048 * 512, 2048, 512, (bf16*)(ws + WS_W13), 4, nullptr, W8SCALE, 64, (size_t)2048 * 512, (size_t)1024 * 2048, rot);
    conv_matrix<MOE_FP8 != 0>(F, P->in[I_W2] + (size_t)l * 64 * 512 * 2048, 512, 2048, (bf16*)(ws + WS_W2), 0, nullptr, W8SCALE, 64, (size_t)512 * 2048, (size_t)2048 * 512, rot);
    conv_matrix<MOE_FP8 != 0>(F, P->in[I_WS1] + (size_t)l * 2048 * 512, 2048, 512, (bf16*)((unsigned char*)(ws + WS_W13) + (size_t)64 * 1024 * 2048 * (MOE_FP8 ? 1 : 2)), 3, nullptr, W8SCALE, 1, 0, 0, rot);
    conv_matrix<MOE_FP8 != 0>(F, P->in[I_WS3] + (size_t)l * 2048 * 512, 2048, 512, (bf16*)((unsigned char*)(ws + WS_W13) + (size_t)64 * 1024 * 2048 * (MOE_FP8 ? 1 : 2)), 4, nullptr, W8SCALE, 1, 0, 0, rot);
    conv_matrix<MOE_FP8 != 0>(F, P->in[I_WS2] + (size_t)l * 512 * 2048, 512, 2048, (bf16*)((unsigned char*)(ws + WS_W2) + (size_t)64 * 2048 * 512 * (MOE_FP8 ? 1 : 2)), 0, nullptr, W8SCALE, 1, 0, 0, rot);
    float* br = (float*)(ws + WS_BIAS); const float* bi = P->in[I_BIN] + (size_t)l * INW;
    for (int i = (F.vcu * NT + F.tid); i < ZW; i += F.G * NT) {
        int n;
        if (i < 1024) n = i; else if (i < 7168) n = i + 64; else if (i < ZC_S) n = i + 80; else if (i < ZC_S + 64) n = 1024 + (i - ZC_S); else if (i < ZC_S + 80) n = 7232 + (i - ZC_S - 64); else n = -1;
        br[i] = n >= 0 ? bi[n] : 0.f; }
}

DI u32x4 pack8(const f32x4& a, const f32x4& b) { u32x4 w; w.x = pk2(a[0], a[1]); w.y = pk2(a[2], a[3]); w.z = pk2(b[0], b[1]); w.w = pk2(b[2], b[3]); return w; }
#define LNCOL(lane, j) (8 * ((lane) + 64 * (j)))
DI u32x2 pack8_fp8(const f32x4& a, const f32x4& b) { int w0 = 0, w1 = 0; w0 = __builtin_amdgcn_cvt_pk_fp8_f32(a[0], a[1], w0, false); w0 = __builtin_amdgcn_cvt_pk_fp8_f32(a[2], a[3], w0, true); w1 = __builtin_amdgcn_cvt_pk_fp8_f32(b[0], b[1], w1, false); w1 = __builtin_amdgcn_cvt_pk_fp8_f32(b[2], b[3], w1, true); return (u32x2){(unsigned)w0, (unsigned)w1}; }
DI void ln_store(f32x4 (&v)[8], const float* g, const float* b, bf16* hbrow, int lane, unsigned char* h8row = nullptr) {
    float s = 0.f;
#pragma unroll
    for (int j = 0; j < 8; ++j) s += (v[j].x + v[j].y) + (v[j].z + v[j].w);
    const float mean = wave_sum(s) * (1.f / DM); float s2 = 0.f;
#pragma unroll
    for (int j = 0; j < 8; ++j) { v[j] = v[j] - mean; s2 += (v[j].x * v[j].x + v[j].y * v[j].y) + (v[j].z * v[j].z + v[j].w * v[j].w); }
    const float rstd = 1.f / sqrtf(wave_sum(s2) * (1.f / DM) + LN_EPS);
#pragma unroll
    for (int j = 0; j < 4; ++j) { const int c = LNCOL(lane, j);
        const f32x4 o0 = v[2 * j] * rstd * *(const f32x4*)(g + c) + *(const f32x4*)(b + c), o1 = v[2 * j + 1] * rstd * *(const f32x4*)(g + c + 4) + *(const f32x4*)(b + c + 4);
        v[2 * j] = o0; v[2 * j + 1] = o1;
        *(u32x4*)(hbrow + c) = pack8(o0, o1);
        if (h8row) *(u32x2*)(h8row + c) = pack8_fp8(o0, o1); }
}

DI void fp8_selftest(const Frame& F);
DI void phase_prologue(const Frame& F, PK P) {
    unsigned char* ws = F.ws;
    float* rt = (float*)(ws + WS_ROPE);
    for (int i = F.vcu * NT + F.tid; i < TP * 32; i += F.G * NT) { const int t = i >> 5, f = i & 31;
        const float invf = 1.0f / powf(10000.0f, (float)(2 * f) * (1.0f / 64.0f)); const float ang = (float)t * invf; float sn, cs; sincosf(ang, &sn, &cs);
        rt[t * 64 + f] = cs; rt[t * 64 + 32 + f] = sn; }
    bf16* hb = (bf16*)(ws + WS_HB);
    const int gw = F.vcu * NW + F.wave, NGW = F.G * NW;
    { f32x4 nx[8]; const float* x = P->in[I_X];
      if (gw < NREAL) {
#pragma unroll
          for (int j = 0; j < 4; ++j) { const int c = LNCOL(F.lane, j); nx[2 * j] = *(const f32x4*)(x + (size_t)gw * DM + c); nx[2 * j + 1] = *(const f32x4*)(x + (size_t)gw * DM + c + 4); } }
      for (int r = gw; r < NREAL; r += NGW) { f32x4 v[8];
#pragma unroll
          for (int j = 0; j < 8; ++j) v[j] = nx[j];
          if (r + NGW < NREAL) {
#pragma unroll
              for (int j = 0; j < 4; ++j) { const int c = LNCOL(F.lane, j); nx[2 * j] = *(const f32x4*)(x + (size_t)(r + NGW) * DM + c); nx[2 * j + 1] = *(const f32x4*)(x + (size_t)(r + NGW) * DM + c + 4); } }
          ln_store(v, P->in[I_LNIN_G], P->in[I_LNIN_B], hb + (size_t)r * DM, F.lane, ws + WS_HB8 + (size_t)r * DM); } }
    for (int r = NREAL + gw; r < RROWS; r += NGW) { f32x4 v[8];
        const float* src;
        { const int pp = (r - NREAL) & 63;
            if (pp < PADL) {
#pragma unroll
                for (int j = 0; j < 4; ++j) { const int c = LNCOL(F.lane, j); *(u32x4*)(hb + (size_t)r * DM + c) = (u32x4){0u, 0u, 0u, 0u}; *(u32x2*)(ws + WS_HB8 + (size_t)r * DM + c) = (u32x2){0u, 0u}; }
                continue; }
            src = P->in[I_META] + (size_t)(pp - PADL) * DM; }
#pragma unroll
        for (int j = 0; j < 4; ++j) { const int c = LNCOL(F.lane, j); v[2 * j] = *(const f32x4*)(src + c); v[2 * j + 1] = *(const f32x4*)(src + c + 4); }
        ln_store(v, P->in[I_LNIN_G], P->in[I_LNIN_B], hb + (size_t)r * DM, F.lane, ws + WS_HB8 + (size_t)r * DM); }
    convert_layer(F, P, 0);
    fp8_selftest(F);
}

#define EPI_ROWS(ai, m) (u.pm * 256 + (ai) * 128 + wr * 64 + (m) * 16 + fr)
#define EPI_COL0 (wc * 64 + 8 * fq)
DI void unpack8(const u32x4& w, f32x4& a, f32x4& b) { a = (f32x4){bflo(w.x), bfhi(w.x), bflo(w.y), bfhi(w.y)}; b = (f32x4){bflo(w.z), bfhi(w.z), bflo(w.w), bfhi(w.w)}; }
DI void st_rows64(LAS unsigned char* slab, int lane, int fr, int fq, const u32x4& w0, const u32x4& w1, bf16* g0, size_t ldc) {
    *(LAS u32x4*)(slab + fr * 144 + fq * 16) = w0; *(LAS u32x4*)(slab + fr * 144 + 64 + fq * 16) = w1;
    LDS_WAIT();
    const int rr = lane >> 3, cc = lane & 7;
    const u32x4 a = *(const LAS u32x4*)(slab + rr * 144 + cc * 16), b = *(const LAS u32x4*)(slab + (8 + rr) * 144 + cc * 16);
    LDS_WAIT();
    *(u32x4*)(g0 + (unsigned)(rr * (int)ldc + cc * 8)) = a; *(u32x4*)(g0 + (unsigned)((8 + rr) * (int)ldc + cc * 8)) = b;
}
DI void st_rows32(LAS unsigned char* slab, int lane, int fr, int fq, const u32x4& w0, bf16* g0, size_t ldc) {
    *(LAS u32x4*)(slab + fr * 80 + fq * 16) = w0;
    LDS_WAIT();
    const int rr = lane >> 2, cc = lane & 3;
    const u32x4 a = *(const LAS u32x4*)(slab + rr * 80 + cc * 16);
    LDS_WAIT();
    *(u32x4*)(g0 + (unsigned)(rr * (int)ldc + cc * 8)) = a;
}
#define EPI_SLABP (slab0 + (wr * 4 + wc) * EPI_SLAB)
#define EPI_ROW0(ai, m) (u.pm * 256 + (ai) * 128 + wr * 64 + (m) * 16)
#define EPI_LANE (fr + 16 * fq)
DI f32x4 sig4(const f32x4& x) { return (f32x4){sigmoidf_(x[0]), sigmoidf_(x[1]), sigmoidf_(x[2]), sigmoidf_(x[3])}; }

struct EpiInProj { static constexpr bool PROBE2 = false;
    bf16* z; float* zs; const float* bias; LAS unsigned char* slab0;
    DI void operator()(const Acc& acc, const Unit& u, int wr, int wc, int fr, int fq) const {
        const int colt = u.pn * 256 + EPI_COL0;
        f32x4 bv[2][2];
#pragma unroll
        for (int bj = 0; bj < 2; ++bj)
#pragma unroll
            for (int n = 0; n < 2; ++n) bv[bj][n] = *(const f32x4*)(bias + colt + bj * 32 + 4 * n);
        if (u.pn < 44) {
#pragma unroll
            for (int ai = 0; ai < 2; ++ai)
#pragma unroll
                for (int m = 0; m < 4; ++m) st_rows64(EPI_SLABP, EPI_LANE, fr, fq, pack8(acc[ai][0][m][0] + bv[0][0], acc[ai][0][m][1] + bv[0][1]), pack8(acc[ai][1][m][0] + bv[1][0], acc[ai][1][m][1] + bv[1][1]),
                                                       z + (size_t)EPI_ROW0(ai, m) * ZW + u.pn * 256 + wc * 64, ZW);
        } else {
#pragma unroll
            for (int ai = 0; ai < 2; ++ai)
#pragma unroll
                for (int m = 0; m < 4; ++m) { float* rowp = zs + (size_t)EPI_ROWS(ai, m) * 128 + EPI_COL0;
                    if (wc < 2) {
#pragma unroll
                        for (int bj = 0; bj < 2; ++bj) { *(f32x4*)(rowp + bj * 32) = acc[ai][bj][m][0] + bv[bj][0]; *(f32x4*)(rowp + bj * 32 + 4) = acc[ai][bj][m][1] + bv[bj][1]; } } }
        }
    }
};
struct EpiRowScale { static constexpr bool PROBE2 = false;
    bf16* out; int ldc; const float* rs; int rs_stride; LAS unsigned char* slab0;
    DI void operator()(const Acc& acc, const Unit& u, int wr, int wc, int fr, int fq) const {
        const int colt = u.pn * 256 + EPI_COL0;
#pragma unroll
        for (int ai = 0; ai < 2; ++ai)
#pragma unroll
            for (int m = 0; m < 4; ++m) { const int row = EPI_ROWS(ai, m); const float s = rs[(size_t)row * rs_stride];
                st_rows64(EPI_SLABP, EPI_LANE, fr, fq, pack8(acc[ai][0][m][0] * s, acc[ai][0][m][1] * s), pack8(acc[ai][1][m][0] * s, acc[ai][1][m][1] * s), out + (size_t)EPI_ROW0(ai, m) * ldc + u.pn * 256 + wc * 64, ldc); }
    }
};
struct EpiColScale { static constexpr bool PROBE2 = false;
    bf16* out; int ldc; const float* cs; int cs_stride; LAS unsigned char* slab0;
    DI void operator()(const Acc& acc, const Unit& u, int wr, int wc, int fr, int fq) const {
        const int colt = u.pn * 256 + EPI_COL0;
        f32x4 sv[2][2];
#pragma unroll
        for (int bj = 0; bj < 2; ++bj)
#pragma unroll
            for (int n = 0; n < 2; ++n)
#pragma unroll
                for (int q = 0; q < 4; ++q) sv[bj][n][q] = cs[(size_t)(colt + bj * 32 + 4 * n + q) * cs_stride];
#pragma unroll
        for (int ai = 0; ai < 2; ++ai)
#pragma unroll
            for (int m = 0; m < 4; ++m) st_rows64(EPI_SLABP, EPI_LANE, fr, fq, pack8(acc[ai][0][m][0] * sv[0][0], acc[ai][0][m][1] * sv[0][1]), pack8(acc[ai][1][m][0] * sv[1][0], acc[ai][1][m][1] * sv[1][1]),
                                                   out + (size_t)EPI_ROW0(ai, m) * ldc + u.pn * 256 + wc * 64, ldc);
    }
};
template <int ADD> struct EpiGate { static constexpr bool PROBE2 = false;
    bf16* out; const bf16* gate; const bf16* prev; LAS unsigned char* slab0;
    DI void operator()(const Acc& acc, const Unit& u, int wr, int wc, int fr, int fq) const {
        const int colt = u.pn * 256 + EPI_COL0;
#pragma unroll
        for (int ai = 0; ai < 2; ++ai)
#pragma unroll
            for (int m = 0; m < 4; ++m) { const int row = EPI_ROWS(ai, m); u32x4 ow[2];
#pragma unroll
                for (int bj = 0; bj < 2; ++bj) { const int col = colt + bj * 32;
                    const u32x4 gw = *(const u32x4*)(gate + (size_t)row * ZW + col); f32x4 g0, g1; unpack8(gw, g0, g1);
                    f32x4 o0 = sig4(g0) * acc[ai][bj][m][0], o1 = sig4(g1) * acc[ai][bj][m][1];
                    if (ADD) { const u32x4 pw = *(const u32x4*)(prev + (size_t)row * DM + col); f32x4 p0, p1; unpack8(pw, p0, p1); o0 += p0; o1 += p1; }
                    ow[bj] = pack8(o0, o1); }
                st_rows64(EPI_SLABP, EPI_LANE, fr, fq, ow[0], ow[1], out + (size_t)EPI_ROW0(ai, m) * DM + u.pn * 256 + wc * 64, DM); }
    }
};
struct EpiResid { static constexpr bool PROBE2 = false;
    const bf16* hb; bf16* r; LAS unsigned char* slab0;
    DI void operator()(const Acc& acc, const Unit& u, int wr, int wc, int fr, int fq) const {
        const int colt = u.pn * 256 + EPI_COL0;
#pragma unroll
        for (int ai = 0; ai < 2; ++ai)
#pragma unroll
            for (int m = 0; m < 4; ++m) { const int row = EPI_ROWS(ai, m); u32x4 ow[2];
#pragma unroll
                for (int bj = 0; bj < 2; ++bj) { const u32x4 hw = *(const u32x4*)(hb + (size_t)row * DM + colt + bj * 32); f32x4 h0, h1; unpack8(hw, h0, h1);
                    ow[bj] = pack8(h0 * ALPHA + acc[ai][bj][m][0], h1 * ALPHA + acc[ai][bj][m][1]); }
                st_rows64(EPI_SLABP, EPI_LANE, fr, fq, ow[0], ow[1], r + (size_t)EPI_ROW0(ai, m) * DM + u.pn * 256 + wc * 64, DM); }
    }
};
struct EpiRouter { static constexpr bool PROBE2 = false;
    float* lg;
    DI void operator()(const Acc& acc, const Unit& u, int wr, int wc, int fr, int fq) const {
        if (wc == 0) {
#pragma unroll
            for (int ai = 0; ai < 2; ++ai)
#pragma unroll
                for (int m = 0; m < 4; ++m) { float* rowp = lg + (size_t)EPI_ROWS(ai, m) * 64 + EPI_COL0;
#pragma unroll
                    for (int bj = 0; bj < 2; ++bj) { *(f32x4*)(rowp + bj * 32) = acc[ai][bj][m][0]; *(f32x4*)(rowp + bj * 32 + 4) = acc[ai][bj][m][1]; } }
        }
    }
};
DI void st_rows32b(LAS unsigned char* slab, int lane, int fr, int fq, const u32x2& w0, unsigned char* g0, size_t ldc) {
    *(LAS u32x2*)(slab + fr * 40 + fq * 8) = w0;
    LDS_WAIT();
    const int rr = lane >> 2, cc = lane & 3;
    const u32x2 a = *(const LAS u32x2*)(slab + rr * 40 + cc * 8);
    LDS_WAIT();
    *(u32x2*)(g0 + (unsigned)(rr * (int)ldc + cc * 8)) = a;
}
struct EpiSwiGLU { static constexpr bool PROBE2 = false;
    unsigned char* hbuf; LAS unsigned char* slab0;
    DI void operator()(const Acc& acc, const Unit& u, int wr, int wc, int fr, int fq) const {
#pragma unroll
        for (int ai = 0; ai < 2; ++ai)
#pragma unroll
            for (int m = 0; m < 4; ++m) { f32x4 o[2];
#pragma unroll
                for (int n = 0; n < 2; ++n) { const f32x4 a = acc[ai][0][m][n], b = acc[ai][1][m][n]; o[n] = a * sig4(a) * b; }
#if MOE_FP8
                int w0 = 0, w1 = 0;
                w0 = __builtin_amdgcn_cvt_pk_fp8_f32(o[0][0], o[0][1], w0, false); w0 = __builtin_amdgcn_cvt_pk_fp8_f32(o[0][2], o[0][3], w0, true);
                w1 = __builtin_amdgcn_cvt_pk_fp8_f32(o[1][0], o[1][1], w1, false); w1 = __builtin_amdgcn_cvt_pk_fp8_f32(o[1][2], o[1][3], w1, true);
                st_rows32b(EPI_SLABP, EPI_LANE, fr, fq, (u32x2){(unsigned)w0, (unsigned)w1}, hbuf + (size_t)EPI_ROW0(ai, m) * DEXP + u.pn * 128 + wc * 32, DEXP);
#else
                st_rows32(EPI_SLABP, EPI_LANE, fr, fq, pack8(o[0], o[1]), (bf16*)hbuf + (size_t)EPI_ROW0(ai, m) * DEXP + u.pn * 128 + wc * 32, DEXP);
#endif
            }
    }
};
struct EpiPlain { static constexpr bool PROBE2 = true;
    bf16* out; int ldc; LAS unsigned char* slab0;
    DI void operator()(const Acc& acc, const Unit& u, int wr, int wc, int fr, int fq) const {
#pragma unroll
        for (int ai = 0; ai < 2; ++ai)
#pragma unroll
            for (int m = 0; m < 4; ++m) st_rows64(EPI_SLABP, EPI_LANE, fr, fq, pack8(acc[ai][0][m][0], acc[ai][0][m][1]), pack8(acc[ai][1][m][0], acc[ai][1][m][1]), out + (size_t)EPI_ROW0(ai, m) * ldc + u.pn * 256 + wc * 64, ldc);
    }
};

DI void st_rows64_32(LAS unsigned char* slab, int lane, int l31, int hh, const u32x4 (&w)[2][2], bf16* g0, int ldc) {
#pragma unroll
    for (int hf = 0; hf < 2; ++hf) {
        if ((l31 >> 4) == hf) { LAS unsigned char* d = slab + (l31 & 15) * 144 + hh * 32;
            *(LAS u32x4*)(d) = w[0][0]; *(LAS u32x4*)(d + 16) = w[0][1]; *(LAS u32x4*)(d + 64) = w[1][0]; *(LAS u32x4*)(d + 80) = w[1][1]; }
        LDS_WAIT();
        const int rr = lane >> 3, cc = lane & 7;
        const u32x4 a = *(const LAS u32x4*)(slab + rr * 144 + cc * 16), b = *(const LAS u32x4*)(slab + (8 + rr) * 144 + cc * 16);
        LDS_WAIT();
        *(u32x4*)(g0 + (unsigned)((16 * hf + rr) * ldc + cc * 8)) = a; *(u32x4*)(g0 + (unsigned)((16 * hf + 8 + rr) * ldc + cc * 8)) = b;
    }
}
DI void st_rows64b_32(LAS unsigned char* slab, int lane, int l31, int hh, const u32x4 (&w)[2], unsigned char* g0, int ldc) {
#pragma unroll
    for (int hf = 0; hf < 2; ++hf) {
        if ((l31 >> 4) == hf) { LAS unsigned char* d = slab + (l31 & 15) * 80 + hh * 16; *(LAS u32x4*)(d) = w[0]; *(LAS u32x4*)(d + 32) = w[1]; }
        LDS_WAIT();
        const int rr = lane >> 2, cc = lane & 3;
        const u32x4 a = *(const LAS u32x4*)(slab + rr * 80 + cc * 16);
        LDS_WAIT();
        *(u32x4*)(g0 + (unsigned)((16 * hf + rr) * ldc + cc * 16)) = a;
    }
}
DI u32x4 pack16_fp8(const f32x16& a, float sc) { u32x4 w;
#pragma unroll
    for (int g = 0; g < 4; ++g) { int ww = 0; ww = __builtin_amdgcn_cvt_pk_fp8_f32(__builtin_amdgcn_fmed3f(a[4 * g] * sc, -448.f, 448.f), __builtin_amdgcn_fmed3f(a[4 * g + 1] * sc, -448.f, 448.f), ww, false);
        ww = __builtin_amdgcn_cvt_pk_fp8_f32(__builtin_amdgcn_fmed3f(a[4 * g + 2] * sc, -448.f, 448.f), __builtin_amdgcn_fmed3f(a[4 * g + 3] * sc, -448.f, 448.f), ww, true); w[g] = (unsigned)ww; }
    return w; }
constexpr float Y8SCALE = 128.f;
struct EpiPlain8 {
    unsigned char* out; LAS unsigned char* slab0;
    DI void operator()(const pg8::Acc32& acc, const Unit& u, int wr, int wc, int l31, int hh) const {
#pragma unroll
        for (int ai = 0; ai < 2; ++ai)
#pragma unroll
            for (int mi = 0; mi < 2; ++mi) { u32x4 w[2];
#pragma unroll
                for (int bj = 0; bj < 2; ++bj) w[bj] = pack16_fp8(acc[ai][bj][mi], Y8SCALE);
                st_rows64b_32(EPI_SLABP, l31 + 32 * hh, l31, hh, w, out + (size_t)(u.pm * 256 + ai * 128 + wr * 64 + mi * 32) * DM + u.pn * 256 + wc * 64, DM); }
    }
};
struct EpiSwiGLU8 {
    unsigned char* hbuf;
    DI void operator()(const pg8::Acc32& acc, const Unit& u, int wr, int wc, int l31, int hh) const {
#pragma unroll
        for (int ai = 0; ai < 2; ++ai)
#pragma unroll
            for (int mi = 0; mi < 2; ++mi) { const f32x16& a = acc[ai][0][mi]; const f32x16& b = acc[ai][1][mi]; u32x4 w;
#pragma unroll
                for (int g = 0; g < 4; ++g) { float o[4];
#pragma unroll
                    for (int j = 0; j < 4; ++j) { const float x = a[4 * g + j]; o[j] = __builtin_amdgcn_fmed3f(x * sigmoidf_(x) * (b[4 * g + j] * H8SCALE), -448.f, 448.f); }
                    int ww = 0; ww = __builtin_amdgcn_cvt_pk_fp8_f32(o[0], o[1], ww, false); ww = __builtin_amdgcn_cvt_pk_fp8_f32(o[2], o[3], ww, true); w[g] = (unsigned)ww; }
                *(u32x4*)(hbuf + (size_t)(u.pm * 256 + ai * 128 + wr * 64 + mi * 32) * DEXP + (unsigned)(l31 * DEXP + u.pn * 128 + wc * 32 + hh * 16)) = w; }
    }
};
struct EpiInProj8 {
    bf16* z; const float* bias; LAS unsigned char* slab0;
    DI void operator()(const pg8::Acc32& acc, const Unit& u, int wr, int wc, int l31, int hh) const {
        const int col0 = ZC_F8 + u.pn * 256 + wc * 64;
        f32x4 bv[2][4];
#pragma unroll
        for (int bj = 0; bj < 2; ++bj)
#pragma unroll
            for (int g = 0; g < 4; ++g) bv[bj][g] = *(const f32x4*)(bias + col0 + bj * 32 + hh * 16 + 4 * g);
#pragma unroll
        for (int ai = 0; ai < 2; ++ai)
#pragma unroll
            for (int mi = 0; mi < 2; ++mi) { u32x4 w[2][2];
#pragma unroll
                for (int bj = 0; bj < 2; ++bj) { const f32x16& a = acc[ai][bj][mi];
                    w[bj][0] = pack8((f32x4){a[0], a[1], a[2], a[3]} + bv[bj][0], (f32x4){a[4], a[5], a[6], a[7]} + bv[bj][1]);
                    w[bj][1] = pack8((f32x4){a[8], a[9], a[10], a[11]} + bv[bj][2], (f32x4){a[12], a[13], a[14], a[15]} + bv[bj][3]); }
                st_rows64_32(EPI_SLABP, l31 + 32 * hh, l31, hh, w, z + (size_t)(u.pm * 256 + ai * 128 + wr * 64 + mi * 32) * ZW + col0, ZW); }
    }
};
constexpr float A8SCALE = 8.f, ATT8SCALE = 16.f;
template <int ADD, int OUT8> struct EpiGate8 {
    void* out; const bf16* gate; const bf16* prev; LAS unsigned char* slab0;
    DI void operator()(const pg8::Acc32& acc, const Unit& u, int wr, int wc, int l31, int hh) const {
        const int colw = u.pn * 256 + wc * 64;
#pragma unroll
        for (int ai = 0; ai < 2; ++ai)
#pragma unroll
            for (int mi = 0; mi < 2; ++mi) { const int row0 = u.pm * 256 + ai * 128 + wr * 64 + mi * 32, row = row0 + l31; f32x16 o[2];
#pragma unroll
                for (int bj = 0; bj < 2; ++bj) { const int col = colw + bj * 32 + hh * 16; const f32x16& a = acc[ai][bj][mi];
                    f32x4 g[4]; { const u32x4 w0 = *(const u32x4*)(gate + (size_t)row * ZW + col), w1 = *(const u32x4*)(gate + (size_t)row * ZW + col + 8); unpack8(w0, g[0], g[1]); unpack8(w1, g[2], g[3]); }
                    f32x4 p[4];
                    if (ADD) { const u32x4 w0 = *(const u32x4*)(prev + (size_t)row * DM + col), w1 = *(const u32x4*)(prev + (size_t)row * DM + col + 8); unpack8(w0, p[0], p[1]); unpack8(w1, p[2], p[3]); }
#pragma unroll
                    for (int q = 0; q < 4; ++q) { const f32x4 s = sig4(g[q]);
#pragma unroll
                        for (int j = 0; j < 4; ++j) o[bj][4 * q + j] = ADD ? p[q][j] + s[j] * a[4 * q + j] : s[j] * a[4 * q + j]; } }
                if (OUT8) { u32x4 w[2]; w[0] = pack16_fp8(o[0], A8SCALE); w[1] = pack16_fp8(o[1], A8SCALE);
                    st_rows64b_32(EPI_SLABP, l31 + 32 * hh, l31, hh, w, (unsigned char*)out + (size_t)row0 * DM + colw, DM); }
                else { u32x4 w[2][2];
#pragma unroll
                    for (int bj = 0; bj < 2; ++bj) { const f32x16& v = o[bj];
                        w[bj][0] = pack8((f32x4){v[0], v[1], v[2], v[3]}, (f32x4){v[4], v[5], v[6], v[7]}); w[bj][1] = pack8((f32x4){v[8], v[9], v[10], v[11]}, (f32x4){v[12], v[13], v[14], v[15]}); }
                    st_rows64_32(EPI_SLABP, l31 + 32 * hh, l31, hh, w, (bf16*)out + (size_t)row0 * DM + colw, DM); } }
    }
};
struct EpiResid8 {
    const bf16* hb; bf16* r; LAS unsigned char* slab0;
    DI void operator()(const pg8::Acc32& acc, const Unit& u, int wr, int wc, int l31, int hh) const {
        const int colw = u.pn * 256 + wc * 64;
#pragma unroll
        for (int ai = 0; ai < 2; ++ai)
#pragma unroll
            for (int mi = 0; mi < 2; ++mi) { const int row0 = u.pm * 256 + ai * 128 + wr * 64 + mi * 32, row = row0 + l31; u32x4 w[2][2];
#pragma unroll
                for (int bj = 0; bj < 2; ++bj) { const int col = colw + bj * 32 + hh * 16; const f32x16& a = acc[ai][bj][mi];
                    f32x4 h[4]; { const u32x4 w0 = *(const u32x4*)(hb + (size_t)row * DM + col), w1 = *(const u32x4*)(hb + (size_t)row * DM + col + 8); unpack8(w0, h[0], h[1]); unpack8(w1, h[2], h[3]); }
                    w[bj][0] = pack8(h[0] * ALPHA + (f32x4){a[0], a[1], a[2], a[3]}, h[1] * ALPHA + (f32x4){a[4], a[5], a[6], a[7]});
                    w[bj][1] = pack8(h[2] * ALPHA + (f32x4){a[8], a[9], a[10], a[11]}, h[3] * ALPHA + (f32x4){a[12], a[13], a[14], a[15]}); }
                st_rows64_32(EPI_SLABP, l31 + 32 * hh, l31, hh, w, r + (size_t)row0 * DM + colw, DM); }
    }
};
struct InProjOrderA : pg8::StaticOrder<DM * 2, DM * 2, RROWS / 256, NT_BF + 1> {
    DI bool next(int i, Unit& u) const { if (!pg8::StaticOrder<DM * 2, DM * 2, RROWS / 256, NT_BF + 1>::next(i, u)) return false; if (u.pn == NT_BF) { u.pn = 44; u.ub = 44u * 256u * (unsigned)(DM * 2); } return true; }
};
struct InProjOrder8 { static constexpr int nM = RROWS / 256, nN = NT_F8, nwg = nM * nN, nA = (RROWS / 256) * (NT_BF + 1);
    const char* A; const char* B; int G, c, heavy, R0;
    DI void init(const void* A_, const void* B_, int G_, int c_) { A = (const char*)A_; B = (const char*)B_; G = G_; c = c_; heavy = nA % G_;
        const int light = G_ - heavy; int r0 = (nwg - (8 * light) / 5 + G_ / 2) / G_; if (r0 < 0) r0 = 0; R0 = ((r0 * G_) % 8 == 0) ? r0 : 0; }
    DI bool next(int i, Unit& u) const {
        int L, wgid;
        if (i < R0) { L = i * G + c; wgid = pg8::xcd_remap(L, R0 * G); }
        else { if (c < heavy) return false; L = R0 * G + (i - R0) * (G - heavy) + (c - heavy); if (L >= nwg) return false; wgid = L; }
        const int nig = pg8::WGM * nN, gid = wgid / nig, fm = gid * pg8::WGM, gsz = (nM - fm) < pg8::WGM ? (nM - fm) : pg8::WGM;
        u.pm = fm + ((wgid % nig) % gsz); u.pn = (wgid % nig) / gsz;
        u.ua = (unsigned)u.pm * (unsigned)(256 * DM); u.ub = (unsigned)u.pn * (unsigned)(256 * DM); return true;
    }
};
template <int NJ, int KKB, bool GATHER> struct MoeOrder {
    const char* A; const char* B; const volatile LAS int* tileL; const int* tokI; int ntr, nunits, G, c;
    DI void init(const void* A_, const void* B_, const int* tab, const int* tok_, LAS unsigned char* lds, int tid, int G_, int c_) {
        A = (const char*)A_; B = (const char*)B_; tokI = tok_; G = G_; c = c_;
        LAS int* tl = (LAS int*)(lds + TILET_OFF);
        const int n0 = tab[0];
#pragma clang loop vectorize(disable) unroll(disable)
        for (int i = tid; i < n0 + 8; i += NT) tl[i] = tab[i];
        __syncthreads();
        tileL = (const volatile LAS int*)tl; ntr = __builtin_amdgcn_readfirstlane(n0); nunits = (ntr + NSHT) * NJ; }
    DI bool next(int i, Unit& u) const {
        const int L = i * G + c; if (L >= nunits) return false;
        const int Lr = pg8::xcd_remap(L, nunits), tau = Lr / NJ, j = Lr - tau * NJ;
        const int e = tau < ntr ? __builtin_amdgcn_readfirstlane(tileL[8 + tau]) : 64;
        u.pm = tau; u.pn = j;
        u.ua = GATHER ? 0u : (unsigned)tau * (unsigned)(256 * KKB);
        u.ub = (unsigned)(e * NJ + j) * (unsigned)(256 * KKB); return true;
    }
    DI int tok(const Unit& u, int row) const { return tokI[u.pm * 256 + row]; }
    DI const int* tokp(const Unit& u) const { return tokI + u.pm * 256; }
};

DI void phase_prep(const Frame& F, PK P, int l) {
    unsigned char* ws = F.ws;
    const bf16* z = (const bf16*)(ws + WS_Z); const float* zs = (const float*)(ws + WS_ZS); const float* rope = (const float*)(ws + WS_ROPE);
    bf16* krr = (bf16*)(ws + WS_KRR); bf16* qkc = (bf16*)(ws + WS_QKC); float* gates = (float*)(ws + WS_GATES); float* rstd = (float*)(ws + WS_RSTD);
    const float* cw = P->in[I_CONVW] + (size_t)l * 4 * 2048; const float* cb = P->in[I_CONVB] + (size_t)l * 2048;
    const int gw = F.vcu * NW + F.wave, NGW = F.G * NW, lane = F.lane;
    u32x4 nq = {0u, 0u, 0u, 0u}, nk = nq;
    if (gw < RROWS) { nq = *(const u32x4*)(z + (size_t)gw * ZW + ZC_CQ + 8 * lane); nk = *(const u32x4*)(z + (size_t)gw * ZW + ZC_CKV + 8 * lane); }
    for (int r = gw; r < RROWS; r += NGW) {
        const int b = r < NREAL ? (r >> 12) : ((r - NREAL) >> 6), p = r < NREAL ? 64 + (r & 4095) : ((r - NREAL) & 63), t = p - PADL;
        {
            const u32x4 wq = nq, wk = nk;
            if (r + NGW < RROWS) { nq = *(const u32x4*)(z + (size_t)(r + NGW) * ZW + ZC_CQ + 8 * lane); nk = *(const u32x4*)(z + (size_t)(r + NGW) * ZW + ZC_CKV + 8 * lane); }
            f32x4 a0, a1, b0, b1; unpack8(wq, a0, a1); unpack8(wk, b0, b1);
            float sq = 0.f, sk = 0.f;
#pragma unroll
            for (int j = 0; j < 4; ++j) { sq += a0[j] * a0[j] + a1[j] * a1[j]; sk += b0[j] * b0[j] + b1[j] * b1[j]; }
            sq = wave_sum(sq); sk = wave_sum(sk);
            if (lane == 0) { rstd[(size_t)r * 2] = 1.f / sqrtf(sq * (1.f / 512.f) + RMS_EPS); rstd[(size_t)r * 2 + 1] = 1.f / sqrtf(sk * (1.f / 512.f) + RMS_EPS); }
        }
        if (lane < 32) {
            const int tt = t < 0 ? 0 : t; const float x1 = zs[(size_t)r * 128 + lane], x2 = zs[(size_t)r * 128 + 32 + lane], c = rope[tt * 64 + lane], s = rope[tt * 64 + 32 + lane];
            float o1 = x1 * c - x2 * s, o2 = x1 * s + x2 * c; if (t < 0) { o1 = 0.f; o2 = 0.f; }
            krr[(size_t)r * 64 + lane] = (bf16)(pk2(o1, 0.f) & 0xffffu); krr[(size_t)r * 64 + 32 + lane] = (bf16)(pk2(o2, 0.f) & 0xffffu);
        }
        if (lane < 8) {
            const float mi = zs[(size_t)r * 128 + 64 + lane], mf = zs[(size_t)r * 128 + 72 + lane];
            float lf = fminf(mf, 0.f) - log1pf(expf(-fabsf(mf))), ig = mi;
            if (t < 0) { lf = 0.f; ig = -1e30f; }
            gates[(size_t)r * 16 + lane] = lf; gates[(size_t)r * 16 + 8 + lane] = ig;
        }
    }
    for (int task = gw; task < NBATCH * 65 * 4; task += NGW) {
        const int ci = task >> 2, qd = task & 3, b = ci / 65, c = ci - b * 65, c0 = (qd * 64 + lane) * 8;
        const size_t row0 = (size_t)chunk_row0(b, c);
        f32x4 w[4][2], bia[2];
#pragma unroll
        for (int jj = 0; jj < 4; ++jj) { w[jj][0] = *(const f32x4*)(cw + jj * 2048 + c0); w[jj][1] = *(const f32x4*)(cw + jj * 2048 + c0 + 4); }
        bia[0] = *(const f32x4*)(cb + c0); bia[1] = *(const f32x4*)(cb + c0 + 4);
        f32x4 xm[3][2];
#pragma unroll
        for (int j = 0; j < 3; ++j) { xm[j][0] = (f32x4){0.f, 0.f, 0.f, 0.f}; xm[j][1] = (f32x4){0.f, 0.f, 0.f, 0.f}; }
        if (c >= 1) { const size_t rp = (size_t)chunk_row0(b, c - 1) + 61;
#pragma unroll
            for (int j = 0; j < 3; ++j) { const u32x4 xw = *(const u32x4*)(z + (rp + j) * ZW + ZC_MQ + c0); unpack8(xw, xm[j][0], xm[j][1]); } }
        const float sc = c0 >= 1024 ? 0.08838834764831845f : 1.f;
        u32x4 xn[8];
#pragma unroll
        for (int i = 0; i < 8; ++i) xn[i] = *(const u32x4*)(z + (row0 + i) * ZW + ZC_MQ + c0);
#pragma unroll 1
        for (int i0 = 0; i0 < 64; i0 += 8) {
            u32x4 xr[8];
#pragma unroll
            for (int i = 0; i < 8; ++i) xr[i] = xn[i];
            if (i0 + 8 < 64) {
#pragma unroll
                for (int i = 0; i < 8; ++i) xn[i] = *(const u32x4*)(z + (row0 + i0 + 8 + i) * ZW + ZC_MQ + c0); }
#pragma unroll
            for (int i = 0; i < 8; ++i) { f32x4 x0, x1; unpack8(xr[i], x0, x1);
                if (c == 0 && i0 + i < PADL) { x0 = (f32x4){0.f, 0.f, 0.f, 0.f}; x1 = x0; }
                f32x4 a0 = bia[0] + w[0][0] * xm[0][0] + w[1][0] * xm[1][0] + w[2][0] * xm[2][0] + w[3][0] * x0;
                f32x4 a1 = bia[1] + w[0][1] * xm[0][1] + w[1][1] * xm[1][1] + w[2][1] * xm[2][1] + w[3][1] * x1;
                xm[0][0] = xm[1][0]; xm[0][1] = xm[1][1]; xm[1][0] = xm[2][0]; xm[1][1] = xm[2][1]; xm[2][0] = x0; xm[2][1] = x1;
                a0 = a0 * sig4(a0) * sc; a1 = a1 * sig4(a1) * sc;
                *(u32x4*)(qkc + (row0 + i0 + i) * 2048 + c0) = pack8(a0, a1); }
        }
    }
}

constexpr int ML_VW = 64, ML_NVT = ML_VW / 16, ML_NNT = ML_NVT + 1, ML_VR = 16 * ML_NNT;
constexpr int ML_SQ = 0, ML_SK = 17408, ML_SKT = 34816, ML_SVT = 53248, ML_SP = ML_SVT + ML_VR * 144, ML_CTB = ML_VR * 272, ML_SCT = ML_SP + 64 * 144, ML_SCAL = ML_SCT + 2 * ML_CTB, ML_SCB = 336 * 4;
constexpr int ML_SVTE = ML_SCAL + 2 * ML_SCB;
static_assert(ML_SVTE + ML_VR * 144 <= MISC_OFF, "mLSTM LDS map");
DI bf16x8 ldfrag(LAS unsigned char* L, int base, int stride, int row, int kb) { return *(const LAS bf16x8*)(L + base + row * stride + kb); }
DI bf16 f2b(float x) { return (bf16)(pk2(x, 0.f) & 0xffffu); }
#define MFMA16(a, b, c) __builtin_amdgcn_mfma_f32_16x16x32_bf16((a), (b), (c), 0, 0, 0)
#define MFMA32(a, b, c) __builtin_amdgcn_mfma_f32_32x32x16_bf16((a), (b), (c), 0, 0, 0)

DI float mlstm_scan(LAS float* SC, float lf, float ig, int lane, float mprev) {
    const float bs = wave_scan_sum(lf);
    const float g = rlane(bs, 63);
    const float u = ig - bs;
    const float pm = wave_scan_max(u);
    const float M = fmaxf(pm, mprev);
    const float a = g + u, amax = wave_max(a), mnew = fmaxf(g + mprev, amax);
    SC[lane] = u; SC[64 + lane] = M; SC[128 + lane] = __expf(mprev - M); SC[192 + lane] = __expf(a - mnew); SC[256 + lane] = __expf(-(bs + M));
    if (lane == 0) SC[320] = __expf(g + mprev - mnew);
    return mnew;
}

DI void mlstm_task(const Frame& F, int b, int hd, int vs) {
    unsigned char* wsl = F.ws; asm volatile("" : "+s"(wsl));
    const bf16* z = (const bf16*)(wsl + WS_Z); const bf16* qkc = (const bf16*)(wsl + WS_QKC); const float* gates = (const float*)(wsl + WS_GATES); bf16* hraw = (bf16*)(wsl + WS_HRAW);
    LAS unsigned char* L = F.lds; int tid = F.tid; asm volatile("" : "+v"(tid)); const int lane = tid & 63, wave = F.wave, l15 = lane & 15, lq = lane >> 4;
    for (int i = tid; i < 16 * 72; i += NT) { const int r = ML_VW + i / 72, c = i % 72; *(LAS bf16*)(L + ML_SVT + r * 144 + c * 2) = (r == ML_VW) ? (bf16)0x3F80 : (bf16)0; *(LAS bf16*)(L + ML_SVTE + r * 144 + c * 2) = (bf16)0; }
    for (int i = tid; i < 2 * ML_CTB / 4; i += NT) *(LAS unsigned*)(L + ML_SCT + i * 4) = 0u;
    f32x4 accC[2][ML_NNT];
#pragma unroll
    for (int a = 0; a < 2; ++a)
#pragma unroll
        for (int n = 0; n < ML_NNT; ++n) accC[a][n] = (f32x4){0.f, 0.f, 0.f, 0.f};
    const int s0 = (lane & 15) + 16 * (wave & 1), dc = (lane >> 4) + 4 * (wave >> 1), sv = tid >> 3, c8 = tid & 7;
    const bf16* gq = qkc + (size_t)s0 * 2048 + hd * 128 + 8 * dc;
    const bf16* gv = z + (size_t)sv * ZW + ZC_MV + hd * 256 + ML_VW * vs + 8 * c8;
    u32x4 rq0, rq1, rk0, rk1, rv;
#define GAS __attribute__((address_space(1)))
#define ML_ISSUE(c) do { const size_t ro = (size_t)chunk_row0(b, (c)); rq0 = *(const GAS u32x4*)(gq + ro * 2048); rq1 = *(const GAS u32x4*)(gq + (ro + 32) * 2048); rk0 = *(const GAS u32x4*)(gq + ro * 2048 + 1024); rk1 = *(const GAS u32x4*)(gq + (ro + 32) * 2048 + 1024); \
        rv = *(const GAS u32x4*)(gv + ro * ZW); } while (0)
#define ML_KT(kv, s) do { _Pragma("unroll") for (int e = 0; e < 4; ++e) { *(LAS bf16*)(L + ML_SKT + (8 * dc + 2 * e) * 144 + ((s) ^ ((dc & 3) << 4)) * 2) = (bf16)((kv)[e] & 0xffffu); *(LAS bf16*)(L + ML_SKT + (8 * dc + 2 * e + 1) * 144 + ((s) ^ ((dc & 3) << 4)) * 2) = (bf16)((kv)[e] >> 16); } } while (0)
#define ML_COMMIT_E(SCn) do { const float ea_ = (SCn)[192 + sv]; \
        _Pragma("unroll") for (int e = 0; e < 4; ++e) { *(LAS bf16*)(L + ML_SVTE + (8 * c8 + 2 * e) * 144 + (sv ^ ((c8 & 3) << 4)) * 2) = f2b(bflo(rv[e]) * ea_); *(LAS bf16*)(L + ML_SVTE + (8 * c8 + 2 * e + 1) * 144 + (sv ^ ((c8 & 3) << 4)) * 2) = f2b(bfhi(rv[e]) * ea_); } \
        if (c8 == 0) *(LAS bf16*)(L + ML_SVTE + ML_VW * 144 + sv * 2) = f2b(ea_); } while (0)
#define ML_COMMIT() do { *(LAS u32x4*)(L + ML_SQ + s0 * 272 + dc * 16) = rq0; *(LAS u32x4*)(L + ML_SQ + (s0 + 32) * 272 + dc * 16) = rq1; *(LAS u32x4*)(L + ML_SK + s0 * 272 + dc * 16) = rk0; *(LAS u32x4*)(L + ML_SK + (s0 + 32) * 272 + dc * 16) = rk1; \
        ML_KT(rk0, s0); ML_KT(rk1, s0 + 32); \
        { _Pragma("unroll") for (int e = 0; e < 4; ++e) { *(LAS bf16*)(L + ML_SVT + (8 * c8 + 2 * e) * 144 + (sv ^ ((c8 & 3) << 4)) * 2) = (bf16)(rv[e] & 0xffffu); *(LAS bf16*)(L + ML_SVT + (8 * c8 + 2 * e + 1) * 144 + (sv ^ ((c8 & 3) << 4)) * 2) = (bf16)(rv[e] >> 16); } } } while (0)
    ML_ISSUE(0);
    float mrun = 0.f;
    float lfn = 0.f, ign = 0.f;
#define ML_GATES(c) do { const size_t rg_ = (size_t)chunk_row0(b, (c)) + lane; lfn = *(const GAS float*)(gates + rg_ * 16 + hd); ign = *(const GAS float*)(gates + rg_ * 16 + 8 + hd); } while (0)
    if (wave == 7) { ML_GATES(0); mrun = mlstm_scan((LAS float*)(L + ML_SCAL), lfn, ign, lane, 0.f); ML_GATES(1); }
    __syncthreads();
    ML_COMMIT(); ML_COMMIT_E((LAS float*)(L + ML_SCAL));
    __syncthreads();
    int cur = 0;
#pragma unroll 1
    for (int c = 0; c < 65; ++c) {
        const size_t r0 = (size_t)chunk_row0(b, c);
        LAS float* SC = (LAS float*)(L + ML_SCAL + (c & 1) * ML_SCB);
        if (c + 1 < 65) ML_ISSUE(c + 1);
#pragma unroll
        for (int q = 0; q < 2; ++q) { const int tile = 2 * wave + q, tt = tile >> 2, st = tile & 3; f32x4 acc = (f32x4){0.f, 0.f, 0.f, 0.f};
            if (st <= tt) {
#pragma unroll
                for (int kk = 0; kk < 4; ++kk) acc = MFMA16(ldfrag(L, ML_SQ, 272, tt * 16 + l15, kk * 64 + lq * 16), ldfrag(L, ML_SK, 272, st * 16 + l15, kk * 64 + lq * 16), acc); }
            const int s = st * 16 + l15; const float us = SC[s];
#pragma unroll
            for (int rg = 0; rg < 4; ++rg) { const int t = tt * 16 + 4 * lq + rg; const float v = (s <= t) ? acc[rg] * __expf(us - SC[64 + t]) : 0.f;
                *(LAS bf16*)(L + ML_SP + t * 144 + s * 2) = f2b(v); } }
        if (wave == 7 && c + 1 < 65) { mrun = mlstm_scan((LAS float*)(L + ML_SCAL + ((c + 1) & 1) * ML_SCB), lfn, ign, lane, mrun); if (c + 2 < 65) ML_GATES(c + 2); }
        __syncthreads();
        if (wave < 4) {
            const int tt = wave; f32x4 a1[ML_NNT], a2[ML_NNT];
#pragma unroll
            for (int n = 0; n < ML_NNT; ++n) { a1[n] = (f32x4){0.f, 0.f, 0.f, 0.f}; a2[n] = (f32x4){0.f, 0.f, 0.f, 0.f}; }
#pragma unroll
            for (int kk = 0; kk < 2; ++kk) { const bf16x8 A = ldfrag(L, ML_SP, 144, tt * 16 + l15, kk * 64 + lq * 16);
#pragma unroll
                for (int n = 0; n < ML_NNT; ++n) a1[n] = MFMA16(ldfrag(L, ML_SVT, 144, n * 16 + l15, (kk * 64 + lq * 16) ^ ((((n * 16 + l15) >> 3) & 3) << 5)), A, a1[n]); }
#pragma unroll
            for (int kk = 0; kk < 4; ++kk) { const bf16x8 A = ldfrag(L, ML_SQ, 272, tt * 16 + l15, kk * 64 + lq * 16);
#pragma unroll
                for (int n = 0; n < ML_NNT; ++n) a2[n] = MFMA16(ldfrag(L, ML_SCT + cur * ML_CTB, 272, n * 16 + l15, kk * 64 + lq * 16), A, a2[n]); }
            const int t = tt * 16 + l15; const float ein = SC[128 + t], emr = SC[256 + t];
            const float rd = a1[ML_NVT][0] + ein * a2[ML_NVT][0];
            const float den = __shfl(rd, l15); const float dn = 1.f / fmaxf(fabsf(den), emr);
            bf16* op = hraw + (r0 + t) * 2048 + hd * 256 + ML_VW * vs + 4 * lq;
#pragma unroll
            for (int n = 0; n < ML_NVT; ++n) { const f32x4 o = (a1[n] + a2[n] * ein) * dn; u32x2 w; w.x = pk2(o[0], o[1]); w.y = pk2(o[2], o[3]); *(GAS u32x2*)(op + 16 * n) = w; }
        } else {
            const int w4 = wave - 4; const float decay = SC[320]; const int nxt = cur ^ 1;
            bf16x8 Bf[2][ML_NNT];
#pragma unroll
            for (int kk = 0; kk < 2; ++kk)
#pragma unroll
                for (int n = 0; n < ML_NNT; ++n) { const int sw = (kk * 32 + lq * 8) ^ ((((n * 16 + l15) >> 3) & 3) << 4);
                    Bf[kk][n] = *(const LAS bf16x8*)(L + ML_SVTE + (n * 16 + l15) * 144 + sw * 2); }
#pragma unroll
            for (int di = 0; di < 2; ++di) { const int dt = 2 * w4 + di;
#pragma unroll
                for (int n = 0; n < ML_NNT; ++n) accC[di][n] = accC[di][n] * decay;
#pragma unroll
                for (int kk = 0; kk < 2; ++kk) { const bf16x8 A = ldfrag(L, ML_SKT, 144, dt * 16 + l15, (kk * 64 + lq * 16) ^ ((((dt * 16 + l15) >> 3) & 3) << 5));
#pragma unroll
                    for (int n = 0; n < ML_NNT; ++n) accC[di][n] = MFMA16(A, Bf[kk][n], accC[di][n]); }
#pragma unroll
                for (int n = 0; n < ML_NNT; ++n) { u32x2 w; w.x = pk2(accC[di][n][0], accC[di][n][1]); w.y = pk2(accC[di][n][2], accC[di][n][3]);
                    *(LAS u32x2*)(L + ML_SCT + nxt * ML_CTB + (n * 16 + l15) * 272 + (dt * 16 + 4 * lq) * 2) = w; } }
        }
        __syncthreads();
        if (c + 1 < 65) { ML_COMMIT(); ML_COMMIT_E((LAS float*)(L + ML_SCAL + ((c + 1) & 1) * ML_SCB)); }
        __syncthreads();
        cur ^= 1;
    }
#undef ML_ISSUE
#undef ML_GATES
#undef ML_KT
#undef ML_COMMIT
#undef ML_COMMIT_E
}

constexpr int AT_KB = 64 * 384, AT_BUF = AT_KB + 128 * 128, AT_NBUF = 3;
#ifndef AT_STAGGER
#define AT_STAGGER 6
#endif
#ifndef AT_OLD
#define AT_OLD 1
#endif
DI void attn_item(const Frame& F, int b, int hd, int G) {
    unsigned char* wsl = F.ws; asm volatile("" : "+s"(wsl));
    const bf16* q = (const bf16*)(wsl + WS_Q); const bf16* kn = (const bf16*)(wsl + WS_KN); const bf16* krr = (const bf16*)(wsl + WS_KRR); const bf16* vt = (const bf16*)(wsl + WS_VT);
    const float* rope = (const float*)(wsl + WS_ROPE); bf16* att = (bf16*)(wsl + WS_ATT);
    LAS unsigned char* L = F.lds; int tid = F.tid; asm volatile("" : "+v"(tid)); const int lane = tid & 63, wave = F.wave, l31 = lane & 31, hh = lane >> 5;
    const int qbase = (G == 0) ? 0 : 64 + 256 * (G - 1), nq = (G == 0) ? 2 : 8, nk = (G == 0) ? 1 : 1 + 4 * G;
    const size_t qrow0 = (G == 0) ? (size_t)(NREAL + 64 * b) : (size_t)(b * SEQ + 256 * (G - 1));
    const bool act = wave < nq;
    const int qp = qbase + 32 * wave + l31, qmax = qbase + 32 * wave + 31;
    const size_t qr = qrow0 + 32 * wave + l31;
    const char* gbase = (const char*)kn;
    unsigned srcK[3], srcV[2]; bool isr[3];
#pragma unroll
    for (int i = 0; i < 3; ++i) { const int ci = 64 * (wave * 3 + i) + lane, key = ci / 24, cp = ci - key * 24, c = (cp & ~7) | ((cp & 7) ^ ((key >> 1) & 7));
        isr[i] = c >= 16;
        srcK[i] = isr[i] ? (unsigned)((const char*)(krr + (size_t)key * 64 + 8 * (c - 16)) - gbase) : (unsigned)((const char*)(kn + (size_t)key * 1024 + hd * 128 + 8 * c) - gbase); }
#pragma unroll
    for (int i = 0; i < 2; ++i) { const int ci = 64 * (wave * 2 + i) + lane, dv = ci >> 3, cp = ci & 7, c = cp ^ ((dv >> 1) & 7);
        srcV[i] = (unsigned)((const char*)(vt + (size_t)(hd * 128 + dv) * RROWS + 8 * c) - gbase); }
#define AT_ISSUE(kt) do { const unsigned ko = (unsigned)chunk_row0(b, (kt)); const int bo_ = ((kt) % AT_NBUF) * AT_BUF; \
        _Pragma("unroll") for (int i_ = 0; i_ < 3; ++i_) __builtin_amdgcn_global_load_lds((const unsigned*)(gbase + (unsigned)(srcK[i_] + ko * (isr[i_] ? 128u : 2048u))), (LAS unsigned*)(L + bo_ + (wave * 3 + i_) * 1024), 16, 0, 0); \
        _Pragma("unroll") for (int i_ = 0; i_ < 2; ++i_) __builtin_amdgcn_global_load_lds((const unsigned*)(gbase + (unsigned)(srcV[i_] + ko * 2u)), (LAS unsigned*)(L + bo_ + AT_KB + (wave * 2 + i_) * 1024), 16, 0, 0); } while (0)
    AT_ISSUE(0);
    if (nk > 1) AT_ISSUE(1);
    bf16x8 Qf[12];
    if (act) { const bf16* qrow = q + qr * 1536 + hd * 192 + 8 * hh;
#pragma unroll
      for (int s = 0; s < 12; ++s) Qf[s] = *(const GAS bf16x8*)(qrow + 16 * s);
      int t = qp - PADL; if (t < 0) t = 0;
#pragma unroll
      for (int s2 = 0; s2 < 2; ++s2) { const int i0 = 16 * s2 + 8 * hh;
          const f32x4 c0 = *(const GAS f32x4*)(rope + t * 64 + i0), c1 = *(const GAS f32x4*)(rope + t * 64 + i0 + 4), s0 = *(const GAS f32x4*)(rope + t * 64 + 32 + i0), s1 = *(const GAS f32x4*)(rope + t * 64 + 32 + i0 + 4);
          const u32x4 w1 = __builtin_bit_cast(u32x4, Qf[8 + s2]), w2 = __builtin_bit_cast(u32x4, Qf[10 + s2]);
          f32x4 x10, x11, x20, x21; unpack8(w1, x10, x11); unpack8(w2, x20, x21);
          const f32x4 o10 = x10 * c0 - x20 * s0, o11 = x11 * c1 - x21 * s1, o20 = x10 * s0 + x20 * c0, o21 = x11 * s1 + x21 * c1;
          Qf[8 + s2] = __builtin_bit_cast(bf16x8, pack8(o10, o11)); Qf[10 + s2] = __builtin_bit_cast(bf16x8, pack8(o20, o21)); } }
    else {
#pragma unroll
      for (int s = 0; s < 12; ++s) Qf[s] = (bf16x8){0, 0, 0, 0, 0, 0, 0, 0}; }
    f32x16 O[4];
    { float z0 = 0.f; asm volatile("" : "+v"(z0));
#pragma unroll
      for (int d = 0; d < 4; ++d)
#pragma unroll
        for (int i = 0; i < 16; ++i) O[d][i] = z0; }
    float m = -INFINITY, lsum = 0.f;
    const int pi = (l31 & 0x13) | ((l31 & 4) << 1) | ((l31 & 8) >> 1);
    int koff[4];
#pragma unroll
    for (int j = 0; j < 4; ++j) koff[j] = pi * 384 + (((2 * j + hh) ^ ((pi >> 1) & 7)) << 4);
    const int vbase = AT_KB + l31 * 128, vx = (l31 >> 1) & 7;
    asm volatile("s_waitcnt vmcnt(0)" ::: "memory");
#pragma unroll 1
    for (int kt = 0; kt < nk; ++kt) {
        const int bo = (kt % AT_NBUF) * AT_BUF;
        if (kt > 0) { if (kt + 1 < nk) asm volatile("s_waitcnt vmcnt(5)" ::: "memory"); else asm volatile("s_waitcnt vmcnt(0)" ::: "memory"); }
        __builtin_amdgcn_s_barrier();
        asm volatile("" ::: "memory");
        const bool busy = act && 64 * kt <= qmax;
        if (!busy && kt + 2 < nk) AT_ISSUE(kt + 2);
        if (busy) {
            f32x16 S0, S1; bf16x8 Pf0[2], Pf1[2];
            const f32x16 zc = {0.f, 0.f, 0.f, 0.f, 0.f, 0.f, 0.f, 0.f, 0.f, 0.f, 0.f, 0.f, 0.f, 0.f, 0.f, 0.f};
            bf16x8 Kg[12];
            {   bf16x8 Kf[12];
#pragma unroll
                for (int s = 0; s < 12; ++s) Kf[s] = *(const LAS bf16x8*)(L + bo + (s >> 2) * 128 + koff[s & 3]);
                S0 = MFMA32(Kf[0], Qf[0], zc);
#pragma unroll
                for (int s = 1; s < 12; ++s) S0 = MFMA32(Kf[s], Qf[s], S0);
#pragma unroll
                for (int s = 0; s < 4; ++s) Kg[s] = *(const LAS bf16x8*)(L + bo + 32 * 384 + (s >> 2) * 128 + koff[s & 3]);
                __builtin_amdgcn_sched_group_barrier(0x100, 6, 0);
#pragma unroll
                for (int i = 0; i < 10; ++i) { __builtin_amdgcn_sched_group_barrier(0x008, 1, 0); __builtin_amdgcn_sched_group_barrier(0x100, 1, 0); }
                __builtin_amdgcn_sched_group_barrier(0x008, 2, 0);
            }
            __builtin_amdgcn_sched_barrier(0);
            const bool diag = 64 * kt + 63 > qbase + 32 * wave || kt == 0;
            if (diag) {
#pragma unroll
                for (int i = 0; i < 16; ++i) { const int kp = 64 * kt + (i & 3) + 4 * ((i >> 2) & 1) + 8 * hh + 16 * (i >> 3); if (kp > qp || kp < PADL) S0[i] = -INFINITY; } }
            const float mu = (m == -INFINITY) ? 0.f : m;
            bf16x8 Vf[2][4], Vg[2][4];
            float mx, rs;
            {
#pragma unroll
                for (int s = 4; s < 12; ++s) Kg[s] = *(const LAS bf16x8*)(L + bo + 32 * 384 + (s >> 2) * 128 + koff[s & 3]);
                S1 = MFMA32(Kg[0], Qf[0], zc);
#pragma unroll
                for (int s = 1; s < 12; ++s) S1 = MFMA32(Kg[s], Qf[s], S1);
#pragma unroll
                for (int s2 = 0; s2 < 2; ++s2)
#pragma unroll
                    for (int d = 0; d < 4; ++d) Vf[s2][d] = *(const LAS bf16x8*)(L + bo + d * 32 * 128 + vbase + (((2 * s2 + hh) ^ vx) << 4));
                { const float m0 = fmaxf(fmaxf(S0[0], S0[1]), fmaxf(S0[2], S0[3])), m1 = fmaxf(fmaxf(S0[4], S0[5]), fmaxf(S0[6], S0[7])), m2 = fmaxf(fmaxf(S0[8], S0[9]), fmaxf(S0[10], S0[11])), m3 = fmaxf(fmaxf(S0[12], S0[13]), fmaxf(S0[14], S0[15]));
                  mx = fmaxf(fmaxf(m0, m1), fmaxf(m2, m3)); }
#pragma unroll
                for (int i = 0; i < 16; ++i) S0[i] = __builtin_amdgcn_exp2f(S0[i] - mu);
                rs = (((S0[0] + S0[1]) + (S0[2] + S0[3])) + ((S0[4] + S0[5]) + (S0[6] + S0[7]))) + (((S0[8] + S0[9]) + (S0[10] + S0[11])) + ((S0[12] + S0[13]) + (S0[14] + S0[15])));
#pragma unroll
                for (int s2 = 0; s2 < 2; ++s2) { u32x4 w; w.x = pk2(S0[8 * s2], S0[8 * s2 + 1]); w.y = pk2(S0[8 * s2 + 2], S0[8 * s2 + 3]); w.z = pk2(S0[8 * s2 + 4], S0[8 * s2 + 5]); w.w = pk2(S0[8 * s2 + 6], S0[8 * s2 + 7]); Pf0[s2] = __builtin_bit_cast(bf16x8, w); }
                __builtin_amdgcn_sched_group_barrier(0x100, 4, 0);
#pragma unroll
                for (int i = 0; i < 4; ++i) { __builtin_amdgcn_sched_group_barrier(0x008, 1, 0); __builtin_amdgcn_sched_group_barrier(0x100, 1, 0); __builtin_amdgcn_sched_group_barrier(0x002, 5, 0); }
#pragma unroll
                for (int i = 0; i < 8; ++i) { __builtin_amdgcn_sched_group_barrier(0x008, 1, 0); __builtin_amdgcn_sched_group_barrier(0x100, 1, 0); __builtin_amdgcn_sched_group_barrier(0x002, 5, 0); }
                asm volatile("" : "+v"(Pf0[0]), "+v"(Pf0[1]), "+v"(rs), "+v"(mx));
            }
            __builtin_amdgcn_sched_barrier(0);
            if (diag) {
#pragma unroll
                for (int i = 0; i < 16; ++i) { const int kp = 64 * kt + 32 + (i & 3) + 4 * ((i >> 2) & 1) + 8 * hh + 16 * (i >> 3); if (kp > qp || kp < PADL) S1[i] = -INFINITY; } }
            {
#pragma unroll
                for (int s2 = 0; s2 < 2; ++s2)
#pragma unroll
                    for (int d = 0; d < 4; ++d) O[d] = MFMA32(Vf[s2][d], Pf0[s2], O[d]);
#pragma unroll
                for (int s2 = 0; s2 < 2; ++s2)
#pragma unroll
                    for (int d = 0; d < 4; ++d) Vg[s2][d] = *(const LAS bf16x8*)(L + bo + d * 32 * 128 + vbase + (((4 + 2 * s2 + hh) ^ vx) << 4));
                { const float m0 = fmaxf(fmaxf(S1[0], S1[1]), fmaxf(S1[2], S1[3])), m1 = fmaxf(fmaxf(S1[4], S1[5]), fmaxf(S1[6], S1[7])), m2 = fmaxf(fmaxf(S1[8], S1[9]), fmaxf(S1[10], S1[11])), m3 = fmaxf(fmaxf(S1[12], S1[13]), fmaxf(S1[14], S1[15]));
                  mx = fmaxf(mx, fmaxf(fmaxf(m0, m1), fmaxf(m2, m3))); }
#pragma unroll
                for (int i = 0; i < 16; ++i) S1[i] = __builtin_amdgcn_exp2f(S1[i] - mu);
#pragma unroll
                for (int i = 0; i < 8; ++i) { __builtin_amdgcn_sched_group_barrier(0x008, 1, 0); __builtin_amdgcn_sched_group_barrier(0x100, 1, 0); __builtin_amdgcn_sched_group_barrier(0x002, 6, 0); }
#pragma unroll
                for (int s2 = 0; s2 < 2; ++s2) { u32x4 w; w.x = pk2(S1[8 * s2], S1[8 * s2 + 1]); w.y = pk2(S1[8 * s2 + 2], S1[8 * s2 + 3]); w.z = pk2(S1[8 * s2 + 4], S1[8 * s2 + 5]); w.w = pk2(S1[8 * s2 + 6], S1[8 * s2 + 7]); Pf1[s2] = __builtin_bit_cast(bf16x8, w); }
                asm volatile("" : "+v"(Pf1[0]), "+v"(Pf1[1]), "+v"(mx));
            }
            __builtin_amdgcn_sched_barrier(0);
#pragma unroll
            for (int s2 = 0; s2 < 2; ++s2)
#pragma unroll
                for (int d = 0; d < 4; ++d) O[d] = MFMA32(Vg[s2][d], Pf1[s2], O[d]);
            rs += (((S1[0] + S1[1]) + (S1[2] + S1[3])) + ((S1[4] + S1[5]) + (S1[6] + S1[7]))) + (((S1[8] + S1[9]) + (S1[10] + S1[11])) + ((S1[12] + S1[13]) + (S1[14] + S1[15])));
            __builtin_amdgcn_sched_barrier(0);
            if (kt + 2 < nk) AT_ISSUE(kt + 2);
            lsum += rs;
            { const u32x2 sw = __builtin_amdgcn_permlane32_swap(__builtin_bit_cast(unsigned, mx), __builtin_bit_cast(unsigned, mx), false, false); mx = fmaxf(__builtin_bit_cast(float, sw[0]), __builtin_bit_cast(float, sw[1])); }
            if (__any(mx > m + 8.f)) { const float mn = fmaxf(m, mx), f = (mn == -INFINITY) ? 1.f : __builtin_amdgcn_exp2f(mu - mn); lsum *= f; m = mn;
#pragma unroll
                for (int d = 0; d < 4; ++d)
#pragma unroll
                    for (int i = 0; i < 16; ++i) O[d][i] *= f; }
        }
    }
#undef AT_ISSUE
    if (act) {
        const float ltot = lsum + __shfl_xor(lsum, 32), inv = ltot > 0.f ? 1.f / ltot : 0.f;
        if (G == 0) {
            bf16* orow = att + qr * 1024 + hd * 128;
#pragma unroll
            for (int d = 0; d < 4; ++d)
#pragma unroll
                for (int g = 0; g < 4; ++g) { u32x2 w; w.x = pk2(O[d][4 * g] * inv, O[d][4 * g + 1] * inv); w.y = pk2(O[d][4 * g + 2] * inv, O[d][4 * g + 3] * inv);
                    *(GAS u32x2*)(orow + 32 * d + 8 * g + 4 * hh) = w; }
        } else {
            unsigned char* orow8 = wsl + WS_ATT8 + qr * 1024 + hd * 128 + 16 * hh; const float sc = inv * ATT8SCALE;
#pragma unroll
            for (int d = 0; d < 4; ++d) { unsigned pc[4];
#pragma unroll
                for (int g = 0; g < 4; ++g) { int ww = 0;
                    ww = __builtin_amdgcn_cvt_pk_fp8_f32(__builtin_amdgcn_fmed3f(O[d][4 * g] * sc, -448.f, 448.f), __builtin_amdgcn_fmed3f(O[d][4 * g + 1] * sc, -448.f, 448.f), ww, false);
                    ww = __builtin_amdgcn_cvt_pk_fp8_f32(__builtin_amdgcn_fmed3f(O[d][4 * g + 2] * sc, -448.f, 448.f), __builtin_amdgcn_fmed3f(O[d][4 * g + 3] * sc, -448.f, 448.f), ww, true); pc[g] = (unsigned)ww; }
                const u32x2 s02 = __builtin_amdgcn_permlane32_swap(pc[0], pc[2], false, false), s13 = __builtin_amdgcn_permlane32_swap(pc[1], pc[3], false, false);
                *(GAS u32x4*)(orow8 + 32 * d) = (u32x4){s02[0], s02[1], s13[0], s13[1]}; }
        }
    }
    __builtin_amdgcn_s_barrier();
}

constexpr int CW_ATTQ = 8256;
DI void phase_mix(const Frame& F, int l) {
#ifndef REPMASK
#define REPMASK 0u
#endif
    volatile LAS int* qslot = (volatile LAS int*)(F.lds + MAIL_OFF);
    const bool spread = (F.G == 256);
    for (int task = spread ? ((F.vcu & 1) ? 128 : (F.vcu >> 1)) : F.vcu; task < 128; task += F.G) {
        const int bh = task >> 2, b = bh >> 3, hd = bh & 7;
        for (int rp = 0; rp < 1 + (int)((REPMASK >> 15) & 1u); ++rp) mlstm_task(F, b, hd, task & 3);
    }
    unsigned* qhead = F.ctl + CW_ATTQ + 64 * l;
    for (;;) {
        if (F.tid == 0) qslot[0] = (int)__hip_atomic_fetch_add(qhead, 1u, __ATOMIC_RELAXED, __HIP_MEMORY_SCOPE_AGENT);
        __syncthreads();
        const int item = __builtin_amdgcn_readfirstlane(qslot[0]);
        __syncthreads();
        if (item >= 32 * 17) break;
        const int G = item < 512 ? 16 - (item >> 5) : 0, bh = item & 31;
        attn_item(F, bh >> 3, bh & 7, G);
    }
}

DI void pass_hmnorm(const Frame& F, PK P, int l) {
    unsigned char* ws = F.ws; const bf16* hraw = (const bf16*)(ws + WS_HRAW); const bf16* z = (const bf16*)(ws + WS_Z); bf16* hm = (bf16*)(ws + WS_HM);
    const float* g = P->in[I_MLNG] + (size_t)l * 2048;
    const int gw = F.vcu * NW + F.wave, NGW = F.G * NW, lane = F.lane;
    u32x4 nh[4], nz[4];
    if (gw < RROWS) {
#pragma unroll
        for (int qd = 0; qd < 4; ++qd) { nh[qd] = *(const u32x4*)(hraw + (size_t)gw * 2048 + 32 * lane + 8 * qd); nz[qd] = *(const u32x4*)(z + (size_t)gw * ZW + ZC_MO + 32 * lane + 8 * qd); } }
    for (int r = gw; r < RROWS; r += NGW) {
        f32x4 x[8]; float ss = 0.f; u32x4 cz[4];
#pragma unroll
        for (int qd = 0; qd < 4; ++qd) { unpack8(nh[qd], x[2 * qd], x[2 * qd + 1]); cz[qd] = nz[qd]; }
        if (r + NGW < RROWS) {
#pragma unroll
            for (int qd = 0; qd < 4; ++qd) { nh[qd] = *(const u32x4*)(hraw + (size_t)(r + NGW) * 2048 + 32 * lane + 8 * qd); nz[qd] = *(const u32x4*)(z + (size_t)(r + NGW) * ZW + ZC_MO + 32 * lane + 8 * qd); } }
#pragma unroll
        for (int i = 0; i < 8; ++i) ss += (x[i][0] * x[i][0] + x[i][1] * x[i][1]) + (x[i][2] * x[i][2] + x[i][3] * x[i][3]);
        ss = grp8_sum(ss);
        const float rs = 1.f / sqrtf(ss * (1.f / 256.f) + RMS_EPS);
#pragma unroll
        for (int qd = 0; qd < 4; ++qd) { f32x4 m0, m1; unpack8(cz[qd], m0, m1);
            const f32x4 g0 = *(const f32x4*)(g + 32 * lane + 8 * qd), g1 = *(const f32x4*)(g + 32 * lane + 8 * qd + 4);
            x[2 * qd] = x[2 * qd] * rs * g0 * sig4(m0); x[2 * qd + 1] = x[2 * qd + 1] * rs * g1 * sig4(m1);
            if (r >= NREAL) *(u32x4*)(hm + (size_t)r * 2048 + 32 * lane + 8 * qd) = pack8(x[2 * qd], x[2 * qd + 1]); }
        if (r < NREAL) { unsigned char* h8 = ws + WS_HM8 + (size_t)r * 2048 + 32 * lane;
#pragma unroll
            for (int hf = 0; hf < 2; ++hf) { u32x4 w;
#pragma unroll
                for (int q2 = 0; q2 < 4; ++q2) { const f32x4 v = x[4 * hf + q2]; int ww = 0;
                    ww = __builtin_amdgcn_cvt_pk_fp8_f32(__builtin_amdgcn_fmed3f(v[0] * A8SCALE, -448.f, 448.f), __builtin_amdgcn_fmed3f(v[1] * A8SCALE, -448.f, 448.f), ww, false);
                    ww = __builtin_amdgcn_cvt_pk_fp8_f32(__builtin_amdgcn_fmed3f(v[2] * A8SCALE, -448.f, 448.f), __builtin_amdgcn_fmed3f(v[3] * A8SCALE, -448.f, 448.f), ww, true); w[q2] = (unsigned)ww; }
                *(u32x4*)(h8 + 16 * hf) = w; } }
    }
}

template <int MODE, int K> DI void mini_meta_gemm(const Frame& F, const bf16* A, const bf16* Bt) {
    unsigned char* ws = F.ws;
    if (F.vcu >= 128) return;
    const int lane = F.lane, l15 = lane & 15, lq = lane >> 4, n0 = F.vcu * 16;
    constexpr int KW = K / 8;
    const bf16* ap = A + (size_t)(NREAL + PADL + l15) * K + F.wave * KW + 8 * lq; const bf16* bp = Bt + (size_t)(n0 + l15) * K + F.wave * KW + 8 * lq;
    f32x4 acc = (f32x4){0.f, 0.f, 0.f, 0.f};
#pragma unroll
    for (int kk = 0; kk < KW / 32; ++kk) acc = MFMA16(*(const bf16x8*)(bp + kk * 32), *(const bf16x8*)(ap + kk * 32), acc);
    LAS f32x4* red = (LAS f32x4*)F.lds;
    red[F.wave * 64 + lane] = acc;
    __syncthreads();
    if (F.wave == 0) {
#pragma unroll
        for (int w = 1; w < 8; ++w) acc += red[w * 64 + lane];
        const int col = n0 + 4 * lq; const size_t r0 = (size_t)(NREAL + PADL + l15);
        if (MODE == 2) { const bf16* hb = (const bf16*)(ws + WS_HB); bf16* rr = (bf16*)(ws + WS_H); const u32x2 hw = *(const u32x2*)(hb + r0 * DM + col);
            const f32x4 o = (f32x4){bflo(hw.x), bfhi(hw.x), bflo(hw.y), bfhi(hw.y)} * ALPHA + acc; u32x2 w; w.x = pk2(o[0], o[1]); w.y = pk2(o[2], o[3]);
#pragma unroll
            for (int b = 0; b < NBATCH; ++b) *(u32x2*)(rr + (r0 + 64 * b) * DM + col) = w; }
        else { const bf16* z = (const bf16*)(ws + WS_Z); bf16* tb = (bf16*)(ws + WS_TBUF); bf16* y = (bf16*)(ws + WS_Y);
            const u32x2 gw = *(const u32x2*)(z + r0 * ZW + (MODE == 0 ? ZC_GA : ZC_GB) + col);
            f32x4 o = (f32x4){sigmoidf_(bflo(gw.x)), sigmoidf_(bfhi(gw.x)), sigmoidf_(bflo(gw.y)), sigmoidf_(bfhi(gw.y))} * acc;
            if (MODE == 1) { const u32x2 pw = *(const u32x2*)(tb + r0 * DM + col); o += (f32x4){bflo(pw.x), bfhi(pw.x), bflo(pw.y), bfhi(pw.y)}; }
            u32x2 w; w.x = pk2(o[0], o[1]); w.y = pk2(o[2], o[3]); bf16* dst = MODE == 0 ? tb : y;
#pragma unroll
            for (int b = 0; b < NBATCH; ++b) *(u32x2*)(dst + (r0 + 64 * b) * DM + col) = w; }
    }
    __syncthreads();
}

typedef int v8i __attribute__((ext_vector_type(8)));
constexpr int CW_FP8BAD = 8192;
DI void fp8_selftest(const Frame& F) {
    if (F.vcu != 0 || F.wave != 0) return;
    const int l = F.lane, i = l & 15, kb = l >> 4;
    v8i A, B;
#pragma unroll
    for (int q = 0; q < 8; ++q) { int wa = 0, wb = 0; float av[4], bv[4];
#pragma unroll
        for (int e = 0; e < 4; ++e) { const int k = 32 * kb + 4 * q + e; av[e] = (float)(((i * 7 + k * 3) % 9) - 4); bv[e] = (float)(((k * 5 + i * 11) % 7) - 3); }
        wa = __builtin_amdgcn_cvt_pk_fp8_f32(av[0], av[1], wa, false); wa = __builtin_amdgcn_cvt_pk_fp8_f32(av[2], av[3], wa, true);
        wb = __builtin_amdgcn_cvt_pk_fp8_f32(bv[0], bv[1], wb, false); wb = __builtin_amdgcn_cvt_pk_fp8_f32(bv[2], bv[3], wb, true);
        A[q] = wa; B[q] = wb; }
    f32x4 c = (f32x4){0.f, 0.f, 0.f, 0.f};
    c = __builtin_amdgcn_mfma_scale_f32_16x16x128_f8f6f4(A, B, c, 0, 0, 0, 0x7F7F7F7F, 0, 0x7F7F7F7F);
    bool bad = false;
#pragma unroll
    for (int rg = 0; rg < 4; ++rg) { const int ii = 4 * (l >> 4) + rg, jj = l & 15; int ref = 0;
        for (int k = 0; k < 128; ++k) ref += (((ii * 7 + k * 3) % 9) - 4) * (((k * 5 + jj * 11) % 7) - 3);
        bad |= (c[rg] != (float)ref); }
    f32x4 c2 = (f32x4){0.f, 0.f, 0.f, 0.f};
    c2 = __builtin_amdgcn_mfma_scale_f32_16x16x128_f8f6f4(A, B, c2, 0, 0, 0, 0x7F7F7F7F, 0, 0x79797979);
#pragma unroll
    for (int rg = 0; rg < 4; ++rg) bad |= (c2[rg] * 64.f != c[rg]);
    { const int i3 = l & 31, kb3 = l >> 5; v8i A3, B3;
#pragma unroll
      for (int q = 0; q < 8; ++q) { int wa = 0, wb = 0; float av[4], bv[4];
#pragma unroll
          for (int e = 0; e < 4; ++e) { const int k = 32 * kb3 + 4 * q + e; av[e] = (float)(((i3 * 7 + k * 3) % 9) - 4); bv[e] = (float)(((k * 5 + i3 * 11) % 7) - 3); }
          wa = __builtin_amdgcn_cvt_pk_fp8_f32(av[0], av[1], wa, false); wa = __builtin_amdgcn_cvt_pk_fp8_f32(av[2], av[3], wa, true);
          wb = __builtin_amdgcn_cvt_pk_fp8_f32(bv[0], bv[1], wb, false); wb = __builtin_amdgcn_cvt_pk_fp8_f32(bv[2], bv[3], wb, true);
          A3[q] = wa; B3[q] = wb; }
      f32x16 c3;
#pragma unroll
      for (int i = 0; i < 16; ++i) c3[i] = 0.f;
      c3 = __builtin_amdgcn_mfma_scale_f32_32x32x64_f8f6f4(A3, B3, c3, 0, 0, 0, 0x7F7F7F7F, 0, 0x7F7F7F7F);
#pragma unroll
      for (int rg = 0; rg < 16; ++rg) { const int ii = (rg & 3) + 8 * (rg >> 2) + 4 * (l >> 5), jj = l & 31; int ref = 0;
          for (int k = 0; k < 64; ++k) ref += (((ii * 7 + k * 3) % 9) - 4) * (((k * 5 + jj * 11) % 7) - 3);
          bad |= (c3[rg] != (float)ref); } }
    if (__any(bad) && l == 0) F.ctl[CW_FP8BAD] = 1u;
}

constexpr int RT_LSTR = 68;
DI void phase_ln1_route(const Frame& F, PK P, int l) {
    unsigned char* ws = F.ws; LAS unsigned char* L = F.lds;
    const bf16* rr = (const bf16*)(ws + WS_H); bf16* hb = (bf16*)(ws + WS_HB);
    const float* eb = P->in[I_EBIAS] + (size_t)l * 64;
    int* selE = (int*)(ws + WS_SELE); float* selW = (float*)(ws + WS_SELW); int* locG = (int*)(ws + WS_LOC); int* cntT = (int*)(ws + WS_CNT);
    LAS unsigned long long* colp = (LAS unsigned long long*)L; LAS unsigned long long* col = (LAS unsigned long long*)(L + 4096); LAS int* colhi = (LAS int*)(L + 4608); LAS int* sE = (LAS int*)(L + 5120); LAS float* red = (LAS float*)(L + 8192);
    const float ebv = eb[F.lane];
    const int lane = F.lane;
    { int* tokI = (int*)(ws + WS_TOK); for (int i = F.vcu * NT + F.tid; i < PROWS; i += F.G * NT) tokI[i] = 0; }
    for (int wg = F.vcu; wg < 256; wg += F.G) {
        { u32x4 nx[4];
#pragma unroll
          for (int j = 0; j < 4; ++j) nx[j] = *(const u32x4*)(rr + (size_t)(65 * wg + F.wave) * DM + LNCOL(lane, j));
          for (int i = F.wave; i < 65; i += NW) { const int r = 65 * wg + i; f32x4 v[8];
#pragma unroll
            for (int j = 0; j < 4; ++j) unpack8(nx[j], v[2 * j], v[2 * j + 1]);
            if (i + NW < 65) {
#pragma unroll
                for (int j = 0; j < 4; ++j) nx[j] = *(const u32x4*)(rr + (size_t)(r + NW) * DM + LNCOL(lane, j)); }
            ln_store(v, P->in[I_LN1G] + (size_t)l * DM, P->in[I_LN1B] + (size_t)l * DM, hb + (size_t)r * DM, lane, MOE_FP8 ? ws + WS_HB8 + (size_t)r * DM : nullptr); } }
        __syncthreads();
        { const int l15 = lane & 15, lq = lane >> 4, kq = F.wave >> 1, nh = F.wave & 1;
          const bf16* wp = (const bf16*)(ws + WS_WR) + (size_t)(32 * nh + l15) * DM + kq * 512 + 8 * lq;
          const bf16* tp = hb + (size_t)(65 * wg) * DM + kq * 512 + 8 * lq;
          unsigned to[5];
#pragma unroll
          for (int t = 0; t < 5; ++t) { const int tr = t * 16 + l15; to[t] = (unsigned)((tr < 65 ? tr : 64) * DM); }
          f32x4 acc[5][2];
#pragma unroll
          for (int t = 0; t < 5; ++t) { acc[t][0] = (f32x4){0.f, 0.f, 0.f, 0.f}; acc[t][1] = (f32x4){0.f, 0.f, 0.f, 0.f}; }
#pragma unroll 1
          for (int k0 = 0; k0 < 512; k0 += 128) { bf16x8 wf[4][2], tf[4][5];
#pragma unroll
              for (int s = 0; s < 4; ++s) { wf[s][0] = *(const bf16x8*)(wp + k0 + 32 * s); wf[s][1] = *(const bf16x8*)(wp + 16 * DM + k0 + 32 * s);
#pragma unroll
                  for (int t = 0; t < 5; ++t) tf[s][t] = *(const bf16x8*)(tp + to[t] + k0 + 32 * s); }
#pragma unroll
              for (int s = 0; s < 4; ++s)
#pragma unroll
                  for (int t = 0; t < 5; ++t) { acc[t][0] = MFMA16(wf[s][0], tf[s][t], acc[t][0]); acc[t][1] = MFMA16(wf[s][1], tf[s][t], acc[t][1]); } }
#pragma unroll
          for (int t = 0; t < 5; ++t)
#pragma unroll
              for (int c = 0; c < 2; ++c) *(LAS f32x4*)(red + (kq * 80 + t * 16 + l15) * RT_LSTR + 32 * nh + 16 * c + 4 * lq) = acc[t][c]; }
        __syncthreads();
        unsigned long long mycol = 0ull; int myhi = 0;
        for (int i = F.wave; i < 65; i += NW) { const int r = 65 * wg + i;
            const float lgv = (red[i * RT_LSTR + lane] + red[(80 + i) * RT_LSTR + lane]) + (red[(160 + i) * RT_LSTR + lane] + red[(240 + i) * RT_LSTR + lane]);
            const float s = 1.f / (1.f + expf(-lgv)), bsc = s + ebv;
            const float m1 = grp8_max(bsc);
            const unsigned long long eqb = __ballot(bsc == m1);
            const unsigned gb = (unsigned)(eqb >> (lane & 56)) & 0xFFu;
            const bool first = (lane & 7) == (__ffs((int)gb) - 1);
            const float m2 = grp8_max(first ? -INFINITY : bsc);
            const float gs = m1 + m2;
            int grank = 0; const int g = lane >> 3;
#pragma unroll
            for (int g2 = 0; g2 < 8; ++g2) { const float v = rlane(gs, 8 * g2); grank += (v > gs || (v == gs && g2 < g)) ? 1 : 0; }
            float rem = grank < 4 ? bsc : -INFINITY; int rank = 8;
#pragma unroll
            for (int k = 0; k < 8; ++k) { const float m = wave_max(rem); const unsigned long long bb = __ballot(rem == m); const int win = (int)__builtin_ctzll(bb); if (lane == win) { rank = k; rem = -INFINITY; } }
            const bool chosen = rank < 8;
            const float ssum = wave_sum(chosen ? s : 0.f);
            if (chosen) { selE[(size_t)r * 8 + rank] = lane; selW[(size_t)r * 8 + rank] = s / ssum * 2.5f; sE[i * 8 + rank] = lane; }
            if (i < 64) mycol |= chosen ? (1ull << i) : 0ull; else myhi = chosen ? 1 : 0;
        }
        colp[F.wave * 64 + lane] = mycol; if (F.wave == 0) colhi[lane] = myhi;
        __syncthreads();
        if (F.tid < 64) { unsigned long long c = 0ull;
#pragma unroll
            for (int w = 0; w < NW; ++w) c |= colp[w * 64 + F.tid];
            col[F.tid] = c; cntT[wg * 64 + F.tid] = __popcll(c) + colhi[F.tid]; }
        __syncthreads();
        for (int idx = F.tid; idx < 520; idx += NT) { const int i = idx >> 3, e = sE[idx]; const unsigned long long c = col[e];
            locG[(size_t)(65 * wg + i) * 8 + (idx & 7)] = i < 64 ? __popcll(c & ((1ull << i) - 1ull)) : __popcll(c); }
        __syncthreads();
    }
}
DI void phase_route2(const Frame& F) {
    unsigned char* ws = F.ws; LAS unsigned char* L = F.lds;
    const int* selE = (const int*)(ws + WS_SELE); const int* locG = (const int*)(ws + WS_LOC); const int* cntT = (const int*)(ws + WS_CNT);
    int* posG = (int*)(ws + WS_POS); int* tileE = (int*)(ws + WS_TILEE); int* tokI = (int*)(ws + WS_TOK);
    LAS int* base = (LAS int*)L; const int lane = F.lane;
    for (int wg = F.vcu; wg < 256; wg += F.G) {
        { const int e = F.tid & 63, sl = F.tid >> 6; int tot = 0, pre = 0;
#pragma unroll 8
          for (int w2 = 32 * sl; w2 < 32 * sl + 32; ++w2) { const int c = cntT[w2 * 64 + e]; tot += c; if (w2 < wg) pre += c; }
          base[128 + F.tid] = tot; base[640 + F.tid] = pre; }
        __syncthreads();
        if (F.tid < 64) { const int e = F.tid; int tot = 0, pre = 0;
#pragma unroll
            for (int sl = 0; sl < 8; ++sl) { tot += base[128 + 64 * sl + e]; pre += base[640 + 64 * sl + e]; }
            const int pc = (tot + 255) & ~255; int incl = pc;
#pragma unroll
            for (int o = 1; o < 64; o <<= 1) { const int t = __shfl_up(incl, o); if (lane >= o) incl += t; }
            const int pstart = incl - pc; base[e] = pstart + pre;
            if (e == 63) base[64] = (pstart + pc) >> 8;
            if (wg == 0) { for (int tau = pstart >> 8; tau < ((pstart + pc) >> 8); ++tau) tileE[8 + tau] = e; if (e == 63) tileE[0] = (pstart + pc) >> 8; }
        }
        __syncthreads();
        const int ntr = base[64];
        for (int idx = F.tid; idx < 65 * 8; idx += NT) { const int r = 65 * wg + (idx >> 3); const int dest = base[selE[(size_t)r * 8 + (idx & 7)]] + locG[(size_t)r * 8 + (idx & 7)]; posG[(size_t)r * 8 + (idx & 7)] = dest; tokI[dest] = r; }
        for (int i = F.tid; i < 65; i += NT) { const int r = 65 * wg + i; tokI[ntr * 256 + r] = r; }
        __syncthreads();
    }
}
DI void phase_combine(const Frame& F, PK P, int l) {
    unsigned char* ws = F.ws; bf16* hb = (bf16*)(ws + WS_HB); const unsigned char* ya = (const unsigned char*)(ws + WS_XG);
    const int* posG = (const int*)(ws + WS_POS); const float* selW = (const float*)(ws + WS_SELW); const int* tileE = (const int*)(ws + WS_TILEE);
    const int gw = F.vcu * NW + F.wave, NGW = F.G * NW, lane = F.lane; const int ntr = tileE[0];
    const bool poison = (l == 1) && (__hip_atomic_load(F.ctl + CW_FP8BAD, __ATOMIC_RELAXED, __HIP_MEMORY_SCOPE_AGENT) != 0u);
    int npos = 0; float nw = 0.f; u32x4 nhb[4];
    if (gw < RROWS) { if (lane < 8) { npos = posG[(size_t)gw * 8 + lane]; nw = selW[(size_t)gw * 8 + lane]; }
#pragma unroll
        for (int j = 0; j < 4; ++j) nhb[j] = *(const u32x4*)(hb + (size_t)gw * DM + LNCOL(lane, j)); }
    for (int r = gw; r < RROWS; r += NGW) {
        const int pos = npos; const float w = nw;
        f32x4 v[8];
#pragma unroll
        for (int j = 0; j < 4; ++j) { unpack8(nhb[j], v[2 * j], v[2 * j + 1]); v[2 * j] = v[2 * j] * ALPHA; v[2 * j + 1] = v[2 * j + 1] * ALPHA; }
        if (r + NGW < RROWS) { if (lane < 8) { npos = posG[(size_t)(r + NGW) * 8 + lane]; nw = selW[(size_t)(r + NGW) * 8 + lane]; }
#pragma unroll
            for (int j = 0; j < 4; ++j) nhb[j] = *(const u32x4*)(hb + (size_t)(r + NGW) * DM + LNCOL(lane, j)); }
#pragma unroll
        for (int k = 0; k < 9; ++k) { const int row = k < 8 ? __builtin_amdgcn_readlane(pos, k) : ntr * 256 + r; const float wk = (k < 8 ? rlane(w, k) : 1.f) * (1.f / Y8SCALE);
            const unsigned char* yr = ya + (size_t)row * DM;
#pragma unroll
            for (int j = 0; j < 4; ++j) { const u32x2 yw = *(const u32x2*)(yr + LNCOL(lane, j));
                const f32x2 a0 = __builtin_amdgcn_cvt_pk_f32_fp8((int)yw.x, false), a1 = __builtin_amdgcn_cvt_pk_f32_fp8((int)yw.x, true), a2 = __builtin_amdgcn_cvt_pk_f32_fp8((int)yw.y, false), a3 = __builtin_amdgcn_cvt_pk_f32_fp8((int)yw.y, true);
                v[2 * j] += (f32x4){a0[0], a0[1], a1[0], a1[1]} * wk; v[2 * j + 1] += (f32x4){a2[0], a2[1], a3[0], a3[1]} * wk; } }
        ln_store(v, P->in[I_LN2G] + (size_t)l * DM, P->in[I_LN2B] + (size_t)l * DM, hb + (size_t)r * DM, lane, l == 0 ? ws + WS_HB8 + (size_t)r * DM : nullptr);
        if (l == 1) {
            if (r < NREAL) { float* o = P->out + (size_t)r * DM;
#pragma unroll
                for (int j = 0; j < 4; ++j) { const int c = LNCOL(lane, j); if (poison) { v[2 * j] = (f32x4){NAN, NAN, NAN, NAN}; v[2 * j + 1] = v[2 * j]; } *(f32x4*)(o + c) = v[2 * j]; *(f32x4*)(o + c + 4) = v[2 * j + 1]; } } }
    }
}

constexpr int NPHASE = 25;
#ifndef PHMASK
#define PHMASK 0xFFFFFFFFu
#endif
#define EN(j) ((PHMASK >> (j)) & 1u)
#ifndef REPMASK
#define REPMASK 0u
#endif
#define REP(j) for (int rep_ = 0; rep_ < 1 + (int)((REPMASK >> (j)) & 1u); ++rep_)
#define IN(k) (lo <= (k) && (k) < hi)
#define PHASE_BEGIN PK P = kargs(); unsigned char* ws = P->ws; Frame F = F0; asm volatile("" : "+s"(F.wave), "+s"(F.vcu), "+s"(F.G)); F.lane = lane_id(); asm volatile("" : "+v"(F.lane)); F.tid = F.wave * 64 + F.lane; F.ws = ws; F.ctl = (unsigned*)(ws + WS_CTL); \
        LAS unsigned char* ring = F.lds; const int G = F.G; int cid = (int)blockIdx.x; asm volatile("" : "+s"(cid)); (void)ring; (void)G; (void)cid;
#define SEAM(k) do { if (IN(k) && IN((k) + 1)) { PK Pb = kargs(); XcdBarrier bar; bar.bar = (unsigned*)(Pb->ws + WS_CTL); bar.x = xb_xcc_id(); bar.st = MISC + 8; xcd_barrier(bar, F0.wave == 0 && lane_id() == 0); } } while (0)


template <int L> DI void run_layer(const Frame& F0, volatile LAS unsigned* MISC, const int lo, const int hi) {
    constexpr int l = L;
        constexpr int pb = 1 + 12 * L;
        if (EN(0) && IN(pb + 0)) REP(0) { PHASE_BEGIN;
            { InProjOrderA S; S.init(ws + WS_HB, ws + WS_WIN, G, cid);
              EpiInProj E{(bf16*)(ws + WS_Z), (float*)(ws + WS_ZS), (const float*)(ws + WS_BIAS), F.lds + EPI_OFF};
              pg8::gemm_phase<DM * 2, DM * 2, DM * 2>(ring, F.tid, S, E); }
            { PHASE_BEGIN;
              InProjOrder8 S; S.init(ws + WS_HB8, ws + WS_WIN8, G, cid);
              EpiInProj8 E{(bf16*)(ws + WS_Z), (const float*)(ws + WS_BIAS), F.lds + EPI_OFF};
              pg8::gemm_phase<DM, DM, DM, false, true, 127, 121>(ring, F.tid, S, E); }
        } SEAM(pb + 0);
        if (EN(1) && IN(pb + 1)) REP(1) { PHASE_BEGIN; phase_prep(F, P, l); } SEAM(pb + 1);
        if (EN(2) && IN(pb + 2)) REP(2) {
            { PHASE_BEGIN; pg8::StaticOrder<ZW * 2, 1024, RROWS / 256, 6> S; S.init(ws + WS_Z + (size_t)ZC_CQ * 2, ws + WS_WUQ, G, cid);
              EpiRowScale E{(bf16*)(ws + WS_Q), 1536, (const float*)(ws + WS_RSTD), 2, F.lds + EPI_OFF}; pg8::gemm_phase<ZW * 2, 1024, 1024>(ring, F.tid, S, E); }
            { PHASE_BEGIN; pg8::StaticOrder<ZW * 2, 1024, RROWS / 256, 4> S; S.init(ws + WS_Z + (size_t)ZC_CKV * 2, ws + WS_WKV, G, (cid + G - (RROWS / 256 * 6) % G) % G);
              EpiRowScale E{(bf16*)(ws + WS_KN), 1024, (const float*)(ws + WS_RSTD) + 1, 2, F.lds + EPI_OFF}; pg8::gemm_phase<ZW * 2, 1024, 1024>(ring, F.tid, S, E); }
            { PHASE_BEGIN; pg8::StaticOrder<1024, ZW * 2, 4, RROWS / 256> S; S.init(ws + WS_WKV + (size_t)1024 * 512 * 2, ws + WS_Z + (size_t)ZC_CKV * 2, G, (cid + 2 * G - (RROWS / 256 * 10) % G) % G);
              EpiColScale E{(bf16*)(ws + WS_VT), RROWS, (const float*)(ws + WS_RSTD) + 1, 2, F.lds + EPI_OFF}; pg8::gemm_phase<1024, ZW * 2, 1024>(ring, F.tid, S, E); }
        } SEAM(pb + 2);
        if (EN(3) && IN(pb + 3)) REP(3) { PHASE_BEGIN; phase_mix(F, l); } SEAM(pb + 3);
        if (EN(4) && IN(pb + 4)) REP(4) {
            { PHASE_BEGIN; pass_hmnorm(F, P, l); }
            { PHASE_BEGIN; mini_meta_gemm<0, 1024>(F, (const bf16*)(ws + WS_ATT), (const bf16*)(ws + WS_WBRA)); }
            { PHASE_BEGIN; pg8::StaticOrder<1024, 1024, NREAL / 256, 8> S; S.init(ws + WS_ATT8, ws + WS_WBRA8, G, cid);
              EpiGate8<0, 0> E{(void*)(ws + WS_TBUF), (const bf16*)(ws + WS_Z) + ZC_GA, nullptr, F.lds + EPI_OFF}; pg8::gemm_phase<1024, 1024, 1024, false, true, 123, 121>(ring, F.tid, S, E); }
        } SEAM(pb + 4);
        if (EN(5) && IN(pb + 5)) REP(5) { PHASE_BEGIN;
            mini_meta_gemm<1, DM>(F, (const bf16*)(ws + WS_HM), (const bf16*)(ws + WS_WBRB));
            pg8::StaticOrder<DM, DM, NREAL / 256, 8> S; S.init(ws + WS_HM8, ws + WS_WBRB8, G, cid);
            EpiGate8<1, 1> E{(void*)(ws + WS_Y8), (const bf16*)(ws + WS_Z) + ZC_GB, (const bf16*)(ws + WS_TBUF), F.lds + EPI_OFF}; pg8::gemm_phase<DM, DM, DM, false, true, 124, 121>(ring, F.tid, S, E);
        } SEAM(pb + 5);
        if (EN(6) && IN(pb + 6)) REP(6) { PHASE_BEGIN;
            mini_meta_gemm<2, DM>(F, (const bf16*)(ws + WS_Y), (const bf16*)(ws + WS_WOUT));
            pg8::StaticOrder<DM, DM, NREAL / 256, 8> S; S.init(ws + WS_Y8, ws + WS_WOUT8, G, cid);
            EpiResid8 E{(const bf16*)(ws + WS_HB), (bf16*)(ws + WS_H), F.lds + EPI_OFF}; pg8::gemm_phase<DM, DM, DM, false, true, 124, 121>(ring, F.tid, S, E);
        } SEAM(pb + 6);
        if (EN(7) && IN(pb + 7)) REP(7) { PHASE_BEGIN; phase_ln1_route(F, P, l); } SEAM(pb + 7);
        if (EN(8) && IN(pb + 8)) REP(8) { PHASE_BEGIN; phase_route2(F); } SEAM(pb + 8);
        if (EN(9) && IN(pb + 9)) REP(9) { PHASE_BEGIN;
#if MOE_FP8
            MoeOrder<4, 2048, true> S; S.init(ws + WS_HB8, ws + WS_W13, (const int*)(ws + WS_TILEE), (const int*)(ws + WS_TOK), F.lds, F.tid, G, cid);
            EpiSwiGLU8 E{(unsigned char*)(ws + WS_HBUF)}; pg8::gemm_phase<DM, DM, DM, true, true, 127, 121>(ring, F.tid, S, E);
#else
            MoeOrder<4, 4096, true> S; S.init(ws + WS_HB, ws + WS_W13, (const int*)(ws + WS_TILEE), (const int*)(ws + WS_TOK), F.lds, F.tid, G, cid);
            EpiSwiGLU E{(unsigned char*)(ws + WS_HBUF), F.lds + EPI_OFF}; pg8::gemm_phase<DM * 2, DM * 2, DM * 2, true>(ring, F.tid, S, E);
#endif
        } SEAM(pb + 9);
        if (EN(10) && IN(pb + 10)) REP(10) { PHASE_BEGIN;
#if MOE_FP8
            MoeOrder<8, 512, false> S; S.init(ws + WS_HBUF, ws + WS_W2, (const int*)(ws + WS_TILEE), (const int*)(ws + WS_TOK), F.lds, F.tid, G, cid);
            EpiPlain8 E{(unsigned char*)(ws + WS_XG), F.lds + EPI_OFF}; pg8::gemm_phase<512, 512, 512, false, true, 124, 121>(ring, F.tid, S, E);
#else
            MoeOrder<8, 1024, false> S; S.init(ws + WS_HBUF, ws + WS_W2, (const int*)(ws + WS_TILEE), (const int*)(ws + WS_TOK), F.lds, F.tid, G, cid);
            EpiPlain E{(bf16*)(ws + WS_XG), DM, F.lds + EPI_OFF}; pg8::gemm_phase<1024, 1024, 1024, false, false>(ring, F.tid, S, E);
#endif
        } SEAM(pb + 10);
        if (EN(11) && IN(pb + 11)) REP(11) { { PHASE_BEGIN; phase_combine(F, P, l); } if (l == 0) { PHASE_BEGIN; convert_layer(F, P, 1); } } SEAM(pb + 11);
    }

__global__ void __launch_bounds__(NT, 2) mega_fwd(Params Pv) {
    extern __shared__ __attribute__((aligned(16))) unsigned char lds_raw[];
    Frame F0;
    F0.lds = (LAS unsigned char*)lds_raw;
    F0.tid = 0; F0.lane = 0; F0.wave = __builtin_amdgcn_readfirstlane((int)threadIdx.x >> 6);
    F0.G = gridDim.x; { const int bx = blockIdx.x; F0.vcu = (F0.G % 8 == 0) ? (bx % 8) * (F0.G / 8) + bx / 8 : bx; }
    F0.ws = nullptr; F0.ctl = nullptr;
    volatile LAS unsigned* MISC = (volatile LAS unsigned*)(F0.lds + MISC_OFF);
    if (threadIdx.x < 32) MISC[threadIdx.x] = 0u;
    __syncthreads();
    const int lo = Pv.ph_lo, hi = Pv.ph_hi;
    if (hi - lo > 1) { PK P = kargs(); (void)xcd_barrier_post((unsigned*)(P->ws + WS_CTL), MISC + 8); }
    if (EN(14) && IN(0)) REP(14) { PHASE_BEGIN; phase_prologue(F, P); } SEAM(0);
    run_layer<0>(F0, MISC, lo, hi);
    run_layer<1>(F0, MISC, lo, hi);
}


#ifndef MK_PER_PHASE
#define MK_PER_PHASE 0
#endif
extern "C" void kernel_launch(void* const* d_in, const int* in_sizes, int n_in, void* d_out, int out_size, void* d_ws, size_t ws_size, hipStream_t stream) {
    static int grid = 0;
    if (grid == 0) {
        if (n_in != 28 || ws_size < WS_END) { fprintf(stderr, "kernel_launch: unexpected inputs (n_in %d, ws %zu, need %zu)\n", n_in, ws_size, (size_t)WS_END); grid = -1; return; }
        int dev = 0, cus = 0;
        if (hipGetDevice(&dev) != hipSuccess || hipDeviceGetAttribute(&cus, hipDeviceAttributeMultiprocessorCount, dev) != hipSuccess) { grid = -1; return; }
        if (hipFuncSetAttribute((const void*)mega_fwd, hipFuncAttributeMaxDynamicSharedMemorySize, LDS_BYTES) != hipSuccess) { grid = -1; return; }
        int per_cu = 0;
        (void)hipOccupancyMaxActiveBlocksPerMultiprocessor(&per_cu, (const void*)mega_fwd, NT, LDS_BYTES);
        (void)hipGetLastError();
        grid = cus;
    }
    if (grid < 0) return;
    (void)hipMemsetAsync((char*)d_ws + WS_CTL, 0, 65536, stream);
    Params p{};
    for (int i = 0; i < 28; ++i) p.in[i] = (const float*)d_in[i];
    p.out = (float*)d_out; p.ws = (unsigned char*)d_ws;
#if MK_PER_PHASE
    for (int ph = 0; ph < NPHASE; ++ph) { p.ph_lo = ph; p.ph_hi = ph + 1; hipLaunchKernelGGL(mega_fwd, dim3(grid), dim3(NT), LDS_BYTES, stream, p); }
#else
    p.ph_lo = 0; p.ph_hi = NPHASE; hipLaunchKernelGGL(mega_fwd, dim3(grid), dim3(NT), LDS_BYTES, stream, p);
#endif
}
```

```cpp
#include <hip/hip_runtime.h>
#include <stdint.h>
#include <stdio.h>

#define LAS __attribute__((address_space(3)))
typedef unsigned short bf16;
typedef short bf16x8 __attribute__((ext_vector_type(8)));
typedef float f32x2 __attribute__((ext_vector_type(2)));
typedef float f32x4 __attribute__((ext_vector_type(4)));
typedef float f32x16 __attribute__((ext_vector_type(16)));
typedef unsigned u32x2 __attribute__((ext_vector_type(2)));
typedef unsigned u32x4 __attribute__((ext_vector_type(4)));
typedef __bf16 bf16x2v __attribute__((ext_vector_type(2)));
#define DI __device__ __forceinline__

constexpr int DM = 2048, NBATCH = 4, SEQ = 4096, NMETA = 16, PADL = 48, TP = 4160, RROWS = NBATCH * TP, NREAL = NBATCH * SEQ;
__host__ __device__ __forceinline__ int chunk_row0(int b, int c) { return c == 0 ? NREAL + 64 * b : b * SEQ + 64 * (c - 1); }
constexpr int INW = 11344, ZW = 11520;
constexpr int ZC_CQ = 0, ZC_CKV = 512, ZC_MQ = 1024, ZC_MK = 2048, ZC_MV = 3072, ZC_MO = 5120, ZC_GA = 7168, ZC_GB = 9216, ZC_S = 11264;
constexpr int NEXP = 64, DEXP = 512, TOPK = 8;
#ifndef ZC_F8_START
#define ZC_F8_START ZC_MQ
#endif
constexpr int ZC_F8 = ZC_F8_START, NT_BF = ZC_F8 / 256, NT_F8 = (ZC_S - ZC_F8) / 256;
constexpr int MAXRT = 584, NSHT = RROWS / 256, MAXTILES = MAXRT + NSHT, PROWS = MAXTILES * 256;
constexpr float ALPHA = 1.41421356237f, LN_EPS = 1e-5f, RMS_EPS = 1e-6f;
constexpr float QSCALE = 0.07216878364870322f * 1.4426950408889634f;
constexpr int NW = 8, NT = 512;

constexpr size_t al4k(size_t x) { return (x + 4095) & ~(size_t)4095; }
constexpr size_t WS_CTL = 0, CTL_BYTES = 1u << 20;
constexpr size_t WS_WIN = CTL_BYTES;
constexpr size_t WS_WIN8 = WS_WIN + al4k((size_t)ZW * DM * 2);
constexpr size_t WS_WUQ = WS_WIN8 + al4k((size_t)(ZC_S - ZC_F8) * DM);
constexpr size_t WS_WKV = WS_WUQ + al4k((size_t)1536 * 512 * 2);
constexpr size_t WS_WBRA = WS_WKV + al4k((size_t)2048 * 512 * 2);
constexpr size_t WS_WBRB = WS_WBRA + al4k((size_t)2048 * 1024 * 2);
constexpr size_t WS_WOUT = WS_WBRB + al4k((size_t)2048 * 2048 * 2);
constexpr size_t WS_WR = WS_WOUT + al4k((size_t)2048 * 2048 * 2);
constexpr size_t WS_W13 = WS_WR + al4k((size_t)256 * 2048 * 2);
constexpr size_t WS_W2 = WS_W13 + al4k((size_t)65 * 1024 * 2048 * 2);
constexpr size_t WS_BIAS = WS_W2 + al4k((size_t)65 * 2048 * 512 * 2);
constexpr size_t WS_ROPE = WS_BIAS + al4k((size_t)ZW * 4);
constexpr size_t WS_H = WS_ROPE + al4k((size_t)TP * 64 * 4);
constexpr size_t WS_HB = WS_H + al4k((size_t)RROWS * DM * 4);
constexpr size_t WS_HB8 = WS_HB + al4k((size_t)RROWS * DM * 2);
constexpr size_t WS_SCR = WS_HB8 + al4k((size_t)RROWS * DM);
constexpr size_t WS_Z = WS_SCR;
constexpr size_t WS_ZS = WS_Z + al4k((size_t)RROWS * ZW * 2);
constexpr size_t WS_Q = WS_ZS + al4k((size_t)RROWS * 128 * 4);
constexpr size_t WS_KN = WS_Q + al4k((size_t)RROWS * 1536 * 2);
constexpr size_t WS_VT = WS_KN + al4k((size_t)RROWS * 1024 * 2);
constexpr size_t WS_KRR = WS_VT + al4k((size_t)RROWS * 1024 * 2);
constexpr size_t WS_QKC = WS_KRR + al4k((size_t)RROWS * 64 * 2);
constexpr size_t WS_GATES = WS_QKC + al4k((size_t)RROWS * 2048 * 2);
constexpr size_t WS_RSTD = WS_GATES + al4k((size_t)RROWS * 16 * 4);
constexpr size_t WS_ATT = WS_RSTD + al4k((size_t)RROWS * 2 * 4);
constexpr size_t WS_HRAW = WS_ATT + al4k((size_t)RROWS * 1024 * 2);
constexpr size_t WS_HM = WS_HRAW + al4k((size_t)RROWS * 2048 * 2);
constexpr size_t WS_MIX_END = WS_HM + al4k((size_t)RROWS * 2048 * 2);
constexpr size_t WS_TBUF = WS_Q;
constexpr size_t WS_Y = WS_QKC;
static_assert((size_t)RROWS * 2048 * 2 <= WS_VT - WS_Q, "tbuf overlay");
constexpr size_t WS_XG = WS_SCR;
constexpr size_t WS_HBUF = WS_XG + al4k((size_t)PROWS * 2048 * 2);
constexpr size_t WS_LOGIT = WS_HBUF + al4k((size_t)PROWS * 512 * 2);
constexpr size_t WS_SELE = WS_LOGIT + al4k((size_t)RROWS * 64 * 4);
constexpr size_t WS_SELW = WS_SELE + al4k((size_t)RROWS * 8 * 4);
constexpr size_t WS_LOC = WS_SELW + al4k((size_t)RROWS * 8 * 4);
constexpr size_t WS_POS = WS_LOC + al4k((size_t)RROWS * 8 * 4);
constexpr size_t WS_CNT = WS_POS + al4k((size_t)RROWS * 8 * 4);
constexpr size_t WS_TILEE = WS_CNT + al4k((size_t)256 * 64 * 4);
constexpr size_t WS_TOK = WS_TILEE + al4k((size_t)(MAXTILES + 8) * 4);
constexpr size_t WS_MOE_END = WS_TOK + al4k((size_t)PROWS * 4);
constexpr size_t WS_WBRA8 = WS_W13 + al4k((size_t)65 * 1024 * 2048), WS_WBRB8 = WS_WBRA8 + al4k((size_t)2048 * 1024), WS_WOUT8 = WS_WBRB8 + al4k((size_t)2048 * 2048);
static_assert(WS_WOUT8 + (size_t)2048 * 2048 <= WS_W2, "fp8 weight copies");
constexpr size_t WS_ATT8 = WS_H + al4k((size_t)RROWS * DM * 2), WS_HM8 = WS_ATT8 + al4k((size_t)NREAL * 1024);
static_assert(WS_HM8 + (size_t)NREAL * 2048 <= WS_HB, "fp8 activations");
constexpr size_t WS_Y8 = WS_HRAW;
constexpr size_t WS_END = WS_MIX_END > WS_MOE_END ? WS_MIX_END : WS_MOE_END;
static_assert(WS_END < ((size_t)2000 << 20), "workspace budget");

constexpr int RING_BYTES = 131072, MISC_OFF = 135168, EPI_OFF = MISC_OFF + 512, EPI_SLAB = 16 * 144, MAIL_OFF = EPI_OFF + 8 * EPI_SLAB, TILET_OFF = MAIL_OFF + 8 * 256, LDS_BYTES = 159744;
static_assert(TILET_OFF + (MAXTILES + 8) * 4 <= LDS_BYTES, "LDS map");

DI int lane_id() { int l; asm volatile("v_mbcnt_lo_u32_b32 %0, -1, 0\n\tv_mbcnt_hi_u32_b32 %0, -1, %0" : "=v"(l)); return l; }
DI unsigned pk2(float a, float b) { f32x2 v = {a, b}; bf16x2v r = __builtin_convertvector(v, bf16x2v); return __builtin_bit_cast(unsigned, r); }
DI float bf2f(unsigned short u) { return __uint_as_float(((unsigned)u) << 16); }
DI float bflo(unsigned u) { return __uint_as_float(u << 16); }
DI float bfhi(unsigned u) { return __uint_as_float(u & 0xffff0000u); }
template <int CTRL, int ROWMASK = 0xF, bool BC = true> DI float dpp_mov(float old, float x) { return __builtin_bit_cast(float, __builtin_amdgcn_update_dpp(__builtin_bit_cast(int, old), __builtin_bit_cast(int, x), CTRL, ROWMASK, 0xF, BC)); }
DI float rlane(float x, int k) { return __builtin_bit_cast(float, __builtin_amdgcn_readlane(__builtin_bit_cast(int, x), k)); }
DI float grp8_sum(float v) { v += dpp_mov<0xB1>(0.f, v); v += dpp_mov<0x4E>(0.f, v); v += dpp_mov<0x141>(0.f, v); return v; }
DI float grp8_max(float v) { v = fmaxf(v, dpp_mov<0xB1>(v, v)); v = fmaxf(v, dpp_mov<0x4E>(v, v)); v = fmaxf(v, dpp_mov<0x141>(v, v)); return v; }
DI float wave_sum(float v) { v = grp8_sum(v); v += dpp_mov<0x140>(0.f, v); return (rlane(v, 0) + rlane(v, 16)) + (rlane(v, 32) + rlane(v, 48)); }
DI float wave_max(float v) { v = grp8_max(v); v = fmaxf(v, dpp_mov<0x140>(v, v)); return fmaxf(fmaxf(rlane(v, 0), rlane(v, 16)), fmaxf(rlane(v, 32), rlane(v, 48))); }
DI float wave_scan_sum(float x) {
    x += dpp_mov<0x111, 0xF, false>(0.f, x); x += dpp_mov<0x112, 0xF, false>(0.f, x); x += dpp_mov<0x114, 0xF, false>(0.f, x); x += dpp_mov<0x118, 0xF, false>(0.f, x);
    x += dpp_mov<0x142, 0xA, false>(0.f, x); x += dpp_mov<0x143, 0xC, false>(0.f, x); return x; }
DI float wave_scan_max(float x) { const float ninf = -__builtin_inff();
    x = fmaxf(x, dpp_mov<0x111, 0xF, false>(ninf, x)); x = fmaxf(x, dpp_mov<0x112, 0xF, false>(ninf, x)); x = fmaxf(x, dpp_mov<0x114, 0xF, false>(ninf, x)); x = fmaxf(x, dpp_mov<0x118, 0xF, false>(ninf, x));
    x = fmaxf(x, dpp_mov<0x142, 0xA, false>(ninf, x)); x = fmaxf(x, dpp_mov<0x143, 0xC, false>(ninf, x)); return x; }
DI float sigmoidf_(float x) { return __builtin_amdgcn_rcpf(1.f + __builtin_amdgcn_exp2f(-1.44269504f * x)); }
#define LDS_WAIT() asm volatile("s_waitcnt lgkmcnt(0)" ::: "memory")
#define VM_WAIT() asm volatile("s_waitcnt vmcnt(0)" ::: "memory")

#define XB_TMO      128
#define XB_XCNT(j)  (256  + 64 * (j))
#define XB_XSUB(j)  (1280 + 64 * (j))
#define XB_XGEN(j)  (2304 + 64 * (j))
#define XB_TOP      3328
#define XB_TOPGEN   3392
#define XCD_BAR_WORDS 3456
#define XB_SPIN_CAP (1u << 18)
DI unsigned xb_ld(unsigned* p)              { return __hip_atomic_load(p, __ATOMIC_RELAXED, __HIP_MEMORY_SCOPE_AGENT); }
DI unsigned xb_add(unsigned* p, unsigned v) { return __hip_atomic_fetch_add(p, v, __ATOMIC_RELAXED, __HIP_MEMORY_SCOPE_AGENT); }
DI unsigned xb_xcc_id() { return (unsigned)__builtin_amdgcn_s_getreg((3 << 11) | 20) & 0xFu; }
#define XB_SPIN(cond, bar) do { unsigned _sp = 0; while (cond) { __builtin_amdgcn_s_sleep(1); \
    if ((++_sp & 255u) == 0u) { if (xb_ld(&(bar)[XB_TMO])) break; if (_sp > XB_SPIN_CAP) { atomicAdd(&(bar)[XB_TMO], 1u); break; } } } } while (0)
struct XcdBarrier { unsigned* bar; unsigned x; volatile LAS unsigned* st; };
DI XcdBarrier xcd_barrier_post(unsigned* bar, volatile LAS unsigned* st) {
    XcdBarrier b; b.bar = bar; b.x = xb_xcc_id(); b.st = st;
    if (threadIdx.x == 0) (void)xb_add(&bar[XB_XCNT(b.x)], 1u);
    return b;
}
DI void xcd_barrier_complete(unsigned* bar, unsigned x, unsigned& nloc, unsigned& nx) {
    const unsigned G = gridDim.x * gridDim.y * gridDim.z;
    unsigned sum, cnt, mine, sp = 0u;
    for (;;) {
        sum = 0u; cnt = 0u; mine = 0u;
#pragma unroll
        for (unsigned j = 0; j < 16; ++j) { const unsigned c = xb_ld(&bar[XB_XCNT(j)]); sum += c; cnt += (c > 0u) ? 1u : 0u; mine = (j == x) ? c : mine; }
        if (sum == G) break;
        __builtin_amdgcn_s_sleep(1);
        if ((++sp & 255u) == 0u) { if (xb_ld(&bar[XB_TMO])) break; if (sp > XB_SPIN_CAP) { atomicAdd(&bar[XB_TMO], 1u); break; } }
    }
    nloc = mine > 0u ? mine : 1u; nx = cnt > 0u ? cnt : 1u;
}
DI void xcd_barrier(const XcdBarrier& b, const bool thread0) {
    asm volatile("s_waitcnt vmcnt(0)" ::: "memory");
    __syncthreads();
    if (thread0) {
        unsigned* bar = b.bar;
        __builtin_amdgcn_s_waitcnt(0);
        unsigned nloc = b.st[0], nx = b.st[1];
        if (nloc == 0u) { xcd_barrier_complete(bar, b.x, nloc, nx); b.st[0] = nloc; b.st[1] = nx; }
        const unsigned old = xb_add(&bar[XB_XSUB(b.x)], 1u);
        const unsigned gen = old / nloc;
        if (old + 1u == (gen + 1u) * nloc) {
            __builtin_amdgcn_fence(__ATOMIC_RELEASE, "agent");
            asm volatile("s_waitcnt vmcnt(0)" ::: "memory");
            const unsigned og = xb_add(&bar[XB_TOP], 1u);
            const unsigned tg = og / nx;
            if (og + 1u == (tg + 1u) * nx) xb_add(&bar[XB_TOPGEN], 1u);
            else XB_SPIN(xb_ld(&bar[XB_TOPGEN]) == tg, bar);
            __builtin_amdgcn_fence(__ATOMIC_ACQUIRE, "agent");
            xb_add(&bar[XB_XGEN(b.x)], 1u);
            asm volatile("s_waitcnt vmcnt(0)" ::: "memory");
        } else {
            XB_SPIN(xb_ld(&bar[XB_XGEN(b.x)]) == gen, bar);
            __builtin_amdgcn_fence(__ATOMIC_ACQUIRE, "agent");
            asm volatile("s_waitcnt vmcnt(0)" ::: "memory");
        }
    }
    __syncthreads();
}

namespace pg8 {
constexpr int BM = 256, BK = 64, HALF = 128, HTB = HALF * BK * 2, STAGE_BYTES = 8 * HTB, NXCD = 8, WGM = 8;
__host__ __device__ __forceinline__ int lds_byte(int r, int c) { const int st = (r >> 4) * 2 + (c >> 5), rr = r & 15, cc = c & 31, ob = rr * 64 + cc * 2; return st * 1024 + (ob ^ (((ob >> 9) & 1) << 5)); }
__host__ __device__ __forceinline__ void stage_rc(int b, int& R, int& C) { const int st = b / 1024, sb = b % 1024, swz = sb ^ (((sb >> 9) & 1) << 5); R = (st >> 1) * 16 + swz / 64; C = (st & 1) * 32 + (swz % 64) / 2; }
__host__ __device__ __forceinline__ int perm32(int rho) { const int n = rho >> 4, i = rho & 15; return 8 * (i >> 2) + 4 * n + (i & 3); }
struct Unit { int pm, pn; unsigned ua, ub; };
typedef f32x4 Acc[2][2][4][2];
typedef f32x16 Acc32[2][2][2];

DI int xcd_remap(int L, int n) { const int q = n / NXCD, r = n % NXCD, xcd = L % NXCD, off = L / NXCD; return (xcd < r ? xcd * (q + 1) : r * (q + 1) + (xcd - r) * q) + off; }

template <int ldaB, int ldbB, int nM, int nN> struct StaticOrder {
    static constexpr int nwg = nM * nN; const char* A; const char* B; int G, c;
    DI void init(const void* A_, const void* B_, int G_, int c_) { A = (const char*)A_; B = (const char*)B_; G = G_; c = c_; }
    DI bool next(int i, Unit& u) const {
        const int L = i * G + c; if (L >= nwg) return false;
        const int wgid = xcd_remap(L, nwg);
        const int nig = WGM * nN, gid = wgid / nig, fm = gid * WGM, gsz = (nM - fm) < WGM ? (nM - fm) : WGM;
        u.pm = fm + ((wgid % nig) % gsz); u.pn = (wgid % nig) / gsz;
        u.ua = (unsigned)u.pm * (unsigned)(256 * ldaB); u.ub = (unsigned)u.pn * (unsigned)(256 * ldbB); return true;
    }
};

typedef int v8i32 __attribute__((ext_vector_type(8)));
typedef float f32x8 __attribute__((ext_vector_type(8)));
template <int ldaB, int ldbB, int KB, bool GATHER = false, bool FP8 = false, int SCA = 127, int SCB = 127, class Epi, class Sched>
DI void gemm_phase(LAS unsigned char* lds, const int tid, const Sched& S, const Epi& E) {
    const int wid = __builtin_amdgcn_readfirstlane(tid >> 6), lane = tid & 63, wr = wid >> 2, wc = wid & 3, fr = lane & 15, fq = lane >> 4;
    constexpr int nt = KB / 128;
    unsigned voffA[2], voffB[2]; int stR[2], stC = 0;
#pragma unroll
    for (int i = 0; i < 2; ++i) { int R, C; stage_rc(tid * 16 + i * 8192, R, C); const int rho = R & 31; const int Rb = 64 * (R >> 5) + (FP8 ? 16 * ((rho >> 2) & 1) + 4 * (rho >> 3) + (rho & 3) : perm32(rho));
        const int Cs = (FP8 && (R & 16)) ? (C ^ 8) : C;
        voffA[i] = (unsigned)(R * ldaB + Cs * 2); voffB[i] = (unsigned)(Rb * ldbB + Cs * 2); stR[i] = R; stC = Cs; }
    constexpr size_t kstep = (size_t)(BK * 2);
    constexpr size_t hstA = (size_t)HALF * ldaB, hstB = (size_t)32 * ldbB;
    const unsigned ldsw = (unsigned)wid * 1024u;
    const int l31 = lane & 31, hh = lane >> 5;
    const int aoff0 = FP8 ? lds_byte(wr * 64 + l31, hh * 16) : lds_byte(wr * 64 + fr, fq * 8);
    const int boff0 = FP8 ? lds_byte(wc * 32 + l31, hh * 16) : lds_byte(wc * 32 + fr, fq * 8);
    const int sw16 = (l31 & 16) ? 16 : 0, aoffL = aoff0 + sw16, aoffH = aoff0 + 16 - sw16, boffL = boff0 + sw16, boffH = boff0 + 16 - sw16;
#define PG8_SA(b, h) (((b) * 2 + (h)) * HTB)
#define PG8_SB(b, h) ((4 + (b) * 2 + (h)) * HTB)
#define PG8_STAGE(bufoff, gbase, uoff, voff) do { _Pragma("unroll") for (int _i = 0; _i < 2; ++_i) \
        __builtin_amdgcn_global_load_lds((const unsigned*)((gbase) + (unsigned)((voff)[_i] + (unsigned)(uoff))), (LAS unsigned*)(lds + (bufoff) + ldsw + _i * 8192), 16, 0, 0); } while (0)
#define PG8_STAGE1(bufoff, gbase, uoff, voff0, step) do { _Pragma("unroll") for (int _i = 0; _i < 2; ++_i) \
        __builtin_amdgcn_global_load_lds((const unsigned*)((gbase) + (unsigned)((voff0) + (unsigned)(uoff) + (unsigned)(_i * (step)))), (LAS unsigned*)(lds + (bufoff) + ldsw + _i * 8192), 16, 0, 0); } while (0)
#define PG8_STAGE_A(bufoff, h, nx, kb) do { if constexpr (GATHER) { unsigned _o[2]; _o[0] = (nx) ? on[h][0] : oc[h][0]; _o[1] = (nx) ? on[h][1] : oc[h][1]; PG8_STAGE(bufoff, gA, (kb), _o); } \
        else { PG8_STAGE1(bufoff, gA, ((nx) ? nA : cA) + (unsigned)(kb) + (unsigned)((h) ? hstA : 0), voffA[0], 64 * ldaB); } } while (0)
typedef int v16i32_ __attribute__((ext_vector_type(16)));
#define PG8_LD8(p0, p1) __builtin_bit_cast(v8i32, __builtin_shufflevector(*(const LAS u32x4*)(p0), *(const LAS u32x4*)(p1), 0, 1, 2, 3, 4, 5, 6, 7))
#define PG8_CAT16(a, b) __builtin_shufflevector((a), (b), 0, 1, 2, 3, 4, 5, 6, 7, 8, 9, 10, 11, 12, 13, 14, 15)
#define PG8_LDA(dst, b, h) do { _Pragma("unroll") for (int mm = 0; mm < 2; ++mm) { if constexpr (FP8) dst[mm] = PG8_CAT16(PG8_LD8(lds + PG8_SA(b, h) + aoffL + mm * 4096, lds + PG8_SA(b, h) + aoffH + mm * 4096), PG8_LD8(lds + PG8_SA(b, h) + aoffL + mm * 4096 + 1024, lds + PG8_SA(b, h) + aoffH + mm * 4096 + 1024)); \
        else dst[mm] = PG8_CAT16(PG8_LD8(lds + PG8_SA(b, h) + aoff0 + (2 * mm) * 2048, lds + PG8_SA(b, h) + aoff0 + 1024 + (2 * mm) * 2048), PG8_LD8(lds + PG8_SA(b, h) + aoff0 + (2 * mm + 1) * 2048, lds + PG8_SA(b, h) + aoff0 + 1024 + (2 * mm + 1) * 2048)); } } while (0)
#define PG8_LDB(dst, b, h) do { if constexpr (FP8) dst = PG8_CAT16(PG8_LD8(lds + PG8_SB(b, h) + boffL, lds + PG8_SB(b, h) + boffH), PG8_LD8(lds + PG8_SB(b, h) + boffL + 1024, lds + PG8_SB(b, h) + boffH + 1024)); \
        else dst = PG8_CAT16(PG8_LD8(lds + PG8_SB(b, h) + boff0, lds + PG8_SB(b, h) + boff0 + 1024), PG8_LD8(lds + PG8_SB(b, h) + boff0 + 2048, lds + PG8_SB(b, h) + boff0 + 1024 + 2048)); } while (0)
#define PG8_H8(x, i) ((i) == 0 ? __builtin_shufflevector((x), (x), 0, 1, 2, 3, 4, 5, 6, 7) : __builtin_shufflevector((x), (x), 8, 9, 10, 11, 12, 13, 14, 15))
#define PG8_LO(x) __builtin_bit_cast(bf16x8, __builtin_shufflevector((x), (x), 0, 1, 2, 3))
#define PG8_HI(x) __builtin_bit_cast(bf16x8, __builtin_shufflevector((x), (x), 4, 5, 6, 7))
#define PG8_MMA(ai, bj, At, Bt) do { __builtin_amdgcn_s_setprio(1); \
        if constexpr (FP8) { _Pragma("unroll") for (int mi = 0; mi < 2; ++mi) _Pragma("unroll") for (int ks = 0; ks < 2; ++ks) \
            acc32[ai][bj][mi] = __builtin_amdgcn_mfma_scale_f32_32x32x64_f8f6f4(PG8_H8(Bt, ks), PG8_H8(At[mi], ks), acc32[ai][bj][mi], 0, 0, 0, (int)((unsigned)SCB * 0x01010101u), 0, (int)((unsigned)SCA * 0x01010101u)); } \
        else { _Pragma("unroll") for (int m = 0; m < 4; ++m) _Pragma("unroll") for (int n = 0; n < 2; ++n) { const v8i32 a8_ = PG8_H8(At[m >> 1], m & 1), b8_ = PG8_H8(Bt, n); \
               acc[ai][bj][m][n] = __builtin_amdgcn_mfma_f32_16x16x32_bf16(PG8_LO(b8_), PG8_LO(a8_), acc[ai][bj][m][n], 0, 0, 0); \
               acc[ai][bj][m][n] = __builtin_amdgcn_mfma_f32_16x16x32_bf16(PG8_HI(b8_), PG8_HI(a8_), acc[ai][bj][m][n], 0, 0, 0); } } \
        __builtin_amdgcn_s_setprio(0); } while (0)
#define PG8_WAIT_V(n) asm volatile("s_waitcnt vmcnt(" #n ")" ::: "memory")
#define PG8_WAIT_L(n) asm volatile("s_waitcnt lgkmcnt(" #n ")" ::: "memory")
#define PG8_BAR __builtin_amdgcn_s_barrier()
#define PG8_SCHED __builtin_amdgcn_sched_barrier(0)
    Unit cur, nxt; int ui = 0;
    if (!S.next(0, cur)) return;
    f32x4 acc[2][2][4][2]; f32x16 acc32[2][2][2];
#define PG8_ZERO_ACC() do { if constexpr (FP8) { _Pragma("unroll") for (int a = 0; a < 2; ++a) _Pragma("unroll") for (int b = 0; b < 2; ++b) _Pragma("unroll") for (int m = 0; m < 2; ++m) _Pragma("unroll") for (int i = 0; i < 16; ++i) acc32[a][b][m][i] = 0.f; } \
        else { _Pragma("unroll") for (int a = 0; a < 2; ++a) _Pragma("unroll") for (int b = 0; b < 2; ++b) _Pragma("unroll") for (int m = 0; m < 4; ++m) _Pragma("unroll") for (int n = 0; n < 2; ++n) acc[a][b][m][n] = (f32x4){0.f, 0.f, 0.f, 0.f}; } } while (0)
    PG8_ZERO_ACC();
    v16i32_ At[2], B0, B1;
    const char* gA = S.A; const char* gB = S.B;
    unsigned cA = cur.ua, cB = cur.ub, nA = cA;
    unsigned oc[2][2], on[2][2];
    if constexpr (GATHER) {
#pragma unroll
        for (int h = 0; h < 2; ++h)
#pragma unroll
            for (int i = 0; i < 2; ++i) { oc[h][i] = (unsigned)S.tok(cur, h * HALF + stR[i]) * (unsigned)ldaB + (unsigned)(stC * 2); on[h][i] = oc[h][i]; }
    }
    PG8_STAGE1(PG8_SB(0, 0), gB, cB, voffB[0], 128 * ldbB); PG8_STAGE1(PG8_SB(0, 1), gB, cB + (unsigned)hstB, voffB[0], 128 * ldbB); PG8_STAGE_A(PG8_SA(0, 0), 0, false, 0); PG8_STAGE_A(PG8_SA(0, 1), 1, false, 0);
    if (wr == 1) PG8_BAR;
    PG8_WAIT_V(2); PG8_BAR;
    PG8_STAGE1(PG8_SB(1, 0), gB, cB + (unsigned)kstep, voffB[0], 128 * ldbB); PG8_STAGE_A(PG8_SA(1, 0), 0, false, kstep); PG8_STAGE1(PG8_SB(1, 1), gB, cB + (unsigned)(hstB + kstep), voffB[0], 128 * ldbB);
    PG8_WAIT_V(6); PG8_BAR;
    for (;;) {
        const bool has_next = S.next(ui + 1, nxt);
        nA = has_next ? nxt.ua : cA; const unsigned nB = has_next ? nxt.ub : cB;
        if constexpr (GATHER) { if (!has_next) {
#pragma unroll
            for (int h = 0; h < 2; ++h)
#pragma unroll
                for (int i = 0; i < 2; ++i) on[h][i] = oc[h][i]; } }
        if constexpr (GATHER) { if (has_next) { const int* tp = S.tokp(nxt) + 16 * (wid >> 1) + (lane & 15);
            if (lane < 16) {
#pragma unroll
                for (int h = 0; h < 2; ++h)
#pragma unroll
                    for (int i = 0; i < 2; ++i) __builtin_amdgcn_global_load_lds((const unsigned*)(tp + h * HALF + i * 64), (LAS unsigned*)(lds + MAIL_OFF + wid * 256 + (h * 2 + i) * 64), 4, 0, 0); } } }
#pragma unroll 1
        for (int t = 0; t < nt; t += 2) {
            const bool last = (t == nt - 2);
            if constexpr (GATHER) { if (last && has_next) {
#pragma unroll
                for (int h = 0; h < 2; ++h)
#pragma unroll
                    for (int i = 0; i < 2; ++i) on[h][i] = *(const volatile LAS unsigned*)(lds + MAIL_OFF + wid * 256 + (h * 2 + i) * 64 + (lane >> 2) * 4) * (unsigned)ldaB + (unsigned)(stC * 2); } }
            const unsigned k1 = (unsigned)(t + 1) * (unsigned)kstep, k2 = last ? 0u : (unsigned)(t + 2) * (unsigned)kstep, k3 = k2 + (unsigned)kstep;
            const unsigned b2 = last ? nB : cB + (unsigned)(t + 2) * (unsigned)kstep, b3 = b2 + (unsigned)kstep;
            PG8_LDB(B0, 0, 0); PG8_LDB(B1, 0, 1); PG8_SCHED; PG8_LDA(At, 0, 0); PG8_STAGE_A(PG8_SA(1, 1), 1, false, k1);
            PG8_WAIT_V(8); PG8_WAIT_L(0); PG8_BAR; PG8_MMA(0, 0, At, B0); PG8_MMA(0, 1, At, B1); PG8_BAR; PG8_SCHED;
            PG8_LDA(At, 0, 1); PG8_STAGE1(PG8_SB(0, 0), gB, b2, voffB[0], 128 * ldbB); PG8_STAGE1(PG8_SB(0, 1), gB, b2 + (unsigned)hstB, voffB[0], 128 * ldbB); PG8_STAGE_A(PG8_SA(0, 0), 0, last, k2);
            PG8_WAIT_V(8); PG8_WAIT_L(0); PG8_BAR; PG8_MMA(1, 0, At, B0); PG8_MMA(1, 1, At, B1); PG8_BAR; PG8_SCHED;
            PG8_LDB(B0, 1, 0); PG8_LDB(B1, 1, 1); PG8_SCHED; PG8_LDA(At, 1, 0); PG8_STAGE_A(PG8_SA(0, 1), 1, last, k2);
            PG8_WAIT_V(8); PG8_WAIT_L(0); PG8_BAR; PG8_MMA(0, 0, At, B0); PG8_MMA(0, 1, At, B1); PG8_BAR; PG8_SCHED;
            PG8_LDA(At, 1, 1); PG8_STAGE1(PG8_SB(1, 0), gB, b3, voffB[0], 128 * ldbB); PG8_STAGE1(PG8_SB(1, 1), gB, b3 + (unsigned)hstB, voffB[0], 128 * ldbB); PG8_STAGE_A(PG8_SA(1, 0), 0, last, k3);
            PG8_WAIT_V(8); PG8_WAIT_L(0); PG8_BAR; PG8_MMA(1, 0, At, B0); PG8_MMA(1, 1, At, B1); PG8_BAR; PG8_SCHED;
        }
        if (wr == 0) PG8_BAR;
        { int t2 = lane_id(); asm volatile("" : "+v"(t2)); if constexpr (FP8) E(acc32, cur, wr, wc, t2 & 31, t2 >> 5); else E(acc, cur, wr, wc, t2 & 15, t2 >> 4); }
        if (!has_next) break;
        PG8_ZERO_ACC();
        cur = nxt; cA = nA; cB = nB; ++ui;
        if constexpr (GATHER) {
#pragma unroll
            for (int h = 0; h < 2; ++h)
#pragma unroll
                for (int i = 0; i < 2; ++i) oc[h][i] = on[h][i]; }
        if (wr == 1) PG8_BAR;
    }
    PG8_WAIT_V(0);
    PG8_BAR;
#undef PG8_SA
#undef PG8_SB
#undef PG8_STAGE
#undef PG8_STAGE_A
#undef PG8_LDA
#undef PG8_LDB
#undef PG8_MMA
#undef PG8_LD8
#undef PG8_LO
#undef PG8_HI
#undef PG8_CAT16
#undef PG8_H8
#undef PG8_ZERO_ACC
#undef PG8_WAIT_V
#undef PG8_WAIT_L
#undef PG8_BAR
#undef PG8_SCHED
}
}
using pg8::Unit;
using pg8::Acc;

struct Params { const float* in[28]; float* out; unsigned char* ws; int ph_lo, ph_hi; };
enum { I_X = 0, I_META, I_LNIN_G, I_LNIN_B, I_WIN, I_BIN, I_QNG, I_KVNG, I_WUQ, I_WUKV, I_CONVW, I_CONVB, I_MLNG, I_WBRA, I_WBRB, I_WOUT, I_LN1G, I_LN1B, I_WROUTER, I_EBIAS, I_W1, I_W3, I_W2, I_WS1, I_WS3, I_WS2, I_LN2G, I_LN2B };

typedef const __attribute__((address_space(4))) Params* PK;
DI PK kargs() { PK p = (PK)__builtin_amdgcn_kernarg_segment_ptr(); asm volatile("" : "+s"(p)); return p; }
struct Frame {
    LAS unsigned char* lds; int tid, lane, wave, vcu, G; unsigned char* ws; unsigned* ctl;
};

DI int rowmap_in(int n) {
        if (n < 1024) return n;
        if (n < 1088) return ZC_S + (n - 1024);
        if (n < 7232) return n - 64;
        if (n < 7248) return ZC_S + 64 + (n - 7232);
        return n - 80;
}
DI int rowmap(int mode, int n) {
    switch (mode) {
    case 1: return rowmap_in(n);
    case 99: {
        if (n < 1024) return n;
        if (n < 1088) return ZC_S + (n - 1024);
        if (n < 7232) return n - 64;
        if (n < 7248) return ZC_S + 64 + (n - 7232);
        return n - 80;
    }
    case 5: { const int r = rowmap_in(n); return (r >= ZC_F8 && r < ZC_S) ? r - ZC_F8 : -1; }
    case 2: { const int h = n >> 8, j = n & 255; return j < 128 ? h * 128 + j : 1024 + h * 128 + (j - 128); }
    case 3: return (n >> 7) * 256 + ((n >> 5) & 3) * 64 + (n & 31);
    case 4: return (n >> 7) * 256 + ((n >> 5) & 3) * 64 + 32 + (n & 31);
    default: return n;
    }
}
constexpr int CV_STRIDE = 65, CV_WAVE_BYTES = 64 * CV_STRIDE * 4;
DI void conv_load(f32x4 (&v)[16], const float* W, int K, int N, int item, int lane) {
    const int nblk = (N + 63) / 64, kb = item / nblk, nb = item % nblk, k0 = 64 * kb, n0 = 64 * nb;
    const int nc = n0 + 4 * (lane & 15); const bool okc = nc < N;
#pragma unroll
    for (int i = 0; i < 16; ++i) { const int kk = 4 * i + (lane >> 4); v[i] = okc ? __builtin_nontemporal_load((const f32x4*)(W + (size_t)(k0 + kk) * N + nc)) : (f32x4){0.f, 0.f, 0.f, 0.f}; }
}
template <bool F8> DI void conv_finish(const f32x4 (&v)[16], int K, int N, bf16* WT, int mode, const float* kscale, float sc, LAS float* scr, int item, int lane, unsigned char* WT8 = nullptr) {
    const int nblk = (N + 63) / 64, kb = item / nblk, nb = item % nblk, k0 = 64 * kb, n0 = 64 * nb;
#pragma unroll
    for (int i = 0; i < 16; ++i) { const int kk = 4 * i + (lane >> 4); LAS float* d = scr + kk * CV_STRIDE + 4 * (lane & 15); d[0] = v[i][0]; d[1] = v[i][1]; d[2] = v[i][2]; d[3] = v[i][3]; }
    LDS_WAIT(); asm volatile("" ::: "memory");
    const int c = lane & 7;
    float ks[8];
#pragma unroll
    for (int q = 0; q < 8; ++q) ks[q] = kscale ? kscale[k0 + 8 * c + q] * sc : sc;
#pragma unroll
    for (int j = 0; j < 8; ++j) { const int n = (lane >> 3) + 8 * j; const LAS float* s = scr + (8 * c) * CV_STRIDE + n;
        if (F8) { u32x2 o8; int w0 = 0, w1 = 0;
            w0 = __builtin_amdgcn_cvt_pk_fp8_f32(s[0 * CV_STRIDE] * ks[0], s[1 * CV_STRIDE] * ks[1], w0, false); w0 = __builtin_amdgcn_cvt_pk_fp8_f32(s[2 * CV_STRIDE] * ks[2], s[3 * CV_STRIDE] * ks[3], w0, true);
            w1 = __builtin_amdgcn_cvt_pk_fp8_f32(s[4 * CV_STRIDE] * ks[4], s[5 * CV_STRIDE] * ks[5], w1, false); w1 = __builtin_amdgcn_cvt_pk_fp8_f32(s[6 * CV_STRIDE] * ks[6], s[7 * CV_STRIDE] * ks[7], w1, true);
            o8.x = (unsigned)w0; o8.y = (unsigned)w1;
            const int rw = (n0 + n < N) ? rowmap(mode, n0 + n) : -1;
            if (rw >= 0) *(u32x2*)((unsigned char*)WT + (size_t)rw * K + k0 + 8 * c) = o8; }
        else { u32x4 o; o.x = pk2(s[0 * CV_STRIDE] * ks[0], s[1 * CV_STRIDE] * ks[1]); o.y = pk2(s[2 * CV_STRIDE] * ks[2], s[3 * CV_STRIDE] * ks[3]); o.z = pk2(s[4 * CV_STRIDE] * ks[4], s[5 * CV_STRIDE] * ks[5]); o.w = pk2(s[6 * CV_STRIDE] * ks[6], s[7 * CV_STRIDE] * ks[7]);
            if (n0 + n < N) *(u32x4*)(WT + (size_t)rowmap(mode, n0 + n) * K + k0 + 8 * c) = o;
            if (WT8) { int w0 = 0, w1 = 0;
                w0 = __builtin_amdgcn_cvt_pk_fp8_f32(s[0 * CV_STRIDE] * 64.f, s[1 * CV_STRIDE] * 64.f, w0, false); w0 = __builtin_amdgcn_cvt_pk_fp8_f32(s[2 * CV_STRIDE] * 64.f, s[3 * CV_STRIDE] * 64.f, w0, true);
                w1 = __builtin_amdgcn_cvt_pk_fp8_f32(s[4 * CV_STRIDE] * 64.f, s[5 * CV_STRIDE] * 64.f, w1, false); w1 = __builtin_amdgcn_cvt_pk_fp8_f32(s[6 * CV_STRIDE] * 64.f, s[7 * CV_STRIDE] * 64.f, w1, true);
                if (n0 + n < N) *(u32x2*)(WT8 + (size_t)(n0 + n) * K + k0 + 8 * c) = (u32x2){(unsigned)w0, (unsigned)w1}; } } }
    LDS_WAIT(); asm volatile("" ::: "memory");
}
template <bool F8 = false> DI void conv_matrix(const Frame& F, const float* W, int K, int N, bf16* WT, int mode, const float* kscale, float sc, int nsub, size_t sstride, size_t dstride, int& rot, int nb0 = 0, int nbe = -1, unsigned char* WT8 = nullptr) {
    LAS float* scr = (LAS float*)(F.lds + F.wave * CV_WAVE_BYTES);
    const int NGW = F.G * NW; int gw = F.vcu * NW + F.wave - rot; if (gw < 0) gw += NGW;
    const int nblk = (N + 63) / 64, nb1 = (nbe < 0 ? nblk : nbe) - nb0, per = (K / 64) * nb1, total = per * nsub;
    rot = (rot + total) % NGW;
#define CV_DECODE(it_, sub_, r_) const int sub_ = (it_) / per, r0_##r_ = (it_) - sub_ * per, r_ = (r0_##r_ / nb1) * nblk + nb0 + (r0_##r_ % nb1)
    f32x4 va[16], vb[16];
    int it = gw;
    if (it < total) { CV_DECODE(it, s0, r0); conv_load(va, W + (size_t)s0 * sstride, K, N, r0, F.lane); }
#pragma unroll 1
    for (; it < total; it += 2 * NGW) {
        CV_DECODE(it, sA, rA);
        const int itb = it + NGW, itc = it + 2 * NGW;
        if (itb < total) { CV_DECODE(itb, sB, rB); conv_load(vb, W + (size_t)sB * sstride, K, N, rB, F.lane); }
        conv_finish<F8>(va, K, N, F8 ? (bf16*)((unsigned char*)WT + (size_t)sA * dstride) : WT + (size_t)sA * dstride, mode, kscale, sc, scr, rA, F.lane, WT8);
        if (itc < total) { CV_DECODE(itc, sC, rC); conv_load(va, W + (size_t)sC * sstride, K, N, rC, F.lane); }
        if (itb < total) { CV_DECODE(itb, sB2, rB2); conv_finish<F8>(vb, K, N, F8 ? (bf16*)((unsigned char*)WT + (size_t)sB2 * dstride) : WT + (size_t)sB2 * dstride, mode, kscale, sc, scr, rB2, F.lane, WT8); }
    }
#undef CV_DECODE
}
#ifndef MOE_FP8
#define MOE_FP8 1
#endif
constexpr float W8SCALE = MOE_FP8 ? 64.f : 1.f;
constexpr float H8SCALE = MOE_FP8 ? 8.f : 1.f;
DI void convert_layer(const Frame& F, PK P, int l) {
    unsigned char* ws = F.ws; int rot = 0;
    conv_matrix(F, P->in[I_WIN] + (size_t)l * DM * INW, DM, INW, (bf16*)(ws + WS_WIN), 1, nullptr, 1.f, 1, 0, 0, rot, 0, (ZC_F8 + 64) / 64);
    conv_matrix(F, P->in[I_WIN] + (size_t)l * DM * INW, DM, INW, (bf16*)(ws + WS_WIN), 1, nullptr, 1.f, 1, 0, 0, rot, 113, 114);
    conv_matrix<true>(F, P->in[I_WIN] + (size_t)l * DM * INW, DM, INW, (bf16*)(ws + WS_WIN8), 5, nullptr, 64.f, 1, 0, 0, rot, (ZC_F8 + 64) / 64);
    conv_matrix(F, P->in[I_WUQ] + (size_t)l * 512 * 1536, 512, 1536, (bf16*)(ws + WS_WUQ), 0, P->in[I_QNG] + l * 512, QSCALE, 1, 0, 0, rot);
    conv_matrix(F, P->in[I_WUKV] + (size_t)l * 512 * 2048, 512, 2048, (bf16*)(ws + WS_WKV), 2, P->in[I_KVNG] + l * 512, 1.f, 1, 0, 0, rot);
    conv_matrix(F, P->in[I_WBRA] + (size_t)l * 1024 * 2048, 1024, 2048, (bf16*)(ws + WS_WBRA), 0, nullptr, 1.f, 1, 0, 0, rot, 0, -1, ws + WS_WBRA8);
    conv_matrix(F, P->in[I_WBRB] + (size_t)l * 2048 * 2048, 2048, 2048, (bf16*)(ws + WS_WBRB), 0, nullptr, 1.f, 1, 0, 0, rot, 0, -1, ws + WS_WBRB8);
    conv_matrix(F, P->in[I_WOUT] + (size_t)l * 2048 * 2048, 2048, 2048, (bf16*)(ws + WS_WOUT), 0, nullptr, 1.f, 1, 0, 0, rot, 0, -1, ws + WS_WOUT8);
    conv_matrix(F, P->in[I_WROUTER] + (size_t)l * 2048 * 64, 2048, 64, (bf16*)(ws + WS_WR), 0, nullptr, 1.f, 1, 0, 0, rot);
    conv_matrix<MOE_FP8 != 0>(F, P->in[I_W1] + (size_t)l * 64 * 2048 * 512, 2048, 512, (bf16*)(ws + WS_W13), 3, nullptr, W8SCALE, 64, (size_t)2048 * 512, (size_t)1024 * 2048, rot);
    conv_matrix<MOE_FP8 != 0>(F, P->in[I_W3] + (size_t)l * 64 * 2048 * 512, 2048, 512, (bf16*)(ws + WS_W13), 4, nullptr, W8SCALE, 64, (size_t)2048 * 512, (size_t)1024 * 2048, rot);
    conv_matrix<MOE_FP8 != 0>(F, P->in[I_W2] + (size_t)l * 64 * 512 * 2048, 512, 2048, (bf16*)(ws + WS_W2), 0, nullptr, W8SCALE, 64, (size_t)512 * 2048, (size_t)2048 * 512, rot);
    conv_matrix<MOE_FP8 != 0>(F, P->in[I_WS1] + (size_t)l * 2048 * 512, 2048, 512, (bf16*)((unsigned char*)(ws + WS_W13) + (size_t)64 * 1024 * 2048 * (MOE_FP8 ? 1 : 2)), 3, nullptr, W8SCALE, 1, 0, 0, rot);
    conv_matrix<MOE_FP8 != 0>(F, P->in[I_WS3] + (size_t)l * 2048 * 512, 2048, 512, (bf16*)((unsigned char*)(ws + WS_W13) + (size_t)64 * 1024 * 2048 * (MOE_FP8 ? 1 : 2)), 4, nullptr, W8SCALE, 1, 0, 0, rot);
    conv_matrix<MOE_FP8 != 0>(F, P->in[I_WS2] + (size_t)l * 512 * 2048, 512, 2048, (bf16*)((unsigned char*)(ws + WS_W2) + (size_t)64 * 2048 * 512 * (MOE_FP8 ? 1 : 2)), 0, nullptr, W8SCALE, 1, 0, 0, rot);
    float* br = (float*)(ws + WS_BIAS); const float* bi = P->in[I_BIN] + (size_t)l * INW;
    for (int i = (F.vcu * NT + F.tid); i < ZW; i += F.G * NT) {
        int n;
        if (i < 1024) n = i; else if (i < 7168) n = i + 64; else if (i < ZC_S) n = i + 80; else if (i < ZC_S + 64) n = 1024 + (i - ZC_S); else if (i < ZC_S + 80) n = 7232 + (i - ZC_S - 64); else n = -1;
        br[i] = n >= 0 ? bi[n] : 0.f; }
}

DI u32x4 pack8(const f32x4& a, const f32x4& b) { u32x4 w; w.x = pk2(a[0], a[1]); w.y = pk2(a[2], a[3]); w.z = pk2(b[0], b[1]); w.w = pk2(b[2], b[3]); return w; }
#define LNCOL(lane, j) (8 * ((lane) + 64 * (j)))
DI u32x2 pack8_fp8(const f32x4& a, const f32x4& b) { int w0 = 0, w1 = 0; w0 = __builtin_amdgcn_cvt_pk_fp8_f32(a[0], a[1], w0, false); w0 = __builtin_amdgcn_cvt_pk_fp8_f32(a[2], a[3], w0, true); w1 = __builtin_amdgcn_cvt_pk_fp8_f32(b[0], b[1], w1, false); w1 = __builtin_amdgcn_cvt_pk_fp8_f32(b[2], b[3], w1, true); return (u32x2){(unsigned)w0, (unsigned)w1}; }
DI void ln_store(f32x4 (&v)[8], const float* g, const float* b, bf16* hbrow, int lane, unsigned char* h8row = nullptr) {
    float s = 0.f;
#pragma unroll
    for (int j = 0; j < 8; ++j) s += (v[j].x + v[j].y) + (v[j].z + v[j].w);
    const float mean = wave_sum(s) * (1.f / DM); float s2 = 0.f;
#pragma unroll
    for (int j = 0; j < 8; ++j) { v[j] = v[j] - mean; s2 += (v[j].x * v[j].x + v[j].y * v[j].y) + (v[j].z * v[j].z + v[j].w * v[j].w); }
    const float rstd = 1.f / sqrtf(wave_sum(s2) * (1.f / DM) + LN_EPS);
#pragma unroll
    for (int j = 0; j < 4; ++j) { const int c = LNCOL(lane, j);
        const f32x4 o0 = v[2 * j] * rstd * *(const f32x4*)(g + c) + *(const f32x4*)(b + c), o1 = v[2 * j + 1] * rstd * *(const f32x4*)(g + c + 4) + *(const f32x4*)(b + c + 4);
        v[2 * j] = o0; v[2 * j + 1] = o1;
        *(u32x4*)(hbrow + c) = pack8(o0, o1);
        if (h8row) *(u32x2*)(h8row + c) = pack8_fp8(o0, o1); }
}

DI void fp8_selftest(const Frame& F);
DI void phase_prologue(const Frame& F, PK P) {
    unsigned char* ws = F.ws;
    float* rt = (float*)(ws + WS_ROPE);
    for (int i = F.vcu * NT + F.tid; i < TP * 32; i += F.G * NT) { const int t = i >> 5, f = i & 31;
        const float invf = 1.0f / powf(10000.0f, (float)(2 * f) * (1.0f / 64.0f)); const float ang = (float)t * invf; float sn, cs; sincosf(ang, &sn, &cs);
        rt[t * 64 + f] = cs; rt[t * 64 + 32 + f] = sn; }
    bf16* hb = (bf16*)(ws + WS_HB);
    const int gw = F.vcu * NW + F.wave, NGW = F.G * NW;
    { f32x4 nx[8]; const float* x = P->in[I_X];
      if (gw < NREAL) {
#pragma unroll
          for (int j = 0; j < 4; ++j) { const int c = LNCOL(F.lane, j); nx[2 * j] = *(const f32x4*)(x + (size_t)gw * DM + c); nx[2 * j + 1] = *(const f32x4*)(x + (size_t)gw * DM + c + 4); } }
      for (int r = gw; r < NREAL; r += NGW) { f32x4 v[8];
#pragma unroll
          for (int j = 0; j < 8; ++j) v[j] = nx[j];
          if (r + NGW < NREAL) {
#pragma unroll
              for (int j = 0; j < 4; ++j) { const int c = LNCOL(F.lane, j); nx[2 * j] = *(const f32x4*)(x + (size_t)(r + NGW) * DM + c); nx[2 * j + 1] = *(const f32x4*)(x + (size_t)(r + NGW) * DM + c + 4); } }
          ln_store(v, P->in[I_LNIN_G], P->in[I_LNIN_B], hb + (size_t)r * DM, F.lane, ws + WS_HB8 + (size_t)r * DM); } }
    for (int r = NREAL + gw; r < RROWS; r += NGW) { f32x4 v[8];
        const float* src;
        { const int pp = (r - NREAL) & 63;
            if (pp < PADL) {
#pragma unroll
                for (int j = 0; j < 4; ++j) { const int c = LNCOL(F.lane, j); *(u32x4*)(hb + (size_t)r * DM + c) = (u32x4){0u, 0u, 0u, 0u}; *(u32x2*)(ws + WS_HB8 + (size_t)r * DM + c) = (u32x2){0u, 0u}; }
                continue; }
            src = P->in[I_META] + (size_t)(pp - PADL) * DM; }
#pragma unroll
        for (int j = 0; j < 4; ++j) { const int c = LNCOL(F.lane, j); v[2 * j] = *(const f32x4*)(src + c); v[2 * j + 1] = *(const f32x4*)(src + c + 4); }
        ln_store(v, P->in[I_LNIN_G], P->in[I_LNIN_B], hb + (size_t)r * DM, F.lane, ws + WS_HB8 + (size_t)r * DM); }
    convert_layer(F, P, 0);
    fp8_selftest(F);
}

#define EPI_ROWS(ai, m) (u.pm * 256 + (ai) * 128 + wr * 64 + (m) * 16 + fr)
#define EPI_COL0 (wc * 64 + 8 * fq)
DI void unpack8(const u32x4& w, f32x4& a, f32x4& b) { a = (f32x4){bflo(w.x), bfhi(w.x), bflo(w.y), bfhi(w.y)}; b = (f32x4){bflo(w.z), bfhi(w.z), bflo(w.w), bfhi(w.w)}; }
DI void st_rows64(LAS unsigned char* slab, int lane, int fr, int fq, const u32x4& w0, const u32x4& w1, bf16* g0, size_t ldc) {
    *(LAS u32x4*)(slab + fr * 144 + fq * 16) = w0; *(LAS u32x4*)(slab + fr * 144 + 64 + fq * 16) = w1;
    LDS_WAIT();
    const int rr = lane >> 3, cc = lane & 7;
    const u32x4 a = *(const LAS u32x4*)(slab + rr * 144 + cc * 16), b = *(const LAS u32x4*)(slab + (8 + rr) * 144 + cc * 16);
    LDS_WAIT();
    *(u32x4*)(g0 + (unsigned)(rr * (int)ldc + cc * 8)) = a; *(u32x4*)(g0 + (unsigned)((8 + rr) * (int)ldc + cc * 8)) = b;
}
DI void st_rows32(LAS unsigned char* slab, int lane, int fr, int fq, const u32x4& w0, bf16* g0, size_t ldc) {
    *(LAS u32x4*)(slab + fr * 80 + fq * 16) = w0;
    LDS_WAIT();
    const int rr = lane >> 2, cc = lane & 3;
    const u32x4 a = *(const LAS u32x4*)(slab + rr * 80 + cc * 16);
    LDS_WAIT();
    *(u32x4*)(g0 + (unsigned)(rr * (int)ldc + cc * 8)) = a;
}
#define EPI_SLABP (slab0 + (wr * 4 + wc) * EPI_SLAB)
#define EPI_ROW0(ai, m) (u.pm * 256 + (ai) * 128 + wr * 64 + (m) * 16)
#define EPI_LANE (fr + 16 * fq)
DI f32x4 sig4(const f32x4& x) { return (f32x4){sigmoidf_(x[0]), sigmoidf_(x[1]), sigmoidf_(x[2]), sigmoidf_(x[3])}; }

struct EpiInProj { static constexpr bool PROBE2 = false;
    bf16* z; float* zs; const float* bias; LAS unsigned char* slab0;
    DI void operator()(const Acc& acc, const Unit& u, int wr, int wc, int fr, int fq) const {
        const int colt = u.pn * 256 + EPI_COL0;
        f32x4 bv[2][2];
#pragma unroll
        for (int bj = 0; bj < 2; ++bj)
#pragma unroll
            for (int n = 0; n < 2; ++n) bv[bj][n] = *(const f32x4*)(bias + colt + bj * 32 + 4 * n);
        if (u.pn < 44) {
#pragma unroll
            for (int ai = 0; ai < 2; ++ai)
#pragma unroll
                for (int m = 0; m < 4; ++m) st_rows64(EPI_SLABP, EPI_LANE, fr, fq, pack8(acc[ai][0][m][0] + bv[0][0], acc[ai][0][m][1] + bv[0][1]), pack8(acc[ai][1][m][0] + bv[1][0], acc[ai][1][m][1] + bv[1][1]),
                                                       z + (size_t)EPI_ROW0(ai, m) * ZW + u.pn * 256 + wc * 64, ZW);
        } else {
#pragma unroll
            for (int ai = 0; ai < 2; ++ai)
#pragma unroll
                for (int m = 0; m < 4; ++m) { float* rowp = zs + (size_t)EPI_ROWS(ai, m) * 128 + EPI_COL0;
                    if (wc < 2) {
#pragma unroll
                        for (int bj = 0; bj < 2; ++bj) { *(f32x4*)(rowp + bj * 32) = acc[ai][bj][m][0] + bv[bj][0]; *(f32x4*)(rowp + bj * 32 + 4) = acc[ai][bj][m][1] + bv[bj][1]; } } }
        }
    }
};
struct EpiRowScale { static constexpr bool PROBE2 = false;
    bf16* out; int ldc; const float* rs; int rs_stride; LAS unsigned char* slab0;
    DI void operator()(const Acc& acc, const Unit& u, int wr, int wc, int fr, int fq) const {
        const int colt = u.pn * 256 + EPI_COL0;
#pragma unroll
        for (int ai = 0; ai < 2; ++ai)
#pragma unroll
            for (int m = 0; m < 4; ++m) { const int row = EPI_ROWS(ai, m); const float s = rs[(size_t)row * rs_stride];
                st_rows64(EPI_SLABP, EPI_LANE, fr, fq, pack8(acc[ai][0][m][0] * s, acc[ai][0][m][1] * s), pack8(acc[ai][1][m][0] * s, acc[ai][1][m][1] * s), out + (size_t)EPI_ROW0(ai, m) * ldc + u.pn * 256 + wc * 64, ldc); }
    }
};
struct EpiColScale { static constexpr bool PROBE2 = false;
    bf16* out; int ldc; const float* cs; int cs_stride; LAS unsigned char* slab0;
    DI void operator()(const Acc& acc, const Unit& u, int wr, int wc, int fr, int fq) const {
        const int colt = u.pn * 256 + EPI_COL0;
        f32x4 sv[2][2];
#pragma unroll
        for (int bj = 0; bj < 2; ++bj)
#pragma unroll
            for (int n = 0; n < 2; ++n)
#pragma unroll
                for (int q = 0; q < 4; ++q) sv[bj][n][q] = cs[(size_t)(colt + bj * 32 + 4 * n + q) * cs_stride];
#pragma unroll
        for (int ai = 0; ai < 2; ++ai)
#pragma unroll
            for (int m = 0; m < 4; ++m) st_rows64(EPI_SLABP, EPI_LANE, fr, fq, pack8(acc[ai][0][m][0] * sv[0][0], acc[ai][0][m][1] * sv[0][1]), pack8(acc[ai][1][m][0] * sv[1][0], acc[ai][1][m][1] * sv[1][1]),
                                                   out + (size_t)EPI_ROW0(ai, m) * ldc + u.pn * 256 + wc * 64, ldc);
    }
};
template <int ADD> struct EpiGate { static constexpr bool PROBE2 = false;
    bf16* out; const bf16* gate; const bf16* prev; LAS unsigned char* slab0;
    DI void operator()(const Acc& acc, const Unit& u, int wr, int wc, int fr, int fq) const {
        const int colt = u.pn * 256 + EPI_COL0;
#pragma unroll
        for (int ai = 0; ai < 2; ++ai)
#pragma unroll
            for (int m = 0; m < 4; ++m) { const int row = EPI_ROWS(ai, m); u32x4 ow[2];
#pragma unroll
                for (int bj = 0; bj < 2; ++bj) { const int col = colt + bj * 32;
                    const u32x4 gw = *(const u32x4*)(gate + (size_t)row * ZW + col); f32x4 g0, g1; unpack8(gw, g0, g1);
                    f32x4 o0 = sig4(g0) * acc[ai][bj][m][0], o1 = sig4(g1) * acc[ai][bj][m][1];
                    if (ADD) { const u32x4 pw = *(const u32x4*)(prev + (size_t)row * DM + col); f32x4 p0, p1; unpack8(pw, p0, p1); o0 += p0; o1 += p1; }
                    ow[bj] = pack8(o0, o1); }
                st_rows64(EPI_SLABP, EPI_LANE, fr, fq, ow[0], ow[1], out + (size_t)EPI_ROW0(ai, m) * DM + u.pn * 256 + wc * 64, DM); }
    }
};
struct EpiResid { static constexpr bool PROBE2 = false;
    const bf16* hb; bf16* r; LAS unsigned char* slab0;
    DI void operator()(const Acc& acc, const Unit& u, int wr, int wc, int fr, int fq) const {
        const int colt = u.pn * 256 + EPI_COL0;
#pragma unroll
        for (int ai = 0; ai < 2; ++ai)
#pragma unroll
            for (int m = 0; m < 4; ++m) { const int row = EPI_ROWS(ai, m); u32x4 ow[2];
#pragma unroll
                for (int bj = 0; bj < 2; ++bj) { const u32x4 hw = *(const u32x4*)(hb + (size_t)row * DM + colt + bj * 32); f32x4 h0, h1; unpack8(hw, h0, h1);
                    ow[bj] = pack8(h0 * ALPHA + acc[ai][bj][m][0], h1 * ALPHA + acc[ai][bj][m][1]); }
                st_rows64(EPI_SLABP, EPI_LANE, fr, fq, ow[0], ow[1], r + (size_t)EPI_ROW0(ai, m) * DM + u.pn * 256 + wc * 64, DM); }
    }
};
struct EpiRouter { static constexpr bool PROBE2 = false;
    float* lg;
    DI void operator()(const Acc& acc, const Unit& u, int wr, int wc, int fr, int fq) const {
        if (wc == 0) {
#pragma unroll
            for (int ai = 0; ai < 2; ++ai)
#pragma unroll
                for (int m = 0; m < 4; ++m) { float* rowp = lg + (size_t)EPI_ROWS(ai, m) * 64 + EPI_COL0;
#pragma unroll
                    for (int bj = 0; bj < 2; ++bj) { *(f32x4*)(rowp + bj * 32) = acc[ai][bj][m][0]; *(f32x4*)(rowp + bj * 32 + 4) = acc[ai][bj][m][1]; } }
        }
    }
};
DI void st_rows32b(LAS unsigned char* slab, int lane, int fr, int fq, const u32x2& w0, unsigned char* g0, size_t ldc) {
    *(LAS u32x2*)(slab + fr * 40 + fq * 8) = w0;
    LDS_WAIT();
    const int rr = lane >> 2, cc = lane & 3;
    const u32x2 a = *(const LAS u32x2*)(slab + rr * 40 + cc * 8);
    LDS_WAIT();
    *(u32x2*)(g0 + (unsigned)(rr * (int)ldc + cc * 8)) = a;
}
struct EpiSwiGLU { static constexpr bool PROBE2 = false;
    unsigned char* hbuf; LAS unsigned char* slab0;
    DI void operator()(const Acc& acc, const Unit& u, int wr, int wc, int fr, int fq) const {
#pragma unroll
        for (int ai = 0; ai < 2; ++ai)
#pragma unroll
            for (int m = 0; m < 4; ++m) { f32x4 o[2];
#pragma unroll
                for (int n = 0; n < 2; ++n) { const f32x4 a = acc[ai][0][m][n], b = acc[ai][1][m][n]; o[n] = a * sig4(a) * b; }
#if MOE_FP8
                int w0 = 0, w1 = 0;
                w0 = __builtin_amdgcn_cvt_pk_fp8_f32(o[0][0], o[0][1], w0, false); w0 = __builtin_amdgcn_cvt_pk_fp8_f32(o[0][2], o[0][3], w0, true);
                w1 = __builtin_amdgcn_cvt_pk_fp8_f32(o[1][0], o[1][1], w1, false); w1 = __builtin_amdgcn_cvt_pk_fp8_f32(o[1][2], o[1][3], w1, true);
                st_rows32b(EPI_SLABP, EPI_LANE, fr, fq, (u32x2){(unsigned)w0, (unsigned)w1}, hbuf + (size_t)EPI_ROW0(ai, m) * DEXP + u.pn * 128 + wc * 32, DEXP);
#else
                st_rows32(EPI_SLABP, EPI_LANE, fr, fq, pack8(o[0], o[1]), (bf16*)hbuf + (size_t)EPI_ROW0(ai, m) * DEXP + u.pn * 128 + wc * 32, DEXP);
#endif
            }
    }
};
struct EpiPlain { static constexpr bool PROBE2 = true;
    bf16* out; int ldc; LAS unsigned char* slab0;
    DI void operator()(const Acc& acc, const Unit& u, int wr, int wc, int fr, int fq) const {
#pragma unroll
        for (int ai = 0; ai < 2; ++ai)
#pragma unroll
            for (int m = 0; m < 4; ++m) st_rows64(EPI_SLABP, EPI_LANE, fr, fq, pack8(acc[ai][0][m][0], acc[ai][0][m][1]), pack8(acc[ai][1][m][0], acc[ai][1][m][1]), out + (size_t)EPI_ROW0(ai, m) * ldc + u.pn * 256 + wc * 64, ldc);
    }
};

DI void st_rows64_32(LAS unsigned char* slab, int lane, int l31, int hh, const u32x4 (&w)[2][2], bf16* g0, int ldc) {
#pragma unroll
    for (int hf = 0; hf < 2; ++hf) {
        if ((l31 >> 4) == hf) { LAS unsigned char* d = slab + (l31 & 15) * 144 + hh * 32;
            *(LAS u32x4*)(d) = w[0][0]; *(LAS u32x4*)(d + 16) = w[0][1]; *(LAS u32x4*)(d + 64) = w[1][0]; *(LAS u32x4*)(d + 80) = w[1][1]; }
        LDS_WAIT();
        const int rr = lane >> 3, cc = lane & 7;
        const u32x4 a = *(const LAS u32x4*)(slab + rr * 144 + cc * 16), b = *(const LAS u32x4*)(slab + (8 + rr) * 144 + cc * 16);
        LDS_WAIT();
        *(u32x4*)(g0 + (unsigned)((16 * hf + rr) * ldc + cc * 8)) = a; *(u32x4*)(g0 + (unsigned)((16 * hf + 8 + rr) * ldc + cc * 8)) = b;
    }
}
DI void st_rows64b_32(LAS unsigned char* slab, int lane, int l31, int hh, const u32x4 (&w)[2], unsigned char* g0, int ldc) {
#pragma unroll
    for (int hf = 0; hf < 2; ++hf) {
        if ((l31 >> 4) == hf) { LAS unsigned char* d = slab + (l31 & 15) * 80 + hh * 16; *(LAS u32x4*)(d) = w[0]; *(LAS u32x4*)(d + 32) = w[1]; }
        LDS_WAIT();
        const int rr = lane >> 2, cc = lane & 3;
        const u32x4 a = *(const LAS u32x4*)(slab + rr * 80 + cc * 16);
        LDS_WAIT();
        *(u32x4*)(g0 + (unsigned)((16 * hf + rr) * ldc + cc * 16)) = a;
    }
}
DI u32x4 pack16_fp8(const f32x16& a, float sc) { u32x4 w;
#pragma unroll
    for (int g = 0; g < 4; ++g) { int ww = 0; ww = __builtin_amdgcn_cvt_pk_fp8_f32(__builtin_amdgcn_fmed3f(a[4 * g] * sc, -448.f, 448.f), __builtin_amdgcn_fmed3f(a[4 * g + 1] * sc, -448.f, 448.f), ww, false);
        ww = __builtin_amdgcn_cvt_pk_fp8_f32(__builtin_amdgcn_fmed3f(a[4 * g + 2] * sc, -448.f, 448.f), __builtin_amdgcn_fmed3f(a[4 * g + 3] * sc, -448.f, 448.f), ww, true); w[g] = (unsigned)ww; }
    return w; }
constexpr float Y8SCALE = 128.f;
struct EpiPlain8 {
    unsigned char* out; LAS unsigned char* slab0;
    DI void operator()(const pg8::Acc32& acc, const Unit& u, int wr, int wc, int l31, int hh) const {
#pragma unroll
        for (int ai = 0; ai < 2; ++ai)
#pragma unroll
            for (int mi = 0; mi < 2; ++mi) { u32x4 w[2];
#pragma unroll
                for (int bj = 0; bj < 2; ++bj) w[bj] = pack16_fp8(acc[ai][bj][mi], Y8SCALE);
                st_rows64b_32(EPI_SLABP, l31 + 32 * hh, l31, hh, w, out + (size_t)(u.pm * 256 + ai * 128 + wr * 64 + mi * 32) * DM + u.pn * 256 + wc * 64, DM); }
    }
};
struct EpiSwiGLU8 {
    unsigned char* hbuf;
    DI void operator()(const pg8::Acc32& acc, const Unit& u, int wr, int wc, int l31, int hh) const {
#pragma unroll
        for (int ai = 0; ai < 2; ++ai)
#pragma unroll
            for (int mi = 0; mi < 2; ++mi) { const f32x16& a = acc[ai][0][mi]; const f32x16& b = acc[ai][1][mi]; u32x4 w;
#pragma unroll
                for (int g = 0; g < 4; ++g) { float o[4];
#pragma unroll
                    for (int j = 0; j < 4; ++j) { const float x = a[4 * g + j]; o[j] = __builtin_amdgcn_fmed3f(x * sigmoidf_(x) * (b[4 * g + j] * H8SCALE), -448.f, 448.f); }
                    int ww = 0; ww = __builtin_amdgcn_cvt_pk_fp8_f32(o[0], o[1], ww, false); ww = __builtin_amdgcn_cvt_pk_fp8_f32(o[2], o[3], ww, true); w[g] = (unsigned)ww; }
                *(u32x4*)(hbuf + (size_t)(u.pm * 256 + ai * 128 + wr * 64 + mi * 32) * DEXP + (unsigned)(l31 * DEXP + u.pn * 128 + wc * 32 + hh * 16)) = w; }
    }
};
struct EpiInProj8 {
    bf16* z; const float* bias; LAS unsigned char* slab0;
    DI void operator()(const pg8::Acc32& acc, const Unit& u, int wr, int wc, int l31, int hh) const {
        const int col0 = ZC_F8 + u.pn * 256 + wc * 64;
        f32x4 bv[2][4];
#pragma unroll
        for (int bj = 0; bj < 2; ++bj)
#pragma unroll
            for (int g = 0; g < 4; ++g) bv[bj][g] = *(const f32x4*)(bias + col0 + bj * 32 + hh * 16 + 4 * g);
#pragma unroll
        for (int ai = 0; ai < 2; ++ai)
#pragma unroll
            for (int mi = 0; mi < 2; ++mi) { u32x4 w[2][2];
#pragma unroll
                for (int bj = 0; bj < 2; ++bj) { const f32x16& a = acc[ai][bj][mi];
                    w[bj][0] = pack8((f32x4){a[0], a[1], a[2], a[3]} + bv[bj][0], (f32x4){a[4], a[5], a[6], a[7]} + bv[bj][1]);
                    w[bj][1] = pack8((f32x4){a[8], a[9], a[10], a[11]} + bv[bj][2], (f32x4){a[12], a[13], a[14], a[15]} + bv[bj][3]); }
                st_rows64_32(EPI_SLABP, l31 + 32 * hh, l31, hh, w, z + (size_t)(u.pm * 256 + ai * 128 + wr * 64 + mi * 32) * ZW + col0, ZW); }
    }
};
constexpr float A8SCALE = 8.f, ATT8SCALE = 16.f;
template <int ADD, int OUT8> struct EpiGate8 {
    void* out; const bf16* gate; const bf16* prev; LAS unsigned char* slab0;
    DI void operator()(const pg8::Acc32& acc, const Unit& u, int wr, int wc, int l31, int hh) const {
        const int colw = u.pn * 256 + wc * 64;
#pragma unroll
        for (int ai = 0; ai < 2; ++ai)
#pragma unroll
            for (int mi = 0; mi < 2; ++mi) { const int row0 = u.pm * 256 + ai * 128 + wr * 64 + mi * 32, row = row0 + l31; f32x16 o[2];
#pragma unroll
                for (int bj = 0; bj < 2; ++bj) { const int col = colw + bj * 32 + hh * 16; const f32x16& a = acc[ai][bj][mi];
                    f32x4 g[4]; { const u32x4 w0 = *(const u32x4*)(gate + (size_t)row * ZW + col), w1 = *(const u32x4*)(gate + (size_t)row * ZW + col + 8); unpack8(w0, g[0], g[1]); unpack8(w1, g[2], g[3]); }
                    f32x4 p[4];
                    if (ADD) { const u32x4 w0 = *(const u32x4*)(prev + (size_t)row * DM + col), w1 = *(const u32x4*)(prev + (size_t)row * DM + col + 8); unpack8(w0, p[0], p[1]); unpack8(w1, p[2], p[3]); }
#pragma unroll
                    for (int q = 0; q < 4; ++q) { const f32x4 s = sig4(g[q]);
#pragma unroll
                        for (int j = 0; j < 4; ++j) o[bj][4 * q + j] = ADD ? p[q][j] + s[j] * a[4 * q + j] : s[j] * a[4 * q + j]; } }
                if (OUT8) { u32x4 w[2]; w[0] = pack16_fp8(o[0], A8SCALE); w[1] = pack16_fp8(o[1], A8SCALE);
                    st_rows64b_32(EPI_SLABP, l31 + 32 * hh, l31, hh, w, (unsigned char*)out + (size_t)row0 * DM + colw, DM); }
                else { u32x4 w[2][2];
#pragma unroll
                    for (int bj = 0; bj < 2; ++bj) { const f32x16& v = o[bj];
                        w[bj][0] = pack8((f32x4){v[0], v[1], v[2], v[3]}, (f32x4){v[4], v[5], v[6], v[7]}); w[bj][1] = pack8((f32x4){v[8], v[9], v[10], v[11]}, (f32x4){v[12], v[13], v[14], v[15]}); }
                    st_rows64_32(EPI_SLABP, l31 + 32 * hh, l31, hh, w, (bf16*)out + (size_t)row0 * DM + colw, DM); } }
    }
};
struct EpiResid8 {
    const bf16* hb; bf16* r; LAS unsigned char* slab0;
    DI void operator()(const pg8::Acc32& acc, const Unit& u, int wr, int wc, int l31, int hh) const {
        const int colw = u.pn * 256 + wc * 64;
#pragma unroll
        for (int ai = 0; ai < 2; ++ai)
#pragma unroll
            for (int mi = 0; mi < 2; ++mi) { const int row0 = u.pm * 256 + ai * 128 + wr * 64 + mi * 32, row = row0 + l31; u32x4 w[2][2];
#pragma unroll
                for (int bj = 0; bj < 2; ++bj) { const int col = colw + bj * 32 + hh * 16; const f32x16& a = acc[ai][bj][mi];
                    f32x4 h[4]; { const u32x4 w0 = *(const u32x4*)(hb + (size_t)row * DM + col), w1 = *(const u32x4*)(hb + (size_t)row * DM + col + 8); unpack8(w0, h[0], h[1]); unpack8(w1, h[2], h[3]); }
                    w[bj][0] = pack8(h[0] * ALPHA + (f32x4){a[0], a[1], a[2], a[3]}, h[1] * ALPHA + (f32x4){a[4], a[5], a[6], a[7]});
                    w[bj][1] = pack8(h[2] * ALPHA + (f32x4){a[8], a[9], a[10], a[11]}, h[3] * ALPHA + (f32x4){a[12], a[13], a[14], a[15]}); }
                st_rows64_32(EPI_SLABP, l31 + 32 * hh, l31, hh, w, r + (size_t)row0 * DM + colw, DM); }
    }
};
struct InProjOrderA : pg8::StaticOrder<DM * 2, DM * 2, RROWS / 256, NT_BF + 1> {
    DI bool next(int i, Unit& u) const { if (!pg8::StaticOrder<DM * 2, DM * 2, RROWS / 256, NT_BF + 1>::next(i, u)) return false; if (u.pn == NT_BF) { u.pn = 44; u.ub = 44u * 256u * (unsigned)(DM * 2); } return true; }
};
struct InProjOrder8 { static constexpr int nM = RROWS / 256, nN = NT_F8, nwg = nM * nN, nA = (RROWS / 256) * (NT_BF + 1);
    const char* A; const char* B; int G, c, heavy, R0;
    DI void init(const void* A_, const void* B_, int G_, int c_) { A = (const char*)A_; B = (const char*)B_; G = G_; c = c_; heavy = nA % G_;
        const int light = G_ - heavy; int r0 = (nwg - (8 * light) / 5 + G_ / 2) / G_; if (r0 < 0) r0 = 0; R0 = ((r0 * G_) % 8 == 0) ? r0 : 0; }
    DI bool next(int i, Unit& u) const {
        int L, wgid;
        if (i < R0) { L = i * G + c; wgid = pg8::xcd_remap(L, R0 * G); }
        else { if (c < heavy) return false; L = R0 * G + (i - R0) * (G - heavy) + (c - heavy); if (L >= nwg) return false; wgid = L; }
        const int nig = pg8::WGM * nN, gid = wgid / nig, fm = gid * pg8::WGM, gsz = (nM - fm) < pg8::WGM ? (nM - fm) : pg8::WGM;
        u.pm = fm + ((wgid % nig) % gsz); u.pn = (wgid % nig) / gsz;
        u.ua = (unsigned)u.pm * (unsigned)(256 * DM); u.ub = (unsigned)u.pn * (unsigned)(256 * DM); return true;
    }
};
template <int NJ, int KKB, bool GATHER> struct MoeOrder {
    const char* A; const char* B; const volatile LAS int* tileL; const int* tokI; int ntr, nunits, G, c;
    DI void init(const void* A_, const void* B_, const int* tab, const int* tok_, LAS unsigned char* lds, int tid, int G_, int c_) {
        A = (const char*)A_; B = (const char*)B_; tokI = tok_; G = G_; c = c_;
        LAS int* tl = (LAS int*)(lds + TILET_OFF);
        const int n0 = tab[0];
#pragma clang loop vectorize(disable) unroll(disable)
        for (int i = tid; i < n0 + 8; i += NT) tl[i] = tab[i];
        __syncthreads();
        tileL = (const volatile LAS int*)tl; ntr = __builtin_amdgcn_readfirstlane(n0); nunits = (ntr + NSHT) * NJ; }
    DI bool next(int i, Unit& u) const {
        const int L = i * G + c; if (L >= nunits) return false;
        const int Lr = pg8::xcd_remap(L, nunits), tau = Lr / NJ, j = Lr - tau * NJ;
        const int e = tau < ntr ? __builtin_amdgcn_readfirstlane(tileL[8 + tau]) : 64;
        u.pm = tau; u.pn = j;
        u.ua = GATHER ? 0u : (unsigned)tau * (unsigned)(256 * KKB);
        u.ub = (unsigned)(e * NJ + j) * (unsigned)(256 * KKB); return true;
    }
    DI int tok(const Unit& u, int row) const { return tokI[u.pm * 256 + row]; }
    DI const int* tokp(const Unit& u) const { return tokI + u.pm * 256; }
};

DI void phase_prep(const Frame& F, PK P, int l) {
    unsigned char* ws = F.ws;
    const bf16* z = (const bf16*)(ws + WS_Z); const float* zs = (const float*)(ws + WS_ZS); const float* rope = (const float*)(ws + WS_ROPE);
    bf16* krr = (bf16*)(ws + WS_KRR); bf16* qkc = (bf16*)(ws + WS_QKC); float* gates = (float*)(ws + WS_GATES); float* rstd = (float*)(ws + WS_RSTD);
    const float* cw = P->in[I_CONVW] + (size_t)l * 4 * 2048; const float* cb = P->in[I_CONVB] + (size_t)l * 2048;
    const int gw = F.vcu * NW + F.wave, NGW = F.G * NW, lane = F.lane;
    u32x4 nq = {0u, 0u, 0u, 0u}, nk = nq;
    if (gw < RROWS) { nq = *(const u32x4*)(z + (size_t)gw * ZW + ZC_CQ + 8 * lane); nk = *(const u32x4*)(z + (size_t)gw * ZW + ZC_CKV + 8 * lane); }
    for (int r = gw; r < RROWS; r += NGW) {
        const int b = r < NREAL ? (r >> 12) : ((r - NREAL) >> 6), p = r < NREAL ? 64 + (r & 4095) : ((r - NREAL) & 63), t = p - PADL;
        {
            const u32x4 wq = nq, wk = nk;
            if (r + NGW < RROWS) { nq = *(const u32x4*)(z + (size_t)(r + NGW) * ZW + ZC_CQ + 8 * lane); nk = *(const u32x4*)(z + (size_t)(r + NGW) * ZW + ZC_CKV + 8 * lane); }
            f32x4 a0, a1, b0, b1; unpack8(wq, a0, a1); unpack8(wk, b0, b1);
            float sq = 0.f, sk = 0.f;
#pragma unroll
            for (int j = 0; j < 4; ++j) { sq += a0[j] * a0[j] + a1[j] * a1[j]; sk += b0[j] * b0[j] + b1[j] * b1[j]; }
            sq = wave_sum(sq); sk = wave_sum(sk);
            if (lane == 0) { rstd[(size_t)r * 2] = 1.f / sqrtf(sq * (1.f / 512.f) + RMS_EPS); rstd[(size_t)r * 2 + 1] = 1.f / sqrtf(sk * (1.f / 512.f) + RMS_EPS); }
        }
        if (lane < 32) {
            const int tt = t < 0 ? 0 : t; const float x1 = zs[(size_t)r * 128 + lane], x2 = zs[(size_t)r * 128 + 32 + lane], c = rope[tt * 64 + lane], s = rope[tt * 64 + 32 + lane];
            float o1 = x1 * c - x2 * s, o2 = x1 * s + x2 * c; if (t < 0) { o1 = 0.f; o2 = 0.f; }
            krr[(size_t)r * 64 + lane] = (bf16)(pk2(o1, 0.f) & 0xffffu); krr[(size_t)r * 64 + 32 + lane] = (bf16)(pk2(o2, 0.f) & 0xffffu);
        }
        if (lane < 8) {
            const float mi = zs[(size_t)r * 128 + 64 + lane], mf = zs[(size_t)r * 128 + 72 + lane];
            float lf = fminf(mf, 0.f) - log1pf(expf(-fabsf(mf))), ig = mi;
            if (t < 0) { lf = 0.f; ig = -1e30f; }
            gates[(size_t)r * 16 + lane] = lf; gates[(size_t)r * 16 + 8 + lane] = ig;
        }
    }
    for (int task = gw; task < NBATCH * 65 * 4; task += NGW) {
        const int ci = task >> 2, qd = task & 3, b = ci / 65, c = ci - b * 65, c0 = (qd * 64 + lane) * 8;
        const size_t row0 = (size_t)chunk_row0(b, c);
        f32x4 w[4][2], bia[2];
#pragma unroll
        for (int jj = 0; jj < 4; ++jj) { w[jj][0] = *(const f32x4*)(cw + jj * 2048 + c0); w[jj][1] = *(const f32x4*)(cw + jj * 2048 + c0 + 4); }
        bia[0] = *(const f32x4*)(cb + c0); bia[1] = *(const f32x4*)(cb + c0 + 4);
        f32x4 xm[3][2];
#pragma unroll
        for (int j = 0; j < 3; ++j) { xm[j][0] = (f32x4){0.f, 0.f, 0.f, 0.f}; xm[j][1] = (f32x4){0.f, 0.f, 0.f, 0.f}; }
        if (c >= 1) { const size_t rp = (size_t)chunk_row0(b, c - 1) + 61;
#pragma unroll
            for (int j = 0; j < 3; ++j) { const u32x4 xw = *(const u32x4*)(z + (rp + j) * ZW + ZC_MQ + c0); unpack8(xw, xm[j][0], xm[j][1]); } }
        const float sc = c0 >= 1024 ? 0.08838834764831845f : 1.f;
        u32x4 xn[8];
#pragma unroll
        for (int i = 0; i < 8; ++i) xn[i] = *(const u32x4*)(z + (row0 + i) * ZW + ZC_MQ + c0);
#pragma unroll 1
        for (int i0 = 0; i0 < 64; i0 += 8) {
            u32x4 xr[8];
#pragma unroll
            for (int i = 0; i < 8; ++i) xr[i] = xn[i];
            if (i0 + 8 < 64) {
#pragma unroll
                for (int i = 0; i < 8; ++i) xn[i] = *(const u32x4*)(z + (row0 + i0 + 8 + i) * ZW + ZC_MQ + c0); }
#pragma unroll
            for (int i = 0; i < 8; ++i) { f32x4 x0, x1; unpack8(xr[i], x0, x1);
                if (c == 0 && i0 + i < PADL) { x0 = (f32x4){0.f, 0.f, 0.f, 0.f}; x1 = x0; }
                f32x4 a0 = bia[0] + w[0][0] * xm[0][0] + w[1][0] * xm[1][0] + w[2][0] * xm[2][0] + w[3][0] * x0;
                f32x4 a1 = bia[1] + w[0][1] * xm[0][1] + w[1][1] * xm[1][1] + w[2][1] * xm[2][1] + w[3][1] * x1;
                xm[0][0] = xm[1][0]; xm[0][1] = xm[1][1]; xm[1][0] = xm[2][0]; xm[1][1] = xm[2][1]; xm[2][0] = x0; xm[2][1] = x1;
                a0 = a0 * sig4(a0) * sc; a1 = a1 * sig4(a1) * sc;
                *(u32x4*)(qkc + (row0 + i0 + i) * 2048 + c0) = pack8(a0, a1); }
        }
    }
}

constexpr int ML_VW = 64, ML_NVT = ML_VW / 16, ML_NNT = ML_NVT + 1, ML_VR = 16 * ML_NNT;
constexpr int ML_SQ = 0, ML_SK = 17408, ML_SKT = 34816, ML_SVT = 53248, ML_SP = ML_SVT + ML_VR * 144, ML_CTB = ML_VR * 272, ML_SCT = ML_SP + 64 * 144, ML_SCAL = ML_SCT + 2 * ML_CTB, ML_SCB = 336 * 4;
constexpr int ML_SVTE = ML_SCAL + 2 * ML_SCB;
static_assert(ML_SVTE + ML_VR * 144 <= MISC_OFF, "mLSTM LDS map");
DI bf16x8 ldfrag(LAS unsigned char* L, int base, int stride, int row, int kb) { return *(const LAS bf16x8*)(L + base + row * stride + kb); }
DI bf16 f2b(float x) { return (bf16)(pk2(x, 0.f) & 0xffffu); }
#define MFMA16(a, b, c) __builtin_amdgcn_mfma_f32_16x16x32_bf16((a), (b), (c), 0, 0, 0)
#define MFMA32(a, b, c) __builtin_amdgcn_mfma_f32_32x32x16_bf16((a), (b), (c), 0, 0, 0)

DI float mlstm_scan(LAS float* SC, float lf, float ig, int lane, float mprev) {
    const float bs = wave_scan_sum(lf);
    const float g = rlane(bs, 63);
    const float u = ig - bs;
    const float pm = wave_scan_max(u);
    const float M = fmaxf(pm, mprev);
    const float a = g + u, amax = wave_max(a), mnew = fmaxf(g + mprev, amax);
    SC[lane] = u; SC[64 + lane] = M; SC[128 + lane] = __expf(mprev - M); SC[192 + lane] = __expf(a - mnew); SC[256 + lane] = __expf(-(bs + M));
    if (lane == 0) SC[320] = __expf(g + mprev - mnew);
    return mnew;
}

DI void mlstm_task(const Frame& F, int b, int hd, int vs) {
    unsigned char* wsl = F.ws; asm volatile("" : "+s"(wsl));
    const bf16* z = (const bf16*)(wsl + WS_Z); const bf16* qkc = (const bf16*)(wsl + WS_QKC); const float* gates = (const float*)(wsl + WS_GATES); bf16* hraw = (bf16*)(wsl + WS_HRAW);
    LAS unsigned char* L = F.lds; int tid = F.tid; asm volatile("" : "+v"(tid)); const int lane = tid & 63, wave = F.wave, l15 = lane & 15, lq = lane >> 4;
    for (int i = tid; i < 16 * 72; i += NT) { const int r = ML_VW + i / 72, c = i % 72; *(LAS bf16*)(L + ML_SVT + r * 144 + c * 2) = (r == ML_VW) ? (bf16)0x3F80 : (bf16)0; *(LAS bf16*)(L + ML_SVTE + r * 144 + c * 2) = (bf16)0; }
    for (int i = tid; i < 2 * ML_CTB / 4; i += NT) *(LAS unsigned*)(L + ML_SCT + i * 4) = 0u;
    f32x4 accC[2][ML_NNT];
#pragma unroll
    for (int a = 0; a < 2; ++a)
#pragma unroll
        for (int n = 0; n < ML_NNT; ++n) accC[a][n] = (f32x4){0.f, 0.f, 0.f, 0.f};
    const int s0 = (lane & 15) + 16 * (wave & 1), dc = (lane >> 4) + 4 * (wave >> 1), sv = tid >> 3, c8 = tid & 7;
    const bf16* gq = qkc + (size_t)s0 * 2048 + hd * 128 + 8 * dc;
    const bf16* gv = z + (size_t)sv * ZW + ZC_MV + hd * 256 + ML_VW * vs + 8 * c8;
    u32x4 rq0, rq1, rk0, rk1, rv;
#define GAS __attribute__((address_space(1)))
#define ML_ISSUE(c) do { const size_t ro = (size_t)chunk_row0(b, (c)); rq0 = *(const GAS u32x4*)(gq + ro * 2048); rq1 = *(const GAS u32x4*)(gq + (ro + 32) * 2048); rk0 = *(const GAS u32x4*)(gq + ro * 2048 + 1024); rk1 = *(const GAS u32x4*)(gq + (ro + 32) * 2048 + 1024); \
        rv = *(const GAS u32x4*)(gv + ro * ZW); } while (0)
#define ML_KT(kv, s) do { _Pragma("unroll") for (int e = 0; e < 4; ++e) { *(LAS bf16*)(L + ML_SKT + (8 * dc + 2 * e) * 144 + ((s) ^ ((dc & 3) << 4)) * 2) = (bf16)((kv)[e] & 0xffffu); *(LAS bf16*)(L + ML_SKT + (8 * dc + 2 * e + 1) * 144 + ((s) ^ ((dc & 3) << 4)) * 2) = (bf16)((kv)[e] >> 16); } } while (0)
#define ML_COMMIT_E(SCn) do { const float ea_ = (SCn)[192 + sv]; \
        _Pragma("unroll") for (int e = 0; e < 4; ++e) { *(LAS bf16*)(L + ML_SVTE + (8 * c8 + 2 * e) * 144 + (sv ^ ((c8 & 3) << 4)) * 2) = f2b(bflo(rv[e]) * ea_); *(LAS bf16*)(L + ML_SVTE + (8 * c8 + 2 * e + 1) * 144 + (sv ^ ((c8 & 3) << 4)) * 2) = f2b(bfhi(rv[e]) * ea_); } \
        if (c8 == 0) *(LAS bf16*)(L + ML_SVTE + ML_VW * 144 + sv * 2) = f2b(ea_); } while (0)
#define ML_COMMIT() do { *(LAS u32x4*)(L + ML_SQ + s0 * 272 + dc * 16) = rq0; *(LAS u32x4*)(L + ML_SQ + (s0 + 32) * 272 + dc * 16) = rq1; *(LAS u32x4*)(L + ML_SK + s0 * 272 + dc * 16) = rk0; *(LAS u32x4*)(L + ML_SK + (s0 + 32) * 272 + dc * 16) = rk1; \
        ML_KT(rk0, s0); ML_KT(rk1, s0 + 32); \
        { _Pragma("unroll") for (int e = 0; e < 4; ++e) { *(LAS bf16*)(L + ML_SVT + (8 * c8 + 2 * e) * 144 + (sv ^ ((c8 & 3) << 4)) * 2) = (bf16)(rv[e] & 0xffffu); *(LAS bf16*)(L + ML_SVT + (8 * c8 + 2 * e + 1) * 144 + (sv ^ ((c8 & 3) << 4)) * 2) = (bf16)(rv[e] >> 16); } } } while (0)
    ML_ISSUE(0);
    float mrun = 0.f;
    float lfn = 0.f, ign = 0.f;
#define ML_GATES(c) do { const size_t rg_ = (size_t)chunk_row0(b, (c)) + lane; lfn = *(const GAS float*)(gates + rg_ * 16 + hd); ign = *(const GAS float*)(gates + rg_ * 16 + 8 + hd); } while (0)
    if (wave == 7) { ML_GATES(0); mrun = mlstm_scan((LAS float*)(L + ML_SCAL), lfn, ign, lane, 0.f); ML_GATES(1); }
    __syncthreads();
    ML_COMMIT(); ML_COMMIT_E((LAS float*)(L + ML_SCAL));
    __syncthreads();
    int cur = 0;
#pragma unroll 1
    for (int c = 0; c < 65; ++c) {
        const size_t r0 = (size_t)chunk_row0(b, c);
        LAS float* SC = (LAS float*)(L + ML_SCAL + (c & 1) * ML_SCB);
        if (c + 1 < 65) ML_ISSUE(c + 1);
#pragma unroll
        for (int q = 0; q < 2; ++q) { const int tile = 2 * wave + q, tt = tile >> 2, st = tile & 3; f32x4 acc = (f32x4){0.f, 0.f, 0.f, 0.f};
            if (st <= tt) {
#pragma unroll
                for (int kk = 0; kk < 4; ++kk) acc = MFMA16(ldfrag(L, ML_SQ, 272, tt * 16 + l15, kk * 64 + lq * 16), ldfrag(L, ML_SK, 272, st * 16 + l15, kk * 64 + lq * 16), acc); }
            const int s = st * 16 + l15; const float us = SC[s];
#pragma unroll
            for (int rg = 0; rg < 4; ++rg) { const int t = tt * 16 + 4 * lq + rg; const float v = (s <= t) ? acc[rg] * __expf(us - SC[64 + t]) : 0.f;
                *(LAS bf16*)(L + ML_SP + t * 144 + s * 2) = f2b(v); } }
        if (wave == 7 && c + 1 < 65) { mrun = mlstm_scan((LAS float*)(L + ML_SCAL + ((c + 1) & 1) * ML_SCB), lfn, ign, lane, mrun); if (c + 2 < 65) ML_GATES(c + 2); }
        __syncthreads();
        if (wave < 4) {
            const int tt = wave; f32x4 a1[ML_NNT], a2[ML_NNT];
#pragma unroll
            for (int n = 0; n < ML_NNT; ++n) { a1[n] = (f32x4){0.f, 0.f, 0.f, 0.f}; a2[n] = (f32x4){0.f, 0.f, 0.f, 0.f}; }
#pragma unroll
            for (int kk = 0; kk < 2; ++kk) { const bf16x8 A = ldfrag(L, ML_SP, 144, tt * 16 + l15, kk * 64 + lq * 16);
#pragma unroll
                for (int n = 0; n < ML_NNT; ++n) a1[n] = MFMA16(ldfrag(L, ML_SVT, 144, n * 16 + l15, (kk * 64 + lq * 16) ^ ((((n * 16 + l15) >> 3) & 3) << 5)), A, a1[n]); }
#pragma unroll
            for (int kk = 0; kk < 4; ++kk) { const bf16x8 A = ldfrag(L, ML_SQ, 272, tt * 16 + l15, kk * 64 + lq * 16);
#pragma unroll
                for (int n = 0; n < ML_NNT; ++n) a2[n] = MFMA16(ldfrag(L, ML_SCT + cur * ML_CTB, 272, n * 16 + l15, kk * 64 + lq * 16), A, a2[n]); }
            const int t = tt * 16 + l15; const float ein = SC[128 + t], emr = SC[256 + t];
            const float rd = a1[ML_NVT][0] + ein * a2[ML_NVT][0];
            const float den = __shfl(rd, l15); const float dn = 1.f / fmaxf(fabsf(den), emr);
            bf16* op = hraw + (r0 + t) * 2048 + hd * 256 + ML_VW * vs + 4 * lq;
#pragma unroll
            for (int n = 0; n < ML_NVT; ++n) { const f32x4 o = (a1[n] + a2[n] * ein) * dn; u32x2 w; w.x = pk2(o[0], o[1]); w.y = pk2(o[2], o[3]); *(GAS u32x2*)(op + 16 * n) = w; }
        } else {
            const int w4 = wave - 4; const float decay = SC[320]; const int nxt = cur ^ 1;
            bf16x8 Bf[2][ML_NNT];
#pragma unroll
            for (int kk = 0; kk < 2; ++kk)
#pragma unroll
                for (int n = 0; n < ML_NNT; ++n) { const int sw = (kk * 32 + lq * 8) ^ ((((n * 16 + l15) >> 3) & 3) << 4);
                    Bf[kk][n] = *(const LAS bf16x8*)(L + ML_SVTE + (n * 16 + l15) * 144 + sw * 2); }
#pragma unroll
            for (int di = 0; di < 2; ++di) { const int dt = 2 * w4 + di;
#pragma unroll
                for (int n = 0; n < ML_NNT; ++n) accC[di][n] = accC[di][n] * decay;
#pragma unroll
                for (int kk = 0; kk < 2; ++kk) { const bf16x8 A = ldfrag(L, ML_SKT, 144, dt * 16 + l15, (kk * 64 + lq * 16) ^ ((((dt * 16 + l15) >> 3) & 3) << 5));
#pragma unroll
                    for (int n = 0; n < ML_NNT; ++n) accC[di][n] = MFMA16(A, Bf[kk][n], accC[di][n]); }
#pragma unroll
                for (int n = 0; n < ML_NNT; ++n) { u32x2 w; w.x = pk2(accC[di][n][0], accC[di][n][1]); w.y = pk2(accC[di][n][2], accC[di][n][3]);
                    *(LAS u32x2*)(L + ML_SCT + nxt * ML_CTB + (n * 16 + l15) * 272 + (dt * 16 + 4 * lq) * 2) = w; } }
        }
        __syncthreads();
        if (c + 1 < 65) { ML_COMMIT(); ML_COMMIT_E((LAS float*)(L + ML_SCAL + ((c + 1) & 1) * ML_SCB)); }
        __syncthreads();
        cur ^= 1;
    }
#undef ML_ISSUE
#undef ML_GATES
#undef ML_KT
#undef ML_COMMIT
#undef ML_COMMIT_E
}

constexpr int AT_KB = 64 * 384, AT_BUF = AT_KB + 128 * 128, AT_NBUF = 3;
#ifndef AT_STAGGER
#define AT_STAGGER 6
#endif
#ifndef AT_OLD
#define AT_OLD 1
#endif
DI void attn_item(const Frame& F, int b, int hd, int G) {
    unsigned char* wsl = F.ws; asm volatile("" : "+s"(wsl));
    const bf16* q = (const bf16*)(wsl + WS_Q); const bf16* kn = (const bf16*)(wsl + WS_KN); const bf16* krr = (const bf16*)(wsl + WS_KRR); const bf16* vt = (const bf16*)(wsl + WS_VT);
    const float* rope = (const float*)(wsl + WS_ROPE); bf16* att = (bf16*)(wsl + WS_ATT);
    LAS unsigned char* L = F.lds; int tid = F.tid; asm volatile("" : "+v"(tid)); const int lane = tid & 63, wave = F.wave, l31 = lane & 31, hh = lane >> 5;
    const int qbase = (G == 0) ? 0 : 64 + 256 * (G - 1), nq = (G == 0) ? 2 : 8, nk = (G == 0) ? 1 : 1 + 4 * G;
    const size_t qrow0 = (G == 0) ? (size_t)(NREAL + 64 * b) : (size_t)(b * SEQ + 256 * (G - 1));
    const bool act = wave < nq;
    const int qp = qbase + 32 * wave + l31, qmax = qbase + 32 * wave + 31;
    const size_t qr = qrow0 + 32 * wave + l31;
    const char* gbase = (const char*)kn;
    unsigned srcK[3], srcV[2]; bool isr[3];
#pragma unroll
    for (int i = 0; i < 3; ++i) { const int ci = 64 * (wave * 3 + i) + lane, key = ci / 24, cp = ci - key * 24, c = (cp & ~7) | ((cp & 7) ^ ((key >> 1) & 7));
        isr[i] = c >= 16;
        srcK[i] = isr[i] ? (unsigned)((const char*)(krr + (size_t)key * 64 + 8 * (c - 16)) - gbase) : (unsigned)((const char*)(kn + (size_t)key * 1024 + hd * 128 + 8 * c) - gbase); }
#pragma unroll
    for (int i = 0; i < 2; ++i) { const int ci = 64 * (wave * 2 + i) + lane, dv = ci >> 3, cp = ci & 7, c = cp ^ ((dv >> 1) & 7);
        srcV[i] = (unsigned)((const char*)(vt + (size_t)(hd * 128 + dv) * RROWS + 8 * c) - gbase); }
#define AT_ISSUE(kt) do { const unsigned ko = (unsigned)chunk_row0(b, (kt)); const int bo_ = ((kt) % AT_NBUF) * AT_BUF; \
        _Pragma("unroll") for (int i_ = 0; i_ < 3; ++i_) __builtin_amdgcn_global_load_lds((const unsigned*)(gbase + (unsigned)(srcK[i_] + ko * (isr[i_] ? 128u : 2048u))), (LAS unsigned*)(L + bo_ + (wave * 3 + i_) * 1024), 16, 0, 0); \
        _Pragma("unroll") for (int i_ = 0; i_ < 2; ++i_) __builtin_amdgcn_global_load_lds((const unsigned*)(gbase + (unsigned)(srcV[i_] + ko * 2u)), (LAS unsigned*)(L + bo_ + AT_KB + (wave * 2 + i_) * 1024), 16, 0, 0); } while (0)
    AT_ISSUE(0);
    if (nk > 1) AT_ISSUE(1);
    bf16x8 Qf[12];
    if (act) { const bf16* qrow = q + qr * 1536 + hd * 192 + 8 * hh;
#pragma unroll
      for (int s = 0; s < 12; ++s) Qf[s] = *(const GAS bf16x8*)(qrow + 16 * s);
      int t = qp - PADL; if (t < 0) t = 0;
#pragma unroll
      for (int s2 = 0; s2 < 2; ++s2) { const int i0 = 16 * s2 + 8 * hh;
          const f32x4 c0 = *(const GAS f32x4*)(rope + t * 64 + i0), c1 = *(const GAS f32x4*)(rope + t * 64 + i0 + 4), s0 = *(const GAS f32x4*)(rope + t * 64 + 32 + i0), s1 = *(const GAS f32x4*)(rope + t * 64 + 32 + i0 + 4);
          const u32x4 w1 = __builtin_bit_cast(u32x4, Qf[8 + s2]), w2 = __builtin_bit_cast(u32x4, Qf[10 + s2]);
          f32x4 x10, x11, x20, x21; unpack8(w1, x10, x11); unpack8(w2, x20, x21);
          const f32x4 o10 = x10 * c0 - x20 * s0, o11 = x11 * c1 - x21 * s1, o20 = x10 * s0 + x20 * c0, o21 = x11 * s1 + x21 * c1;
          Qf[8 + s2] = __builtin_bit_cast(bf16x8, pack8(o10, o11)); Qf[10 + s2] = __builtin_bit_cast(bf16x8, pack8(o20, o21)); } }
    else {
#pragma unroll
      for (int s = 0; s < 12; ++s) Qf[s] = (bf16x8){0, 0, 0, 0, 0, 0, 0, 0}; }
    f32x16 O[4];
    { float z0 = 0.f; asm volatile("" : "+v"(z0));
#pragma unroll
      for (int d = 0; d < 4; ++d)
#pragma unroll
        for (int i = 0; i < 16; ++i) O[d][i] = z0; }
    float m = -INFINITY, lsum = 0.f;
    const int pi = (l31 & 0x13) | ((l31 & 4) << 1) | ((l31 & 8) >> 1);
    int koff[4];
#pragma unroll
    for (int j = 0; j < 4; ++j) koff[j] = pi * 384 + (((2 * j + hh) ^ ((pi >> 1) & 7)) << 4);
    const int vbase = AT_KB + l31 * 128, vx = (l31 >> 1) & 7;
    asm volatile("s_waitcnt vmcnt(0)" ::: "memory");
#pragma unroll 1
    for (int kt = 0; kt < nk; ++kt) {
        const int bo = (kt % AT_NBUF) * AT_BUF;
        if (kt > 0) { if (kt + 1 < nk) asm volatile("s_waitcnt vmcnt(5)" ::: "memory"); else asm volatile("s_waitcnt vmcnt(0)" ::: "memory"); }
        __builtin_amdgcn_s_barrier();
        asm volatile("" ::: "memory");
        const bool busy = act && 64 * kt <= qmax;
        if (!busy && kt + 2 < nk) AT_ISSUE(kt + 2);
        if (busy) {
            f32x16 S0, S1; bf16x8 Pf0[2], Pf1[2];
            const f32x16 zc = {0.f, 0.f, 0.f, 0.f, 0.f, 0.f, 0.f, 0.f, 0.f, 0.f, 0.f, 0.f, 0.f, 0.f, 0.f, 0.f};
            bf16x8 Kg[12];
            {   bf16x8 Kf[12];
#pragma unroll
                for (int s = 0; s < 12; ++s) Kf[s] = *(const LAS bf16x8*)(L + bo + (s >> 2) * 128 + koff[s & 3]);
                S0 = MFMA32(Kf[0], Qf[0], zc);
#pragma unroll
                for (int s = 1; s < 12; ++s) S0 = MFMA32(Kf[s], Qf[s], S0);
#pragma unroll
                for (int s = 0; s < 4; ++s) Kg[s] = *(const LAS bf16x8*)(L + bo + 32 * 384 + (s >> 2) * 128 + koff[s & 3]);
                __builtin_amdgcn_sched_group_barrier(0x100, 6, 0);
#pragma unroll
                for (int i = 0; i < 10; ++i) { __builtin_amdgcn_sched_group_barrier(0x008, 1, 0); __builtin_amdgcn_sched_group_barrier(0x100, 1, 0); }
                __builtin_amdgcn_sched_group_barrier(0x008, 2, 0);
            }
            __builtin_amdgcn_sched_barrier(0);
            const bool diag = 64 * kt + 63 > qbase + 32 * wave || kt == 0;
            if (diag) {
#pragma unroll
                for (int i = 0; i < 16; ++i) { const int kp = 64 * kt + (i & 3) + 4 * ((i >> 2) & 1) + 8 * hh + 16 * (i >> 3); if (kp > qp || kp < PADL) S0[i] = -INFINITY; } }
            const float mu = (m == -INFINITY) ? 0.f : m;
            bf16x8 Vf[2][4], Vg[2][4];
            float mx, rs;
            {
#pragma unroll
                for (int s = 4; s < 12; ++s) Kg[s] = *(const LAS bf16x8*)(L + bo + 32 * 384 + (s >> 2) * 128 + koff[s & 3]);
                S1 = MFMA32(Kg[0], Qf[0], zc);
#pragma unroll
                for (int s = 1; s < 12; ++s) S1 = MFMA32(Kg[s], Qf[s], S1);
#pragma unroll
                for (int s2 = 0; s2 < 2; ++s2)
#pragma unroll
                    for (int d = 0; d < 4; ++d) Vf[s2][d] = *(const LAS bf16x8*)(L + bo + d * 32 * 128 + vbase + (((2 * s2 + hh) ^ vx) << 4));
                { const float m0 = fmaxf(fmaxf(S0[0], S0[1]), fmaxf(S0[2], S0[3])), m1 = fmaxf(fmaxf(S0[4], S0[5]), fmaxf(S0[6], S0[7])), m2 = fmaxf(fmaxf(S0[8], S0[9]), fmaxf(S0[10], S0[11])), m3 = fmaxf(fmaxf(S0[12], S0[13]), fmaxf(S0[14], S0[15]));
                  mx = fmaxf(fmaxf(m0, m1), fmaxf(m2, m3)); }
#pragma unroll
                for (int i = 0; i < 16; ++i) S0[i] = __builtin_amdgcn_exp2f(S0[i] - mu);
                rs = (((S0[0] + S0[1]) + (S0[2] + S0[3])) + ((S0[4] + S0[5]) + (S0[6] + S0[7]))) + (((S0[8] + S0[9]) + (S0[10] + S0[11])) + ((S0[12] + S0[13]) + (S0[14] + S0[15])));
#pragma unroll
                for (int s2 = 0; s2 < 2; ++s2) { u32x4 w; w.x = pk2(S0[8 * s2], S0[8 * s2 + 1]); w.y = pk2(S0[8 * s2 + 2], S0[8 * s2 + 3]); w.z = pk2(S0[8 * s2 + 4], S0[8 * s2 + 5]); w.w = pk2(S0[8 * s2 + 6], S0[8 * s2 + 7]); Pf0[s2] = __builtin_bit_cast(bf16x8, w); }
                __builtin_amdgcn_sched_group_barrier(0x100, 4, 0);
#pragma unroll
                for (int i = 0; i < 4; ++i) { __builtin_amdgcn_sched_group_barrier(0x008, 1, 0); __builtin_amdgcn_sched_group_barrier(0x100, 1, 0); __builtin_amdgcn_sched_group_barrier(0x002, 5, 0); }
#pragma unroll
                for (int i = 0; i < 8; ++i) { __builtin_amdgcn_sched_group_barrier(0x008, 1, 0); __builtin_amdgcn_sched_group_barrier(0x100, 1, 0); __builtin_amdgcn_sched_group_barrier(0x002, 5, 0); }
                asm volatile("" : "+v"(Pf0[0]), "+v"(Pf0[1]), "+v"(rs), "+v"(mx));
            }
            __builtin_amdgcn_sched_barrier(0);
            if (diag) {
#pragma unroll
                for (int i = 0; i < 16; ++i) { const int kp = 64 * kt + 32 + (i & 3) + 4 * ((i >> 2) & 1) + 8 * hh + 16 * (i >> 3); if (kp > qp || kp < PADL) S1[i] = -INFINITY; } }
            {
#pragma unroll
                for (int s2 = 0; s2 < 2; ++s2)
#pragma unroll
                    for (int d = 0; d < 4; ++d) O[d] = MFMA32(Vf[s2][d], Pf0[s2], O[d]);
#pragma unroll
                for (int s2 = 0; s2 < 2; ++s2)
#pragma unroll
                    for (int d = 0; d < 4; ++d) Vg[s2][d] = *(const LAS bf16x8*)(L + bo + d * 32 * 128 + vbase + (((4 + 2 * s2 + hh) ^ vx) << 4));
                { const float m0 = fmaxf(fmaxf(S1[0], S1[1]), fmaxf(S1[2], S1[3])), m1 = fmaxf(fmaxf(S1[4], S1[5]), fmaxf(S1[6], S1[7])), m2 = fmaxf(fmaxf(S1[8], S1[9]), fmaxf(S1[10], S1[11])), m3 = fmaxf(fmaxf(S1[12], S1[13]), fmaxf(S1[14], S1[15]));
                  mx = fmaxf(mx, fmaxf(fmaxf(m0, m1), fmaxf(m2, m3))); }
#pragma unroll
                for (int i = 0; i < 16; ++i) S1[i] = __builtin_amdgcn_exp2f(S1[i] - mu);
#pragma unroll
                for (int i = 0; i < 8; ++i) { __builtin_amdgcn_sched_group_barrier(0x008, 1, 0); __builtin_amdgcn_sched_group_barrier(0x100, 1, 0); __builtin_amdgcn_sched_group_barrier(0x002, 6, 0); }
#pragma unroll
                for (int s2 = 0; s2 < 2; ++s2) { u32x4 w; w.x = pk2(S1[8 * s2], S1[8 * s2 + 1]); w.y = pk2(S1[8 * s2 + 2], S1[8 * s2 + 3]); w.z = pk2(S1[8 * s2 + 4], S1[8 * s2 + 5]); w.w = pk2(S1[8 * s2 + 6], S1[8 * s2 + 7]); Pf1[s2] = __builtin_bit_cast(bf16x8, w); }
                asm volatile("" : "+v"(Pf1[0]), "+v"(Pf1[1]), "+v"(mx));
            }
            __builtin_amdgcn_sched_barrier(0);
#pragma unroll
            for (int s2 = 0; s2 < 2; ++s2)
#pragma unroll
                for (int d = 0; d < 4; ++d) O[d] = MFMA32(Vg[s2][d], Pf1[s2], O[d]);
            rs += (((S1[0] + S1[1]) + (S1[2] + S1[3])) + ((S1[4] + S1[5]) + (S1[6] + S1[7]))) + (((S1[8] + S1[9]) + (S1[10] + S1[11])) + ((S1[12] + S1[13]) + (S1[14] + S1[15])));
            __builtin_amdgcn_sched_barrier(0);
            if (kt + 2 < nk) AT_ISSUE(kt + 2);
            lsum += rs;
            { const u32x2 sw = __builtin_amdgcn_permlane32_swap(__builtin_bit_cast(unsigned, mx), __builtin_bit_cast(unsigned, mx), false, false); mx = fmaxf(__builtin_bit_cast(float, sw[0]), __builtin_bit_cast(float, sw[1])); }
            if (__any(mx > m + 8.f)) { const float mn = fmaxf(m, mx), f = (mn == -INFINITY) ? 1.f : __builtin_amdgcn_exp2f(mu - mn); lsum *= f; m = mn;
#pragma unroll
                for (int d = 0; d < 4; ++d)
#pragma unroll
                    for (int i = 0; i < 16; ++i) O[d][i] *= f; }
        }
    }
#undef AT_ISSUE
    if (act) {
        const float ltot = lsum + __shfl_xor(lsum, 32), inv = ltot > 0.f ? 1.f / ltot : 0.f;
        if (G == 0) {
            bf16* orow = att + qr * 1024 + hd * 128;
#pragma unroll
            for (int d = 0; d < 4; ++d)
#pragma unroll
                for (int g = 0; g < 4; ++g) { u32x2 w; w.x = pk2(O[d][4 * g] * inv, O[d][4 * g + 1] * inv); w.y = pk2(O[d][4 * g + 2] * inv, O[d][4 * g + 3] * inv);
                    *(GAS u32x2*)(orow + 32 * d + 8 * g + 4 * hh) = w; }
        } else {
            unsigned char* orow8 = wsl + WS_ATT8 + qr * 1024 + hd * 128 + 16 * hh; const float sc = inv * ATT8SCALE;
#pragma unroll
            for (int d = 0; d < 4; ++d) { unsigned pc[4];
#pragma unroll
                for (int g = 0; g < 4; ++g) { int ww = 0;
                    ww = __builtin_amdgcn_cvt_pk_fp8_f32(__builtin_amdgcn_fmed3f(O[d][4 * g] * sc, -448.f, 448.f), __builtin_amdgcn_fmed3f(O[d][4 * g + 1] * sc, -448.f, 448.f), ww, false);
                    ww = __builtin_amdgcn_cvt_pk_fp8_f32(__builtin_amdgcn_fmed3f(O[d][4 * g + 2] * sc, -448.f, 448.f), __builtin_amdgcn_fmed3f(O[d][4 * g + 3] * sc, -448.f, 448.f), ww, true); pc[g] = (unsigned)ww; }
                const u32x2 s02 = __builtin_amdgcn_permlane32_swap(pc[0], pc[2], false, false), s13 = __builtin_amdgcn_permlane32_swap(pc[1], pc[3], false, false);
                *(GAS u32x4*)(orow8 + 32 * d) = (u32x4){s02[0], s02[1], s13[0], s13[1]}; }
        }
    }
    __builtin_amdgcn_s_barrier();
}

constexpr int CW_ATTQ = 8256;
DI void phase_mix(const Frame& F, int l) {
#ifndef REPMASK
#define REPMASK 0u
#endif
    volatile LAS int* qslot = (volatile LAS int*)(F.lds + MAIL_OFF);
    const bool spread = (F.G == 256);
    for (int task = spread ? ((F.vcu & 1) ? 128 : (F.vcu >> 1)) : F.vcu; task < 128; task += F.G) {
        const int bh = task >> 2, b = bh >> 3, hd = bh & 7;
        for (int rp = 0; rp < 1 + (int)((REPMASK >> 15) & 1u); ++rp) mlstm_task(F, b, hd, task & 3);
    }
    unsigned* qhead = F.ctl + CW_ATTQ + 64 * l;
    for (;;) {
        if (F.tid == 0) qslot[0] = (int)__hip_atomic_fetch_add(qhead, 1u, __ATOMIC_RELAXED, __HIP_MEMORY_SCOPE_AGENT);
        __syncthreads();
        const int item = __builtin_amdgcn_readfirstlane(qslot[0]);
        __syncthreads();
        if (item >= 32 * 17) break;
        const int G = item < 512 ? 16 - (item >> 5) : 0, bh = item & 31;
        attn_item(F, bh >> 3, bh & 7, G);
    }
}

DI void pass_hmnorm(const Frame& F, PK P, int l) {
    unsigned char* ws = F.ws; const bf16* hraw = (const bf16*)(ws + WS_HRAW); const bf16* z = (const bf16*)(ws + WS_Z); bf16* hm = (bf16*)(ws + WS_HM);
    const float* g = P->in[I_MLNG] + (size_t)l * 2048;
    const int gw = F.vcu * NW + F.wave, NGW = F.G * NW, lane = F.lane;
    u32x4 nh[4], nz[4];
    if (gw < RROWS) {
#pragma unroll
        for (int qd = 0; qd < 4; ++qd) { nh[qd] = *(const u32x4*)(hraw + (size_t)gw * 2048 + 32 * lane + 8 * qd); nz[qd] = *(const u32x4*)(z + (size_t)gw * ZW + ZC_MO + 32 * lane + 8 * qd); } }
    for (int r = gw; r < RROWS; r += NGW) {
        f32x4 x[8]; float ss = 0.f; u32x4 cz[4];
#pragma unroll
        for (int qd = 0; qd < 4; ++qd) { unpack8(nh[qd], x[2 * qd], x[2 * qd + 1]); cz[qd] = nz[qd]; }
        if (r + NGW < RROWS) {
#pragma unroll
            for (int qd = 0; qd < 4; ++qd) { nh[qd] = *(const u32x4*)(hraw + (size_t)(r + NGW) * 2048 + 32 * lane + 8 * qd); nz[qd] = *(const u32x4*)(z + (size_t)(r + NGW) * ZW + ZC_MO + 32 * lane + 8 * qd); } }
#pragma unroll
        for (int i = 0; i < 8; ++i) ss += (x[i][0] * x[i][0] + x[i][1] * x[i][1]) + (x[i][2] * x[i][2] + x[i][3] * x[i][3]);
        ss = grp8_sum(ss);
        const float rs = 1.f / sqrtf(ss * (1.f / 256.f) + RMS_EPS);
#pragma unroll
        for (int qd = 0; qd < 4; ++qd) { f32x4 m0, m1; unpack8(cz[qd], m0, m1);
            const f32x4 g0 = *(const f32x4*)(g + 32 * lane + 8 * qd), g1 = *(const f32x4*)(g + 32 * lane + 8 * qd + 4);
            x[2 * qd] = x[2 * qd] * rs * g0 * sig4(m0); x[2 * qd + 1] = x[2 * qd + 1] * rs * g1 * sig4(m1);
            if (r >= NREAL) *(u32x4*)(hm + (size_t)r * 2048 + 32 * lane + 8 * qd) = pack8(x[2 * qd], x[2 * qd + 1]); }
        if (r < NREAL) { unsigned char* h8 = ws + WS_HM8 + (size_t)r * 2048 + 32 * lane;
#pragma unroll
            for (int hf = 0; hf < 2; ++hf) { u32x4 w;
#pragma unroll
                for (int q2 = 0; q2 < 4; ++q2) { const f32x4 v = x[4 * hf + q2]; int ww = 0;
                    ww = __builtin_amdgcn_cvt_pk_fp8_f32(__builtin_amdgcn_fmed3f(v[0] * A8SCALE, -448.f, 448.f), __builtin_amdgcn_fmed3f(v[1] * A8SCALE, -448.f, 448.f), ww, false);
                    ww = __builtin_amdgcn_cvt_pk_fp8_f32(__builtin_amdgcn_fmed3f(v[2] * A8SCALE, -448.f, 448.f), __builtin_amdgcn_fmed3f(v[3] * A8SCALE, -448.f, 448.f), ww, true); w[q2] = (unsigned)ww; }
                *(u32x4*)(h8 + 16 * hf) = w; } }
    }
}

template <int MODE, int K> DI void mini_meta_gemm(const Frame& F, const bf16* A, const bf16* Bt) {
    unsigned char* ws = F.ws;
    if (F.vcu >= 128) return;
    const int lane = F.lane, l15 = lane & 15, lq = lane >> 4, n0 = F.vcu * 16;
    constexpr int KW = K / 8;
    const bf16* ap = A + (size_t)(NREAL + PADL + l15) * K + F.wave * KW + 8 * lq; const bf16* bp = Bt + (size_t)(n0 + l15) * K + F.wave * KW + 8 * lq;
    f32x4 acc = (f32x4){0.f, 0.f, 0.f, 0.f};
#pragma unroll
    for (int kk = 0; kk < KW / 32; ++kk) acc = MFMA16(*(const bf16x8*)(bp + kk * 32), *(const bf16x8*)(ap + kk * 32), acc);
    LAS f32x4* red = (LAS f32x4*)F.lds;
    red[F.wave * 64 + lane] = acc;
    __syncthreads();
    if (F.wave == 0) {
#pragma unroll
        for (int w = 1; w < 8; ++w) acc += red[w * 64 + lane];
        const int col = n0 + 4 * lq; const size_t r0 = (size_t)(NREAL + PADL + l15);
        if (MODE == 2) { const bf16* hb = (const bf16*)(ws + WS_HB); bf16* rr = (bf16*)(ws + WS_H); const u32x2 hw = *(const u32x2*)(hb + r0 * DM + col);
            const f32x4 o = (f32x4){bflo(hw.x), bfhi(hw.x), bflo(hw.y), bfhi(hw.y)} * ALPHA + acc; u32x2 w; w.x = pk2(o[0], o[1]); w.y = pk2(o[2], o[3]);
#pragma unroll
            for (int b = 0; b < NBATCH; ++b) *(u32x2*)(rr + (r0 + 64 * b) * DM + col) = w; }
        else { const bf16* z = (const bf16*)(ws + WS_Z); bf16* tb = (bf16*)(ws + WS_TBUF); bf16* y = (bf16*)(ws + WS_Y);
            const u32x2 gw = *(const u32x2*)(z + r0 * ZW + (MODE == 0 ? ZC_GA : ZC_GB) + col);
            f32x4 o = (f32x4){sigmoidf_(bflo(gw.x)), sigmoidf_(bfhi(gw.x)), sigmoidf_(bflo(gw.y)), sigmoidf_(bfhi(gw.y))} * acc;
            if (MODE == 1) { const u32x2 pw = *(const u32x2*)(tb + r0 * DM + col); o += (f32x4){bflo(pw.x), bfhi(pw.x), bflo(pw.y), bfhi(pw.y)}; }
            u32x2 w; w.x = pk2(o[0], o[1]); w.y = pk2(o[2], o[3]); bf16* dst = MODE == 0 ? tb : y;
#pragma unroll
            for (int b = 0; b < NBATCH; ++b) *(u32x2*)(dst + (r0 + 64 * b) * DM + col) = w; }
    }
    __syncthreads();
}

typedef int v8i __attribute__((ext_vector_type(8)));
constexpr int CW_FP8BAD = 8192;
DI void fp8_selftest(const Frame& F) {
    if (F.vcu != 0 || F.wave != 0) return;
    const int l = F.lane, i = l & 15, kb = l >> 4;
    v8i A, B;
#pragma unroll
    for (int q = 0; q < 8; ++q) { int wa = 0, wb = 0; float av[4], bv[4];
#pragma unroll
        for (int e = 0; e < 4; ++e) { const int k = 32 * kb + 4 * q + e; av[e] = (float)(((i * 7 + k * 3) % 9) - 4); bv[e] = (float)(((k * 5 + i * 11) % 7) - 3); }
        wa = __builtin_amdgcn_cvt_pk_fp8_f32(av[0], av[1], wa, false); wa = __builtin_amdgcn_cvt_pk_fp8_f32(av[2], av[3], wa, true);
        wb = __builtin_amdgcn_cvt_pk_fp8_f32(bv[0], bv[1], wb, false); wb = __builtin_amdgcn_cvt_pk_fp8_f32(bv[2], bv[3], wb, true);
        A[q] = wa; B[q] = wb; }
    f32x4 c = (f32x4){0.f, 0.f, 0.f, 0.f};
    c = __builtin_amdgcn_mfma_scale_f32_16x16x128_f8f6f4(A, B, c, 0, 0, 0, 0x7F7F7F7F, 0, 0x7F7F7F7F);
    bool bad = false;
#pragma unroll
    for (int rg = 0; rg < 4; ++rg) { const int ii = 4 * (l >> 4) + rg, jj = l & 15; int ref = 0;
        for (int k = 0; k < 128; ++k) ref += (((ii * 7 + k * 3) % 9) - 4) * (((k * 5 + jj * 11) % 7) - 3);
        bad |= (c[rg] != (float)ref); }
    f32x4 c2 = (f32x4){0.f, 0.f, 0.f, 0.f};
    c2 = __builtin_amdgcn_mfma_scale_f32_16x16x128_f8f6f4(A, B, c2, 0, 0, 0, 0x7F7F7F7F, 0, 0x79797979);
#pragma unroll
    for (int rg = 0; rg < 4; ++rg) bad |= (c2[rg] * 64.f != c[rg]);
    { const int i3 = l & 31, kb3 = l >> 5; v8i A3, B3;
#pragma unroll
      for (int q = 0; q < 8; ++q) { int wa = 0, wb = 0; float av[4], bv[4];
#pragma unroll
          for (int e = 0; e < 4; ++e) { const int k = 32 * kb3 + 4 * q + e; av[e] = (float)(((i3 * 7 + k * 3) % 9) - 4); bv[e] = (float)(((k * 5 + i3 * 11) % 7) - 3); }
          wa = __builtin_amdgcn_cvt_pk_fp8_f32(av[0], av[1], wa, false); wa = __builtin_amdgcn_cvt_pk_fp8_f32(av[2], av[3], wa, true);
          wb = __builtin_amdgcn_cvt_pk_fp8_f32(bv[0], bv[1], wb, false); wb = __builtin_amdgcn_cvt_pk_fp8_f32(bv[2], bv[3], wb, true);
          A3[q] = wa; B3[q] = wb; }
      f32x16 c3;
#pragma unroll
      for (int i = 0; i < 16; ++i) c3[i] = 0.f;
      c3 = __builtin_amdgcn_mfma_scale_f32_32x32x64_f8f6f4(A3, B3, c3, 0, 0, 0, 0x7F7F7F7F, 0, 0x7F7F7F7F);
#pragma unroll
      for (int rg = 0; rg < 16; ++rg) { const int ii = (rg & 3) + 8 * (rg >> 2) + 4 * (l >> 5), jj = l & 31; int ref = 0;
          for (int k = 0; k < 64; ++k) ref += (((ii * 7 + k * 3) % 9) - 4) * (((k * 5 + jj * 11) % 7) - 3);
          bad |= (c3[rg] != (float)ref); } }
    if (__any(bad) && l == 0) F.ctl[CW_FP8BAD] = 1u;
}

constexpr int RT_LSTR = 68;
DI void phase_ln1_route(const Frame& F, PK P, int l) {
    unsigned char* ws = F.ws; LAS unsigned char* L = F.lds;
    const bf16* rr = (const bf16*)(ws + WS_H); bf16* hb = (bf16*)(ws + WS_HB);
    const float* eb = P->in[I_EBIAS] + (size_t)l * 64;
    int* selE = (int*)(ws + WS_SELE); float* selW = (float*)(ws + WS_SELW); int* locG = (int*)(ws + WS_LOC); int* cntT = (int*)(ws + WS_CNT);
    LAS unsigned long long* colp = (LAS unsigned long long*)L; LAS unsigned long long* col = (LAS unsigned long long*)(L + 4096); LAS int* colhi = (LAS int*)(L + 4608); LAS int* sE = (LAS int*)(L + 5120); LAS float* red = (LAS float*)(L + 8192);
    const float ebv = eb[F.lane];
    const int lane = F.lane;
    { int* tokI = (int*)(ws + WS_TOK); for (int i = F.vcu * NT + F.tid; i < PROWS; i += F.G * NT) tokI[i] = 0; }
    for (int wg = F.vcu; wg < 256; wg += F.G) {
        { u32x4 nx[4];
#pragma unroll
          for (int j = 0; j < 4; ++j) nx[j] = *(const u32x4*)(rr + (size_t)(65 * wg + F.wave) * DM + LNCOL(lane, j));
          for (int i = F.wave; i < 65; i += NW) { const int r = 65 * wg + i; f32x4 v[8];
#pragma unroll
            for (int j = 0; j < 4; ++j) unpack8(nx[j], v[2 * j], v[2 * j + 1]);
            if (i + NW < 65) {
#pragma unroll
                for (int j = 0; j < 4; ++j) nx[j] = *(const u32x4*)(rr + (size_t)(r + NW) * DM + LNCOL(lane, j)); }
            ln_store(v, P->in[I_LN1G] + (size_t)l * DM, P->in[I_LN1B] + (size_t)l * DM, hb + (size_t)r * DM, lane, MOE_FP8 ? ws + WS_HB8 + (size_t)r * DM : nullptr); } }
        __syncthreads();
        { const int l15 = lane & 15, lq = lane >> 4, kq = F.wave >> 1, nh = F.wave & 1;
          const bf16* wp = (const bf16*)(ws + WS_WR) + (size_t)(32 * nh + l15) * DM + kq * 512 + 8 * lq;
          const bf16* tp = hb + (size_t)(65 * wg) * DM + kq * 512 + 8 * lq;
          unsigned to[5];
#pragma unroll
          for (int t = 0; t < 5; ++t) { const int tr = t * 16 + l15; to[t] = (unsigned)((tr < 65 ? tr : 64) * DM); }
          f32x4 acc[5][2];
#pragma unroll
          for (int t = 0; t < 5; ++t) { acc[t][0] = (f32x4){0.f, 0.f, 0.f, 0.f}; acc[t][1] = (f32x4){0.f, 0.f, 0.f, 0.f}; }
#pragma unroll 1
          for (int k0 = 0; k0 < 512; k0 += 128) { bf16x8 wf[4][2], tf[4][5];
#pragma unroll
              for (int s = 0; s < 4; ++s) { wf[s][0] = *(const bf16x8*)(wp + k0 + 32 * s); wf[s][1] = *(const bf16x8*)(wp + 16 * DM + k0 + 32 * s);
#pragma unroll
                  for (int t = 0; t < 5; ++t) tf[s][t] = *(const bf16x8*)(tp + to[t] + k0 + 32 * s); }
#pragma unroll
              for (int s = 0; s < 4; ++s)
#pragma unroll
                  for (int t = 0; t < 5; ++t) { acc[t][0] = MFMA16(wf[s][0], tf[s][t], acc[t][0]); acc[t][1] = MFMA16(wf[s][1], tf[s][t], acc[t][1]); } }
#pragma unroll
          for (int t = 0; t < 5; ++t)
#pragma unroll
              for (int c = 0; c < 2; ++c) *(LAS f32x4*)(red + (kq * 80 + t * 16 + l15) * RT_LSTR + 32 * nh + 16 * c + 4 * lq) = acc[t][c]; }
        __syncthreads();
        unsigned long long mycol = 0ull; int myhi = 0;
        for (int i = F.wave; i < 65; i += NW) { const int r = 65 * wg + i;
            const float lgv = (red[i * RT_LSTR + lane] + red[(80 + i) * RT_LSTR + lane]) + (red[(160 + i) * RT_LSTR + lane] + red[(240 + i) * RT_LSTR + lane]);
            const float s = 1.f / (1.f + expf(-lgv)), bsc = s + ebv;
            const float m1 = grp8_max(bsc);
            const unsigned long long eqb = __ballot(bsc == m1);
            const unsigned gb = (unsigned)(eqb >> (lane & 56)) & 0xFFu;
            const bool first = (lane & 7) == (__ffs((int)gb) - 1);
            const float m2 = grp8_max(first ? -INFINITY : bsc);
            const float gs = m1 + m2;
            int grank = 0; const int g = lane >> 3;
#pragma unroll
            for (int g2 = 0; g2 < 8; ++g2) { const float v = rlane(gs, 8 * g2); grank += (v > gs || (v == gs && g2 < g)) ? 1 : 0; }
            float rem = grank < 4 ? bsc : -INFINITY; int rank = 8;
#pragma unroll
            for (int k = 0; k < 8; ++k) { const float m = wave_max(rem); const unsigned long long bb = __ballot(rem == m); const int win = (int)__builtin_ctzll(bb); if (lane == win) { rank = k; rem = -INFINITY; } }
            const bool chosen = rank < 8;
            const float ssum = wave_sum(chosen ? s : 0.f);
            if (chosen) { selE[(size_t)r * 8 + rank] = lane; selW[(size_t)r * 8 + rank] = s / ssum * 2.5f; sE[i * 8 + rank] = lane; }
            if (i < 64) mycol |= chosen ? (1ull << i) : 0ull; else myhi = chosen ? 1 : 0;
        }
        colp[F.wave * 64 + lane] = mycol; if (F.wave == 0) colhi[lane] = myhi;
        __syncthreads();
        if (F.tid < 64) { unsigned long long c = 0ull;
#pragma unroll
            for (int w = 0; w < NW; ++w) c |= colp[w * 64 + F.tid];
            col[F.tid] = c; cntT[wg * 64 + F.tid] = __popcll(c) + colhi[F.tid]; }
        __syncthreads();
        for (int idx = F.tid; idx < 520; idx += NT) { const int i = idx >> 3, e = sE[idx]; const unsigned long long c = col[e];
            locG[(size_t)(65 * wg + i) * 8 + (idx & 7)] = i < 64 ? __popcll(c & ((1ull << i) - 1ull)) : __popcll(c); }
        __syncthreads();
    }
}
DI void phase_route2(const Frame& F) {
    unsigned char* ws = F.ws; LAS unsigned char* L = F.lds;
    const int* selE = (const int*)(ws + WS_SELE); const int* locG = (const int*)(ws + WS_LOC); const int* cntT = (const int*)(ws + WS_CNT);
    int* posG = (int*)(ws + WS_POS); int* tileE = (int*)(ws + WS_TILEE); int* tokI = (int*)(ws + WS_TOK);
    LAS int* base = (LAS int*)L; const int lane = F.lane;
    for (int wg = F.vcu; wg < 256; wg += F.G) {
        { const int e = F.tid & 63, sl = F.tid >> 6; int tot = 0, pre = 0;
#pragma unroll 8
          for (int w2 = 32 * sl; w2 < 32 * sl + 32; ++w2) { const int c = cntT[w2 * 64 + e]; tot += c; if (w2 < wg) pre += c; }
          base[128 + F.tid] = tot; base[640 + F.tid] = pre; }
        __syncthreads();
        if (F.tid < 64) { const int e = F.tid; int tot = 0, pre = 0;
#pragma unroll
            for (int sl = 0; sl < 8; ++sl) { tot += base[128 + 64 * sl + e]; pre += base[640 + 64 * sl + e]; }
            const int pc = (tot + 255) & ~255; int incl = pc;
#pragma unroll
            for (int o = 1; o < 64; o <<= 1) { const int t = __shfl_up(incl, o); if (lane >= o) incl += t; }
            const int pstart = incl - pc; base[e] = pstart + pre;
            if (e == 63) base[64] = (pstart + pc) >> 8;
            if (wg == 0) { for (int tau = pstart >> 8; tau < ((pstart + pc) >> 8); ++tau) tileE[8 + tau] = e; if (e == 63) tileE[0] = (pstart + pc) >> 8; }
        }
        __syncthreads();
        const int ntr = base[64];
        for (int idx = F.tid; idx < 65 * 8; idx += NT) { const int r = 65 * wg + (idx >> 3); const int dest = base[selE[(size_t)r * 8 + (idx & 7)]] + locG[(size_t)r * 8 + (idx & 7)]; posG[(size_t)r * 8 + (idx & 7)] = dest; tokI[dest] = r; }
        for (int i = F.tid; i < 65; i += NT) { const int r = 65 * wg + i; tokI[ntr * 256 + r] = r; }
        __syncthreads();
    }
}
DI void phase_combine(const Frame& F, PK P, int l) {
    unsigned char* ws = F.ws; bf16* hb = (bf16*)(ws + WS_HB); const unsigned char* ya = (const unsigned char*)(ws + WS_XG);
    const int* posG = (const int*)(ws + WS_POS); const float* selW = (const float*)(ws + WS_SELW); const int* tileE = (const int*)(ws + WS_TILEE);
    const int gw = F.vcu * NW + F.wave, NGW = F.G * NW, lane = F.lane; const int ntr = tileE[0];
    const bool poison = (l == 1) && (__hip_atomic_load(F.ctl + CW_FP8BAD, __ATOMIC_RELAXED, __HIP_MEMORY_SCOPE_AGENT) != 0u);
    int npos = 0; float nw = 0.f; u32x4 nhb[4];
    if (gw < RROWS) { if (lane < 8) { npos = posG[(size_t)gw * 8 + lane]; nw = selW[(size_t)gw * 8 + lane]; }
#pragma unroll
        for (int j = 0; j < 4; ++j) nhb[j] = *(const u32x4*)(hb + (size_t)gw * DM + LNCOL(lane, j)); }
    for (int r = gw; r < RROWS; r += NGW) {
        const int pos = npos; const float w = nw;
        f32x4 v[8];
#pragma unroll
        for (int j = 0; j < 4; ++j) { unpack8(nhb[j], v[2 * j], v[2 * j + 1]); v[2 * j] = v[2 * j] * ALPHA; v[2 * j + 1] = v[2 * j + 1] * ALPHA; }
        if (r + NGW < RROWS) { if (lane < 8) { npos = posG[(size_t)(r + NGW) * 8 + lane]; nw = selW[(size_t)(r + NGW) * 8 + lane]; }
#pragma unroll
            for (int j = 0; j < 4; ++j) nhb[j] = *(const u32x4*)(hb + (size_t)(r + NGW) * DM + LNCOL(lane, j)); }
#pragma unroll
        for (int k = 0; k < 9; ++k) { const int row = k < 8 ? __builtin_amdgcn_readlane(pos, k) : ntr * 256 + r; const float wk = (k < 8 ? rlane(w, k) : 1.f) * (1.f / Y8SCALE);
            const unsigned char* yr = ya + (size_t)row * DM;
#pragma unroll
            for (int j = 0; j < 4; ++j) { const u32x2 yw = __builtin_nontemporal_load((const u32x2*)(yr + LNCOL(lane, j)));
                const f32x2 a0 = __builtin_amdgcn_cvt_pk_f32_fp8((int)yw.x, false), a1 = __builtin_amdgcn_cvt_pk_f32_fp8((int)yw.x, true), a2 = __builtin_amdgcn_cvt_pk_f32_fp8((int)yw.y, false), a3 = __builtin_amdgcn_cvt_pk_f32_fp8((int)yw.y, true);
                v[2 * j] += (f32x4){a0[0], a0[1], a1[0], a1[1]} * wk; v[2 * j + 1] += (f32x4){a2[0], a2[1], a3[0], a3[1]} * wk; } }
        ln_store(v, P->in[I_LN2G] + (size_t)l * DM, P->in[I_LN2B] + (size_t)l * DM, hb + (size_t)r * DM, lane, l == 0 ? ws + WS_HB8 + (size_t)r * DM : nullptr);
        if (l == 1) {
            if (r < NREAL) { float* o = P->out + (size_t)r * DM;
#pragma unroll
                for (int j = 0; j < 4; ++j) { const int c = LNCOL(lane, j); if (poison) { v[2 * j] = (f32x4){NAN, NAN, NAN, NAN}; v[2 * j + 1] = v[2 * j]; } *(f32x4*)(o + c) = v[2 * j]; *(f32x4*)(o + c + 4) = v[2 * j + 1]; } } }
    }
}

constexpr int NPHASE = 25;
#ifndef PHMASK
#define PHMASK 0xFFFFFFFFu
#endif
#define EN(j) ((PHMASK >> (j)) & 1u)
#ifndef REPMASK
#define REPMASK 0u
#endif
#define REP(j) for (int rep_ = 0; rep_ < 1 + (int)((REPMASK >> (j)) & 1u); ++rep_)
#define IN(k) (lo <= (k) && (k) < hi)
#define PHASE_BEGIN PK P = kargs(); unsigned char* ws = P->ws; Frame F = F0; asm volatile("" : "+s"(F.wave), "+s"(F.vcu), "+s"(F.G)); F.lane = lane_id(); asm volatile("" : "+v"(F.lane)); F.tid = F.wave * 64 + F.lane; F.ws = ws; F.ctl = (unsigned*)(ws + WS_CTL); \
        LAS unsigned char* ring = F.lds; const int G = F.G; int cid = (int)blockIdx.x; asm volatile("" : "+s"(cid)); (void)ring; (void)G; (void)cid;
#define SEAM(k) do { if (IN(k) && IN((k) + 1)) { PK Pb = kargs(); XcdBarrier bar; bar.bar = (unsigned*)(Pb->ws + WS_CTL); bar.x = xb_xcc_id(); bar.st = MISC + 8; xcd_barrier(bar, F0.wave == 0 && lane_id() == 0); } } while (0)


template <int L> DI void run_layer(const Frame& F0, volatile LAS unsigned* MISC, const int lo, const int hi) {
    constexpr int l = L;
        constexpr int pb = 1 + 12 * L;
        if (EN(0) && IN(pb + 0)) REP(0) { PHASE_BEGIN;
            { InProjOrderA S; S.init(ws + WS_HB, ws + WS_WIN, G, cid);
              EpiInProj E{(bf16*)(ws + WS_Z), (float*)(ws + WS_ZS), (const float*)(ws + WS_BIAS), F.lds + EPI_OFF};
              pg8::gemm_phase<DM * 2, DM * 2, DM * 2>(ring, F.tid, S, E); }
            { PHASE_BEGIN;
              InProjOrder8 S; S.init(ws + WS_HB8, ws + WS_WIN8, G, cid);
              EpiInProj8 E{(bf16*)(ws + WS_Z), (const float*)(ws + WS_BIAS), F.lds + EPI_OFF};
              pg8::gemm_phase<DM, DM, DM, false, true, 127, 121>(ring, F.tid, S, E); }
        } SEAM(pb + 0);
        if (EN(1) && IN(pb + 1)) REP(1) { PHASE_BEGIN; phase_prep(F, P, l); } SEAM(pb + 1);
        if (EN(2) && IN(pb + 2)) REP(2) {
            { PHASE_BEGIN; pg8::StaticOrder<ZW * 2, 1024, RROWS / 256, 6> S; S.init(ws + WS_Z + (size_t)ZC_CQ * 2, ws + WS_WUQ, G, cid);
              EpiRowScale E{(bf16*)(ws + WS_Q), 1536, (const float*)(ws + WS_RSTD), 2, F.lds + EPI_OFF}; pg8::gemm_phase<ZW * 2, 1024, 1024>(ring, F.tid, S, E); }
            { PHASE_BEGIN; pg8::StaticOrder<ZW * 2, 1024, RROWS / 256, 4> S; S.init(ws + WS_Z + (size_t)ZC_CKV * 2, ws + WS_WKV, G, (cid + G - (RROWS / 256 * 6) % G) % G);
              EpiRowScale E{(bf16*)(ws + WS_KN), 1024, (const float*)(ws + WS_RSTD) + 1, 2, F.lds + EPI_OFF}; pg8::gemm_phase<ZW * 2, 1024, 1024>(ring, F.tid, S, E); }
            { PHASE_BEGIN; pg8::StaticOrder<1024, ZW * 2, 4, RROWS / 256> S; S.init(ws + WS_WKV + (size_t)1024 * 512 * 2, ws + WS_Z + (size_t)ZC_CKV * 2, G, (cid + 2 * G - (RROWS / 256 * 10) % G) % G);
              EpiColScale E{(bf16*)(ws + WS_VT), RROWS, (const float*)(ws + WS_RSTD) + 1, 2, F.lds + EPI_OFF}; pg8::gemm_phase<1024, ZW * 2, 1024>(ring, F.tid, S, E); }
        } SEAM(pb + 2);
        if (EN(3) && IN(pb + 3)) REP(3) { PHASE_BEGIN; phase_mix(F, l); } SEAM(pb + 3);
        if (EN(4) && IN(pb + 4)) REP(4) {
            { PHASE_BEGIN; pass_hmnorm(F, P, l); }
            { PHASE_BEGIN; mini_meta_gemm<0, 1024>(F, (const bf16*)(ws + WS_ATT), (const bf16*)(ws + WS_WBRA)); }
            { PHASE_BEGIN; pg8::StaticOrder<1024, 1024, NREAL / 256, 8> S; S.init(ws + WS_ATT8, ws + WS_WBRA8, G, cid);
              EpiGate8<0, 0> E{(void*)(ws + WS_TBUF), (const bf16*)(ws + WS_Z) + ZC_GA, nullptr, F.lds + EPI_OFF}; pg8::gemm_phase<1024, 1024, 1024, false, true, 123, 121>(ring, F.tid, S, E); }
        } SEAM(pb + 4);
        if (EN(5) && IN(pb + 5)) REP(5) { PHASE_BEGIN;
            mini_meta_gemm<1, DM>(F, (const bf16*)(ws + WS_HM), (const bf16*)(ws + WS_WBRB));
            pg8::StaticOrder<DM, DM, NREAL / 256, 8> S; S.init(ws + WS_HM8, ws + WS_WBRB8, G, cid);
            EpiGate8<1, 1> E{(void*)(ws + WS_Y8), (const bf16*)(ws + WS_Z) + ZC_GB, (const bf16*)(ws + WS_TBUF), F.lds + EPI_OFF}; pg8::gemm_phase<DM, DM, DM, false, true, 124, 121>(ring, F.tid, S, E);
        } SEAM(pb + 5);
        if (EN(6) && IN(pb + 6)) REP(6) { PHASE_BEGIN;
            mini_meta_gemm<2, DM>(F, (const bf16*)(ws + WS_Y), (const bf16*)(ws + WS_WOUT));
            pg8::StaticOrder<DM, DM, NREAL / 256, 8> S; S.init(ws + WS_Y8, ws + WS_WOUT8, G, cid);
            EpiResid8 E{(const bf16*)(ws + WS_HB), (bf16*)(ws + WS_H), F.lds + EPI_OFF}; pg8::gemm_phase<DM, DM, DM, false, true, 124, 121>(ring, F.tid, S, E);
        } SEAM(pb + 6);
        if (EN(7) && IN(pb + 7)) REP(7) { PHASE_BEGIN; phase_ln1_route(F, P, l); } SEAM(pb + 7);
        if (EN(8) && IN(pb + 8)) REP(8) { PHASE_BEGIN; phase_route2(F); } SEAM(pb + 8);
        if (EN(9) && IN(pb + 9)) REP(9) { PHASE_BEGIN;
#if MOE_FP8
            MoeOrder<4, 2048, true> S; S.init(ws + WS_HB8, ws + WS_W13, (const int*)(ws + WS_TILEE), (const int*)(ws + WS_TOK), F.lds, F.tid, G, cid);
            EpiSwiGLU8 E{(unsigned char*)(ws + WS_HBUF)}; pg8::gemm_phase<DM, DM, DM, true, true, 127, 121>(ring, F.tid, S, E);
#else
            MoeOrder<4, 4096, true> S; S.init(ws + WS_HB, ws + WS_W13, (const int*)(ws + WS_TILEE), (const int*)(ws + WS_TOK), F.lds, F.tid, G, cid);
            EpiSwiGLU E{(unsigned char*)(ws + WS_HBUF), F.lds + EPI_OFF}; pg8::gemm_phase<DM * 2, DM * 2, DM * 2, true>(ring, F.tid, S, E);
#endif
        } SEAM(pb + 9);
        if (EN(10) && IN(pb + 10)) REP(10) { PHASE_BEGIN;
#if MOE_FP8
            MoeOrder<8, 512, false> S; S.init(ws + WS_HBUF, ws + WS_W2, (const int*)(ws + WS_TILEE), (const int*)(ws + WS_TOK), F.lds, F.tid, G, cid);
            EpiPlain8 E{(unsigned char*)(ws + WS_XG), F.lds + EPI_OFF}; pg8::gemm_phase<512, 512, 512, false, true, 124, 121>(ring, F.tid, S, E);
#else
            MoeOrder<8, 1024, false> S; S.init(ws + WS_HBUF, ws + WS_W2, (const int*)(ws + WS_TILEE), (const int*)(ws + WS_TOK), F.lds, F.tid, G, cid);
            EpiPlain E{(bf16*)(ws + WS_XG), DM, F.lds + EPI_OFF}; pg8::gemm_phase<1024, 1024, 1024, false, false>(ring, F.tid, S, E);
#endif
        } SEAM(pb + 10);
        if (EN(11) && IN(pb + 11)) REP(11) { { PHASE_BEGIN; phase_combine(F, P, l); } if (l == 0) { PHASE_BEGIN; convert_layer(F, P, 1); } } SEAM(pb + 11);
    }

__global__ void __launch_bounds__(NT, 2) mega_fwd(Params Pv) {
    extern __shared__ __attribute__((aligned(16))) unsigned char lds_raw[];
    Frame F0;
    F0.lds = (LAS unsigned char*)lds_raw;
    F0.tid = 0; F0.lane = 0; F0.wave = __builtin_amdgcn_readfirstlane((int)threadIdx.x >> 6);
    F0.G = gridDim.x; { const int bx = blockIdx.x; F0.vcu = (F0.G % 8 == 0) ? (bx % 8) * (F0.G / 8) + bx / 8 : bx; }
    F0.ws = nullptr; F0.ctl = nullptr;
    volatile LAS unsigned* MISC = (volatile LAS unsigned*)(F0.lds + MISC_OFF);
    if (threadIdx.x < 32) MISC[threadIdx.x] = 0u;
    __syncthreads();
    const int lo = Pv.ph_lo, hi = Pv.ph_hi;
    if (hi - lo > 1) { PK P = kargs(); (void)xcd_barrier_post((unsigned*)(P->ws + WS_CTL), MISC + 8); }
    if (EN(14) && IN(0)) REP(14) { PHASE_BEGIN; phase_prologue(F, P); } SEAM(0);
    run_layer<0>(F0, MISC, lo, hi);
    run_layer<1>(F0, MISC, lo, hi);
}


#ifndef MK_PER_PHASE
#define MK_PER_PHASE 0
#endif
extern "C" void kernel_launch(void* const* d_in, const int* in_sizes, int n_in, void* d_out, int out_size, void* d_ws, size_t ws_size, hipStream_t stream) {
    static int grid = 0;
    if (grid == 0) {
        if (n_in != 28 || ws_size < WS_END) { fprintf(stderr, "kernel_launch: unexpected inputs (n_in %d, ws %zu, need %zu)\n", n_in, ws_size, (size_t)WS_END); grid = -1; return; }
        int dev = 0, cus = 0;
        if (hipGetDevice(&dev) != hipSuccess || hipDeviceGetAttribute(&cus, hipDeviceAttributeMultiprocessorCount, dev) != hipSuccess) { grid = -1; return; }
        if (hipFuncSetAttribute((const void*)mega_fwd, hipFuncAttributeMaxDynamicSharedMemorySize, LDS_BYTES) != hipSuccess) { grid = -1; return; }
        int per_cu = 0;
        (void)hipOccupancyMaxActiveBlocksPerMultiprocessor(&per_cu, (const void*)mega_fwd, NT, LDS_BYTES);
        (void)hipGetLastError();
        grid = cus;
    }
    if (grid < 0) return;
    (void)hipMemsetAsync((char*)d_ws + WS_CTL, 0, 65536, stream);
    Params p{};
    for (int i = 0; i < 28; ++i) p.in[i] = (const float*)d_in[i];
    p.out = (float*)d_out; p.ws = (unsigned char*)d_ws;
#if MK_PER_PHASE
    for (int ph = 0; ph < NPHASE; ++ph) { p.ph_lo = ph; p.ph_hi = ph + 1; hipLaunchKernelGGL(mega_fwd, dim3(grid), dim3(NT), LDS_BYTES, stream, p); }
#else
    p.ph_lo = 0; p.ph_hi = NPHASE; hipLaunchKernelGGL(mega_fwd, dim3(grid), dim3(NT), LDS_BYTES, stream, p);
#endif
}
```
